# Optimizing an MI355X kernel written in HIP

```python
import jax, jax.numpy as jnp
from jax import lax
import numpy as np

D_MODEL = 1024
BATCH = 2
SEQ = 8192
DEPTH = 2
DEC_BATCH = 16
DEC_SEQ = 4096
PAST_LEN = 128

GRID_W = 64
Q_BLOCK = 128
EPS = 1e-6
ROPE_THETA = 10000.0
NEG_INF = -1e30
A_HEADS = 8
A_HEAD_DIM = 64
DILATED_CONFIGS = ((128, 1), (512, 4), (2048, 16))
MLA_HEADS = 8
MLA_Q_RANK = 256
MLA_KV_RANK = 128
MLA_NOPE_DIM = 64
MLA_ROPE_DIM = 32
MLA_V_DIM = 64
C_HEADS = 16
C_KV_HEADS = 4
C_HEAD_DIM = 64
A_WIDTH = A_HEADS * A_HEAD_DIM
B_WIDTH = MLA_HEADS * MLA_V_DIM
AB_WIDTH = A_WIDTH + B_WIDTH
SPLIT_AB = list(np.cumsum([A_WIDTH, A_WIDTH, A_WIDTH, MLA_Q_RANK, MLA_KV_RANK, MLA_ROPE_DIM]))
IN_AB = 3 * A_WIDTH + MLA_Q_RANK + MLA_KV_RANK + MLA_ROPE_DIM + AB_WIDTH
C_WIDTH = C_HEADS * C_HEAD_DIM
C_KV_WIDTH = C_KV_HEADS * C_HEAD_DIM
SPLIT_C = list(np.cumsum([C_WIDTH, C_KV_WIDTH, C_KV_WIDTH]))
IN_C = C_WIDTH + 2 * C_KV_WIDTH + C_WIDTH
N_EVEN_LAYERS = (DEPTH + 1) // 2
N_ODD_LAYERS = DEPTH // 2

kernel_name = "hybrid_dilated_mla_axial_gqa_encoder"


def rms_norm(x, g):
    xf = x.astype(jnp.float32)
    y = xf * lax.rsqrt(jnp.mean(xf * xf, axis=-1, keepdims=True) + EPS)
    return (y * g.astype(jnp.float32)).astype(x.dtype)


def rope(x, pos):
    half = x.shape[-1] // 2
    freqs = ROPE_THETA ** (-jnp.arange(half, dtype=jnp.float32) / half)
    ang = pos[:, None] * freqs[None, :]
    cos = jnp.cos(ang)[:, None, :].astype(x.dtype)
    sin = jnp.sin(ang)[:, None, :].astype(x.dtype)
    x1, x2 = x[..., :half], x[..., half:]
    return jnp.concatenate([x1 * cos - x2 * sin, x2 * cos + x1 * sin], axis=-1)


def alibi_slopes(n):
    return 2.0 ** (-8.0 * jnp.arange(1, n + 1, dtype=jnp.float32) / n)


def dilated_window_branch(q, k, v, slopes, window, dilation):
    B, T, H, C = q.shape
    d = dilation
    R = window // (2 * d)
    U = T // d
    nb = -(-U // R)
    Up = nb * R

    def to_classes(x):
        x = x.reshape(B, U, d, H, C)
        return jnp.pad(x, ((0, 0), (0, Up - U), (0, 0), (0, 0), (0, 0)))

    def band(x):
        xp = jnp.pad(to_classes(x), ((0, 0), (R, R), (0, 0), (0, 0), (0, 0)))
        xp = xp.reshape(B, nb + 2, R, d, H, C)
        return jnp.concatenate([xp[:, :-2], xp[:, 1:-1], xp[:, 2:]], axis=2)

    qc = to_classes(q).reshape(B, nb, R, d, H, C)
    kb, vb = band(k), band(v)
    s = jnp.einsum('bnqrhc,bnkrhc->bnrhqk', qc, kb).astype(jnp.float32)
    qi = jnp.arange(R)[:, None]
    ki = jnp.arange(3 * R)[None, :]
    diff = ki - R - qi
    u_key = (jnp.arange(nb)[:, None, None] - 1) * R + ki[None]
    valid = (jnp.abs(diff)[None] <= R) & (u_key >= 0) & (u_key < U)
    dist = (d * jnp.abs(diff)).astype(jnp.float32)
    s = s - slopes[:, None, None] * dist[None]
    s = jnp.where(valid[None, :, None, None], s, NEG_INF)
    m = jnp.max(s, axis=-1)
    p = jnp.exp(s - m[..., None])
    z = jnp.sum(p, axis=-1)
    o = jnp.einsum('bnrhqk,bnkrhc->bnqrhc', p, vb.astype(jnp.float32))
    m = jnp.transpose(m, (0, 1, 4, 2, 3)).reshape(B, Up * d, H)[:, :T]
    z = jnp.transpose(z, (0, 1, 4, 2, 3)).reshape(B, Up * d, H)[:, :T]
    o = o.reshape(B, Up * d, H, C)[:, :T]
    return m, z, o


def block_attention(q, k, v, scale):
    B, T, KH, G, C = q.shape
    nq = T // Q_BLOCK
    qb = jnp.moveaxis(q.reshape(B, nq, Q_BLOCK, KH, G, C), 1, 0)

    def one(qblk):
        s = jnp.einsum('bqhgc,bkhc->bhgqk', qblk, k).astype(jnp.float32) * scale
        p = jax.nn.softmax(s, axis=-1).astype(v.dtype)
        return jnp.einsum('bhgqk,bkhc->bqhgc', p, v)

    o = lax.map(one, qb)
    return jnp.moveaxis(o, 0, 1).reshape(B, T, KH * G, v.shape[-1])


def even_layer(x, g_pre, g_post, w_in, q_a_norm, w_uq, kv_a_norm, w_ukv, w_out):
    B, T, _ = x.shape
    h = rms_norm(x, g_pre)
    proj = jnp.einsum('btd,de->bte', h, w_in)
    qa, ka, va, cq, ckv, kr, gate = jnp.split(proj, SPLIT_AB, axis=-1)
    shp = (B, T, A_HEADS, A_HEAD_DIM)
    qa = qa.reshape(shp) * (A_HEAD_DIM ** -0.5)
    ka = ka.reshape(shp)
    va = va.reshape(shp)
    slopes = alibi_slopes(A_HEADS)
    stats = [dilated_window_branch(qa, ka, va, slopes, wdw, dil) for wdw, dil in DILATED_CONFIGS]
    m_all = jnp.stack([st[0] for st in stats])
    z_all = jnp.stack([st[1] for st in stats])
    o_all = jnp.stack([st[2] for st in stats])
    wts = jnp.exp(m_all - jnp.max(m_all, axis=0, keepdims=True))
    z = jnp.sum(z_all * wts, axis=0)
    o_a = jnp.sum(o_all * wts[..., None], axis=0) / z[..., None]
    out_a = o_a.astype(x.dtype).reshape(B, T, A_WIDTH)
    pos = jnp.arange(T, dtype=jnp.float32)
    cq = rms_norm(cq, q_a_norm)
    qb = jnp.einsum('btr,re->bte', cq, w_uq).reshape(B, T, MLA_HEADS, MLA_NOPE_DIM + MLA_ROPE_DIM)
    q_nope, q_rope = qb[..., :MLA_NOPE_DIM], qb[..., MLA_NOPE_DIM:]
    q_b = jnp.concatenate([q_nope, rope(q_rope, pos)], axis=-1)
    ckv = rms_norm(ckv, kv_a_norm)
    kv = jnp.einsum('btr,re->bte', ckv, w_ukv).reshape(B, T, MLA_HEADS, MLA_NOPE_DIM + MLA_V_DIM)
    k_nope, v_b = kv[..., :MLA_NOPE_DIM], kv[..., MLA_NOPE_DIM:]
    k_rope = jnp.broadcast_to(rope(kr[:, :, None, :], pos), (B, T, MLA_HEADS, MLA_ROPE_DIM))
    k_b = jnp.concatenate([k_nope, k_rope], axis=-1)
    out_b = block_attention(q_b[:, :, :, None, :], k_b, v_b,
                            (MLA_NOPE_DIM + MLA_ROPE_DIM) ** -0.5).reshape(B, T, B_WIDTH)
    y = jnp.concatenate([out_a, out_b], axis=-1) * jax.nn.silu(gate)
    y = jnp.einsum('bte,ed->btd', y, w_out)
    return x + rms_norm(y, g_post)


def odd_layer(x, g_pre, g_post, w_in, q_norm, k_norm, w_out):
    B, T, _ = x.shape
    n_rows = T // GRID_W
    rows = jnp.repeat(jnp.arange(n_rows, dtype=jnp.float32), GRID_W)
    cols = jnp.tile(jnp.arange(GRID_W, dtype=jnp.float32), n_rows)
    half = C_HEAD_DIM // 2
    h = rms_norm(x, g_pre)
    proj = jnp.einsum('btd,de->bte', h, w_in)
    q, k, v, gate = jnp.split(proj, SPLIT_C, axis=-1)
    q = rms_norm(q.reshape(B, T, C_HEADS, C_HEAD_DIM), q_norm)
    k = rms_norm(k.reshape(B, T, C_KV_HEADS, C_HEAD_DIM), k_norm)
    v = v.reshape(B, T, C_KV_HEADS, C_HEAD_DIM)
    q = jnp.concatenate([rope(q[..., :half], rows), rope(q[..., half:], cols)], axis=-1)
    k = jnp.concatenate([rope(k[..., :half], rows), rope(k[..., half:], cols)], axis=-1)
    q = q.reshape(B, T, C_KV_HEADS, C_HEADS // C_KV_HEADS, C_HEAD_DIM)
    o = block_attention(q, k, v, C_HEAD_DIM ** -0.5).reshape(B, T, C_WIDTH)
    y = jnp.einsum('bte,ed->btd', o * jax.nn.silu(gate), w_out)
    return x + rms_norm(y, g_post)


def trunk(x, norm_pre, norm_post, w_in_ab, mla_q_norm, w_uq, mla_kv_norm, w_ukv, w_out_ab,
          w_in_c, c_q_norm, c_k_norm, w_out_c):
    for layer in range(DEPTH):
        i = layer // 2
        if layer % 2 == 0:
            x = even_layer(x, norm_pre[layer], norm_post[layer], w_in_ab[i], mla_q_norm[i], w_uq[i],
                           mla_kv_norm[i], w_ukv[i], w_out_ab[i])
        else:
            x = odd_layer(x, norm_pre[layer], norm_post[layer], w_in_c[i], c_q_norm[i], c_k_norm[i], w_out_c[i])
    return x


def setup_inputs(seed: int = 0) -> dict:
    key = jax.random.key(seed)
    ks = jax.random.split(key, 16)

    def w(k, shape, fan_in):
        return jax.random.normal(k, shape, jnp.float32) * (fan_in ** -0.5)

    def gain(k, shape):
        return 1.0 + 0.05 * jax.random.normal(k, shape, jnp.float32)

    return {
        "x_prompt": jax.random.normal(ks[0], (BATCH, SEQ, D_MODEL), jnp.float32),
        "x_sample": jax.random.normal(ks[1], (DEC_BATCH, DEC_SEQ, D_MODEL), jnp.float32),
        "norm_pre": gain(ks[2], (DEPTH, D_MODEL)),
        "norm_post": gain(ks[3], (DEPTH, D_MODEL)),
        "w_in_ab": w(ks[4], (N_EVEN_LAYERS, D_MODEL, IN_AB), D_MODEL),
        "mla_q_norm": gain(ks[5], (N_EVEN_LAYERS, MLA_Q_RANK)),
        "w_uq": w(ks[6], (N_EVEN_LAYERS, MLA_Q_RANK, MLA_HEADS * (MLA_NOPE_DIM + MLA_ROPE_DIM)), MLA_Q_RANK),
        "mla_kv_norm": gain(ks[7], (N_EVEN_LAYERS, MLA_KV_RANK)),
        "w_ukv": w(ks[8], (N_EVEN_LAYERS, MLA_KV_RANK, MLA_HEADS * (MLA_NOPE_DIM + MLA_V_DIM)), MLA_KV_RANK),
        "w_out_ab": w(ks[9], (N_EVEN_LAYERS, AB_WIDTH, D_MODEL), AB_WIDTH),
        "w_in_c": w(ks[10], (N_ODD_LAYERS, D_MODEL, IN_C), D_MODEL),
        "c_q_norm": gain(ks[11], (N_ODD_LAYERS, C_HEAD_DIM)),
        "c_k_norm": gain(ks[12], (N_ODD_LAYERS, C_HEAD_DIM)),
        "w_out_c": w(ks[13], (N_ODD_LAYERS, C_WIDTH, D_MODEL), C_WIDTH),
    }


def reference(x_prompt, x_sample, norm_pre, norm_post, w_in_ab, mla_q_norm, w_uq, mla_kv_norm, w_ukv,
              w_out_ab, w_in_c, c_q_norm, c_k_norm, w_out_c):
    y_prompt = trunk(x_prompt, norm_pre, norm_post, w_in_ab, mla_q_norm, w_uq, mla_kv_norm, w_ukv,
                     w_out_ab, w_in_c, c_q_norm, c_k_norm, w_out_c)
    y_sample = trunk(x_sample, norm_pre, norm_post, w_in_ab, mla_q_norm, w_uq, mla_kv_norm, w_ukv,
                     w_out_ab, w_in_c, c_q_norm, c_k_norm, w_out_c)
    return (y_prompt, y_sample)
```

```cpp
#include <hip/hip_runtime.h>
#include <hip/hip_cooperative_groups.h>
#include <cstdint>
#include <cstdio>
namespace cg = cooperative_groups;

#ifndef N_LAUNCH_MODE
#define N_LAUNCH_MODE 1
#endif

typedef unsigned short bf16_t;
typedef short bf16x8 __attribute__((ext_vector_type(8)));
typedef float f32x16 __attribute__((ext_vector_type(16)));
typedef float f32x4 __attribute__((ext_vector_type(4)));
typedef float f32x2 __attribute__((ext_vector_type(2)));
typedef unsigned u32x4 __attribute__((ext_vector_type(4)));
typedef unsigned u32x2 __attribute__((ext_vector_type(2)));
typedef __bf16 bf16x2_t __attribute__((ext_vector_type(2)));
typedef short s16x4 __attribute__((ext_vector_type(4)));

#define DI __device__ __forceinline__
#define MFMA32(a, b, c) __builtin_amdgcn_mfma_f32_32x32x16_bf16((a), (b), (c), 0, 0, 0)

constexpr int M_TOK = 81920, M_PROMPT = 16384;
constexpr int N_AB = 2976, N_C = 2560;
constexpr int LD0 = 1440;
constexpr float EPS = 1e-6f;
constexpr float LOG2E = 1.4426950408889634f;
constexpr int LDS_BYTES = 147456;

struct Params {
  const float *x_prompt, *x_sample, *norm_pre, *norm_post, *w_in_ab, *mla_q_norm, *w_uq, *mla_kv_norm, *w_ukv,
      *w_out_ab, *w_in_c, *c_q_norm, *c_k_norm, *w_out_c;
  float* out;
  bf16_t *wt_in_ab, *wt_out_ab, *wt_in_c, *wt_out_c, *wt_uq, *wt_ukv;
  float2* rope;
  bf16_t *h;
  bf16_t *proj;
  bf16_t *qb;
  bf16_t *knope;
  bf16_t *vbT;
  bf16_t *krope;
  bf16_t *v1T;
  bf16_t *yout1;
  bf16_t *pA;
  float *lse;
  bf16_t *qkva;
  float *rss_q, *rss_kv;
};

DI unsigned pk_bf16(float lo, float hi) {
  f32x2 v = {lo, hi};
  bf16x2_t b = __builtin_convertvector(v, bf16x2_t);
  return __builtin_bit_cast(unsigned, b);
}
DI bf16_t f2bf(float x) { return (bf16_t)(pk_bf16(x, 0.f) & 0xffffu); }
DI float bflo(unsigned u) { return __uint_as_float(u << 16); }
DI float bfhi(unsigned u) { return __uint_as_float(u & 0xffff0000u); }
DI float bf2f(bf16_t v) { return __uint_as_float(((unsigned)v) << 16); }
DI float silu_f(float v) { return v * __builtin_amdgcn_rcpf(1.f + __builtin_amdgcn_exp2f(-v * LOG2E)); }
DI float wave_sum(float v) {
  v += __shfl_xor(v, 32); v += __shfl_xor(v, 16); v += __shfl_xor(v, 8);
  v += __shfl_xor(v, 4); v += __shfl_xor(v, 2); v += __shfl_xor(v, 1);
  return v;
}
DI int fresh_tid() { int t = threadIdx.x; asm volatile("" : "+v"(t)); return t; }
DI float fmax_nc(float a, float b) { return __builtin_amdgcn_fmed3f(a, b, __builtin_inff()); }
DI int crow(int i, int h) { return (i & 3) + 8 * (i >> 2) + 4 * h; }
DI const float* xrow(const Params& p, int m) {
  return (m < M_PROMPT) ? p.x_prompt + (size_t)m * 1024 : p.x_sample + (size_t)(m - M_PROMPT) * 1024;
}

DI void phase_prep(const Params& p, char* lds) {
  const int tid = fresh_tid(), nblk = gridDim.x, bid = blockIdx.x, lane = tid & 63, wid = __builtin_amdgcn_readfirstlane(tid >> 6);
  float (*tile)[65] = (float (*)[65])lds;
  for (int t0 = bid; t0 < 2000; t0 += nblk) {
    const float* src; bf16_t* dst; int K, N, tt = t0; const float* kg = nullptr;
    if (tt < 768) { src = p.w_in_ab; dst = p.wt_in_ab; K = 1024; N = 2976; }
    else if ((tt -= 768) < 256) { src = p.w_out_ab; dst = p.wt_out_ab; K = 1024; N = 1024; }
    else if ((tt -= 256) < 640) { src = p.w_in_c; dst = p.wt_in_c; K = 1024; N = 2560; }
    else if ((tt -= 640) < 256) { src = p.w_out_c; dst = p.wt_out_c; K = 1024; N = 1024; }
    else if ((tt -= 256) < 48) { src = p.w_uq; dst = p.wt_uq; K = 256; N = 768; kg = p.mla_q_norm; }
    else { tt -= 48; src = p.w_ukv; dst = p.wt_ukv; K = 128; N = 1024; kg = p.mla_kv_norm; }
    const int nkt = K >> 6;
    const int k0 = (tt % nkt) * 64, n0 = (tt / nkt) * 64;
    __syncthreads();
    {
      const int tx = tid & 63, ty = tid >> 6;
#pragma unroll
      for (int i = 0; i < 8; ++i) {
        const int k = ty + 8 * i, n = n0 + tx;
        tile[k][tx] = (n < N) ? src[(size_t)(k0 + k) * N + n] * (kg ? kg[k0 + k] : 1.f) : 0.f;
      }
    }
    __syncthreads();
    {
      const int kx = tid & 63, ny = tid >> 6;
#pragma unroll
      for (int i = 0; i < 8; ++i) {
        const int n = ny + 8 * i;
        dst[(size_t)(n0 + n) * K + k0 + kx] = f2bf(tile[kx][n]);
      }
    }
  }
  for (int e = bid * 512 + tid; e < M_TOK; e += nblk * 512) { p.rss_q[e] = 0.f; p.rss_kv[e] = 0.f; }
  for (int e = bid * 512 + tid; e < 8192 * 16; e += nblk * 512) {
    const int pos = e >> 4, i = e & 15;
    const double freq = exp2(-(double)i * (13.287712379549449 / 16.0));
    const double ang = (double)pos * freq;
    const double kk = rint(ang * 0.15915494309189535);
    const float rf = (float)(ang - kk * 6.283185307179586);
    p.rope[e] = make_float2(cosf(rf), sinf(rf));
  }
  for (int m = bid * 8 + wid; m < M_TOK; m += nblk * 8) {
    const float* xr = xrow(p, m);
    f32x4 v[4]; float ss = 0.f;
#pragma unroll
    for (int i = 0; i < 4; ++i) {
      v[i] = __builtin_nontemporal_load((const f32x4*)(xr + i * 256 + lane * 4));
      ss += v[i][0] * v[i][0] + v[i][1] * v[i][1] + v[i][2] * v[i][2] + v[i][3] * v[i][3];
    }
    ss = wave_sum(ss);
    const float rinv = rsqrtf(ss * (1.f / 1024.f) + EPS);
#pragma unroll
    for (int i = 0; i < 4; ++i) {
      const f32x4 g = *(const f32x4*)(p.norm_pre + i * 256 + lane * 4);
      u32x2 w;
      w[0] = pk_bf16(v[i][0] * rinv * g[0], v[i][1] * rinv * g[1]);
      w[1] = pk_bf16(v[i][2] * rinv * g[2], v[i][3] * rinv * g[3]);
      *(u32x2*)(p.h + (size_t)m * 1024 + i * 256 + lane * 4) = w;
    }
  }
}

template <bool LAST>
DI void phase_postnorm(const Params& p, const bf16_t* yout, const float* gpost, const float* gpre) {
  const int tid = fresh_tid(), nblk = gridDim.x, bid = blockIdx.x, lane = tid & 63, wid = __builtin_amdgcn_readfirstlane(tid >> 6);
  for (int m = bid * 8 + wid; m < M_TOK; m += nblk * 8) {
    const float* xr = LAST ? (const float*)(p.out + (size_t)m * 1024) : xrow(p, m);
    f32x4 y[4], x[4]; float ss = 0.f;
#pragma unroll
    for (int i = 0; i < 4; ++i) {
      const u32x2 w = __builtin_nontemporal_load((const u32x2*)(yout + (size_t)m * 1024 + i * 256 + lane * 4));
      y[i][0] = bflo(w[0]); y[i][1] = bfhi(w[0]); y[i][2] = bflo(w[1]); y[i][3] = bfhi(w[1]);
      x[i] = __builtin_nontemporal_load((const f32x4*)(xr + i * 256 + lane * 4));
      ss += y[i][0] * y[i][0] + y[i][1] * y[i][1] + y[i][2] * y[i][2] + y[i][3] * y[i][3];
    }
    ss = wave_sum(ss);
    const float rinv = rsqrtf(ss * (1.f / 1024.f) + EPS);
    float ss2 = 0.f;
#pragma unroll
    for (int i = 0; i < 4; ++i) {
      const f32x4 g = *(const f32x4*)(gpost + i * 256 + lane * 4);
#pragma unroll
      for (int j = 0; j < 4; ++j) { x[i][j] = x[i][j] + y[i][j] * rinv * g[j]; ss2 += x[i][j] * x[i][j]; }
      __builtin_nontemporal_store(x[i], (f32x4*)(p.out + (size_t)m * 1024 + i * 256 + lane * 4));
    }
    if (!LAST) {
      ss2 = wave_sum(ss2);
      const float rinv2 = rsqrtf(ss2 * (1.f / 1024.f) + EPS);
#pragma unroll
      for (int i = 0; i < 4; ++i) {
        const f32x4 g = *(const f32x4*)(gpre + i * 256 + lane * 4);
        u32x2 w;
        w[0] = pk_bf16(x[i][0] * rinv2 * g[0], x[i][1] * rinv2 * g[1]);
        w[1] = pk_bf16(x[i][2] * rinv2 * g[2], x[i][3] * rinv2 * g[3]);
        *(u32x2*)(p.h + (size_t)m * 1024 + i * 256 + lane * 4) = w;
      }
    }
  }
}

DI void phase_mlanorm(const Params& p) {
  const int tid = fresh_tid(), nblk = gridDim.x, bid = blockIdx.x, lane = tid & 63, wid = __builtin_amdgcn_readfirstlane(tid >> 6);
  for (int m = bid * 8 + wid; m < M_TOK; m += nblk * 8) {
    bf16_t* pr = p.proj + (size_t)m * LD0 - 1536;
    const int T = (m < M_PROMPT) ? 8192 : 4096, t = m & (T - 1);
    {
      const u32x2 w = *(const u32x2*)(pr + 1536 + lane * 4);
      float v0 = bflo(w[0]), v1 = bfhi(w[0]), v2 = bflo(w[1]), v3 = bfhi(w[1]);
      float ss = wave_sum(v0 * v0 + v1 * v1 + v2 * v2 + v3 * v3);
      const float rinv = rsqrtf(ss * (1.f / 256.f) + EPS);
      const f32x4 g = *(const f32x4*)(p.mla_q_norm + lane * 4);
      u32x2 o; o[0] = pk_bf16(v0 * rinv * g[0], v1 * rinv * g[1]); o[1] = pk_bf16(v2 * rinv * g[2], v3 * rinv * g[3]);
      *(u32x2*)(pr + 1536 + lane * 4) = o;
    }
    {
      const unsigned w = *(const unsigned*)(pr + 1792 + lane * 2);
      float v0 = bflo(w), v1 = bfhi(w);
      float ss = wave_sum(v0 * v0 + v1 * v1);
      const float rinv = rsqrtf(ss * (1.f / 128.f) + EPS);
      const f32x2 g = *(const f32x2*)(p.mla_kv_norm + lane * 2);
      *(unsigned*)(pr + 1792 + lane * 2) = pk_bf16(v0 * rinv * g[0], v1 * rinv * g[1]);
    }
    {
      const float xv = bf2f(pr[1920 + (lane & 31)]);
      const float pv = __shfl_xor(xv, 16);
      const float2 cs = p.rope[t * 16 + (lane & 15)];
      const float o = (lane & 16) ? (xv * cs.x + pv * cs.y) : (xv * cs.x - pv * cs.y);
      if (lane < 32) p.krope[(size_t)m * 32 + lane] = f2bf(o);
    }
  }
}

#define LAS __attribute__((address_space(3)))
#define GAS __attribute__((address_space(1)))
DI void g8_stage_rc(int b, int& R, int& C) {
  const int st = b / 1024, sb = b % 1024, swz = sb ^ (((sb >> 9) & 1) << 5);
  R = (st >> 1) * 16 + swz / 64; C = (st & 1) * 32 + (swz % 64) / 2;
}
DI void g8_tile(int L, int nM, int nN, int& pm, int& pn) {
  const int nwg = nM * nN, q = nwg / 8, r = nwg % 8, xcd = L % 8, off = L / 8;
  const int wg = (xcd < r ? xcd * (q + 1) : r * (q + 1) + (xcd - r) * q) + off;
  const int nig = 8 * nN, gid = wg / nig, fm = gid * 8, gsz = (nM - fm) < 8 ? (nM - fm) : 8;
  pm = fm + (wg % nig) % gsz; pn = (wg % nig) / gsz;
}
DI void st4(bf16_t* dst, const f32x4& v) {
  u32x2 w; w[0] = pk_bf16(v[0], v[1]); w[1] = pk_bf16(v[2], v[3]);
  *(u32x2*)dst = w;
}

template <int EPI>
DI void gemm_epilogue(const Params& p, f32x4 (&acc)[2][2][4][2], int m0, int n0, int wr, int wc, int fr, int fq) {
#pragma unroll
  for (int bj = 0; bj < 2; ++bj)
#pragma unroll
    for (int ni = 0; ni < 2; ++ni) {
      const int m = m0 + bj * 128 + wc * 32 + ni * 16 + fr;
      const int T = (m < M_PROMPT) ? 8192 : 4096, t = m & (T - 1);
      float ssq = 0.f;
#pragma unroll
      for (int ai = 0; ai < 2; ++ai) {
        const int nb = n0 + ai * 128 + wr * 64;
        if (EPI == 0) {
#pragma unroll
          for (int mi = 0; mi < 4; ++mi) {
            const int n = nb + mi * 16 + fq * 4;
            if (n < 1536) {
              st4(p.qkva + ((size_t)(n >> 6) * M_TOK + m) * 64 + (n & 63), acc[ai][bj][mi][ni]);
            } else if (n < N_AB) {
              f32x4 v = acc[ai][bj][mi][ni];
              if (n >= 1952) { v[0] = silu_f(v[0]); v[1] = silu_f(v[1]); v[2] = silu_f(v[2]); v[3] = silu_f(v[3]); }
              if (n < 1920 || n >= 1952) st4(p.proj + (size_t)m * LD0 + (n - 1536), v);
            }
          }
          if (nb >= 1536 && nb < 1920) {
#pragma unroll
            for (int mi = 0; mi < 4; ++mi)
#pragma unroll
              for (int j = 0; j < 4; ++j) { const float v = acc[ai][bj][mi][ni][j]; ssq += v * v; }
          } else if (nb == 1920) {
            const f32x4* rp = (const f32x4*)(p.rope + t * 16 + fq * 4);
            const f32x4 r0 = rp[0], r1 = rp[1];
            const float cs[4] = {r0[0], r0[2], r1[0], r1[2]}, sn[4] = {r0[1], r0[3], r1[1], r1[3]};
            f32x4 y1, y2;
#pragma unroll
            for (int j = 0; j < 4; ++j) {
              const float x1 = acc[ai][bj][0][ni][j], x2 = acc[ai][bj][1][ni][j];
              y1[j] = x1 * cs[j] - x2 * sn[j];
              y2[j] = x2 * cs[j] + x1 * sn[j];
            }
            st4(p.krope + (size_t)m * 32 + fq * 4, y1);
            st4(p.krope + (size_t)m * 32 + 16 + fq * 4, y2);
          }
        } else if (EPI == 1) {
          {
            const float rinv = rsqrtf(p.rss_q[m] * (1.f / 256.f) + EPS);
#pragma unroll
            for (int mi = 0; mi < 4; ++mi) acc[ai][bj][mi][ni] *= rinv;
          }
#pragma unroll
          for (int blk = 0; blk < 2; ++blk) {
            const int nblk = nb + 32 * blk;
            if (((nblk >> 5) % 3) == 2) {
              const f32x4* rp = (const f32x4*)(p.rope + t * 16 + fq * 4);
              const f32x4 r0 = rp[0], r1 = rp[1];
              const float cs[4] = {r0[0], r0[2], r1[0], r1[2]}, sn[4] = {r0[1], r0[3], r1[1], r1[3]};
#pragma unroll
              for (int j = 0; j < 4; ++j) {
                const float x1 = acc[ai][bj][2 * blk][ni][j], x2 = acc[ai][bj][2 * blk + 1][ni][j];
                acc[ai][bj][2 * blk][ni][j] = x1 * cs[j] - x2 * sn[j];
                acc[ai][bj][2 * blk + 1][ni][j] = x2 * cs[j] + x1 * sn[j];
              }
            }
          }
#pragma unroll
          for (int mi = 0; mi < 4; ++mi) st4(p.qb + (size_t)m * 768 + nb + mi * 16 + fq * 4, acc[ai][bj][mi][ni]);
        } else if (EPI == 2) {
          {
            const float rinv = rsqrtf(p.rss_kv[m] * (1.f / 128.f) + EPS);
#pragma unroll
            for (int mi = 0; mi < 4; ++mi) acc[ai][bj][mi][ni] *= rinv;
          }
          const int hh = (n0 + ai * 128) >> 7;
          if (wr == 0) {
#pragma unroll
            for (int mi = 0; mi < 4; ++mi) st4(p.knope + (size_t)m * 512 + hh * 64 + mi * 16 + fq * 4, acc[ai][bj][mi][ni]);
          } else {
            bf16_t* vb = p.vbT + (size_t)(m - t) * 512 + t;
#pragma unroll
            for (int mi = 0; mi < 4; ++mi)
#pragma unroll
              for (int j = 0; j < 4; ++j) vb[(size_t)(hh * 64 + mi * 16 + fq * 4 + j) * T] = f2bf(acc[ai][bj][mi][ni][j]);
          }
        } else if (EPI == 3 || EPI == 5) {
          bf16_t* dst = (EPI == 3) ? p.proj : p.yout1;
#pragma unroll
          for (int mi = 0; mi < 4; ++mi) st4(dst + (size_t)m * 1024 + nb + mi * 16 + fq * 4, acc[ai][bj][mi][ni]);
        } else if (EPI == 4) {
          if (n0 < 1280) {
            const float* gain = (n0 < 1024) ? p.c_q_norm : p.c_k_norm;
            float ss = 0.f;
#pragma unroll
            for (int mi = 0; mi < 4; ++mi)
#pragma unroll
              for (int j = 0; j < 4; ++j) { const float v = acc[ai][bj][mi][ni][j]; ss += v * v; }
            ss += __shfl_xor(ss, 16);
            ss += __shfl_xor(ss, 32);
            const float rinv = rsqrtf(ss * (1.f / 64.f) + EPS);
#pragma unroll
            for (int blk = 0; blk < 2; ++blk) {
              const int pos = (blk == 0) ? (t >> 6) : (t & 63);
              const f32x4* rp = (const f32x4*)(p.rope + pos * 16 + fq * 4);
              const f32x4 r0 = rp[0], r1 = rp[1];
              const float cs[4] = {r0[0], r0[2], r1[0], r1[2]}, sn[4] = {r0[1], r0[3], r1[1], r1[3]};
              const f32x4 g1 = *(const f32x4*)(gain + blk * 32 + fq * 4), g2 = *(const f32x4*)(gain + blk * 32 + 16 + fq * 4);
#pragma unroll
              for (int j = 0; j < 4; ++j) {
                const float x1 = acc[ai][bj][2 * blk][ni][j] * rinv * g1[j], x2 = acc[ai][bj][2 * blk + 1][ni][j] * rinv * g2[j];
                acc[ai][bj][2 * blk][ni][j] = x1 * cs[j] - x2 * sn[j];
                acc[ai][bj][2 * blk + 1][ni][j] = x2 * cs[j] + x1 * sn[j];
              }
            }
#pragma unroll
            for (int mi = 0; mi < 4; ++mi) st4(p.proj + (size_t)m * N_C + nb + mi * 16 + fq * 4, acc[ai][bj][mi][ni]);
          } else if (n0 < 1536) {
            bf16_t* vb = p.v1T + (size_t)(m - t) * 256 + t;
#pragma unroll
            for (int mi = 0; mi < 4; ++mi)
#pragma unroll
              for (int j = 0; j < 4; ++j) vb[(size_t)(nb - 1280 + mi * 16 + fq * 4 + j) * T] = f2bf(acc[ai][bj][mi][ni][j]);
          } else {
#pragma unroll
            for (int mi = 0; mi < 4; ++mi) {
              f32x4 v = acc[ai][bj][mi][ni];
              v[0] = silu_f(v[0]); v[1] = silu_f(v[1]); v[2] = silu_f(v[2]); v[3] = silu_f(v[3]);
              st4(p.proj + (size_t)m * N_C + nb + mi * 16 + fq * 4, v);
            }
          }
        }
      }
      if (EPI == 0 && (n0 == 1536 || n0 == 1792)) {
        ssq += __shfl_xor(ssq, 16);
        ssq += __shfl_xor(ssq, 32);
        if (fq == 0) atomicAdd((n0 == 1536) ? p.rss_q + m : p.rss_kv + m, ssq);
      }
    }
}

template <int EPI>
DI void gemm_tile(const Params& p, const bf16_t* __restrict__ X, int ldx, const bf16_t* __restrict__ Wt, int K,
                  int m0, int n0, char* lds) {
  constexpr int HTB = 16384;
  const int tid = fresh_tid(), lane = tid & 63, wid = __builtin_amdgcn_readfirstlane(tid >> 6);
  const int wr = wid >> 2, wc = wid & 3, fr = lane & 15, fq = lane >> 4;
  f32x4 acc[2][2][4][2];
#pragma unroll
  for (int a = 0; a < 2; ++a)
#pragma unroll
    for (int b = 0; b < 2; ++b)
#pragma unroll
      for (int c = 0; c < 4; ++c)
#pragma unroll
        for (int d = 0; d < 2; ++d) acc[a][b][c][d] = (f32x4){0.f, 0.f, 0.f, 0.f};
  bf16x8 At[4][2], B0[2][2], B1[2][2];
  int sr0, sc0, sr1, sc1;
  g8_stage_rc(tid * 16, sr0, sc0);
  g8_stage_rc(tid * 16 + 8192, sr1, sc1);
  const unsigned gw0 = (unsigned)(sr0 * K + sc0) * 2u, gw1 = (unsigned)(sr1 * K + sc1) * 2u, gx0 = (unsigned)(sr0 * ldx + sc0) * 2u, gx1 = (unsigned)(sr1 * ldx + sc1) * 2u;
  const bf16_t* wbase = Wt + (size_t)n0 * K;
  const bf16_t* xbase = X + (size_t)m0 * ldx;
  const int lw = tid * 16;
  const int lo = (fr * 64 + fq * 16) ^ ((fr >> 3) << 5);
  const int la = wr * 8 * 1024 + lo, lb = wc * 4 * 1024 + lo;
#define SA(b, h) (lds + ((b) * 2 + (h)) * HTB)
#define SB(b, h) (lds + (4 + (b) * 2 + (h)) * HTB)
#define STAGE_W(P, half, kt) do { const bf16_t* g_ = wbase + (size_t)(half) * 128 * K + (kt) * 64; \
    __builtin_amdgcn_global_load_lds((const GAS unsigned*)((const char*)g_ + gw0), (LAS unsigned*)((P) + lw), 16, 0, 0); \
    __builtin_amdgcn_global_load_lds((const GAS unsigned*)((const char*)g_ + gw1), (LAS unsigned*)((P) + lw + 8192), 16, 0, 0); } while (0)
#define STAGE_X(P, half, kt) do { const bf16_t* g_ = xbase + (size_t)(half) * 128 * ldx + (kt) * 64; \
    __builtin_amdgcn_global_load_lds((const GAS unsigned*)((const char*)g_ + gx0), (LAS unsigned*)((P) + lw), 16, 0, 0); \
    __builtin_amdgcn_global_load_lds((const GAS unsigned*)((const char*)g_ + gx1), (LAS unsigned*)((P) + lw + 8192), 16, 0, 0); } while (0)
#define LDA(dst, b, h) _Pragma("unroll") for (int m_ = 0; m_ < 4; ++m_) _Pragma("unroll") for (int k_ = 0; k_ < 2; ++k_) \
    dst[m_][k_] = *(const bf16x8*)(SA(b, h) + la + (m_ * 2 + k_) * 1024)
#define LDB(dst, b, h) _Pragma("unroll") for (int n_ = 0; n_ < 2; ++n_) _Pragma("unroll") for (int k_ = 0; k_ < 2; ++k_) \
    dst[n_][k_] = *(const bf16x8*)(SB(b, h) + lb + (n_ * 2 + k_) * 1024)
#define MMA(ai, bj, Af, Bf) do { __builtin_amdgcn_s_setprio(1); \
    _Pragma("unroll") for (int m_ = 0; m_ < 4; ++m_) _Pragma("unroll") for (int n_ = 0; n_ < 2; ++n_) _Pragma("unroll") for (int k_ = 0; k_ < 2; ++k_) \
      acc[ai][bj][m_][n_] = __builtin_amdgcn_mfma_f32_16x16x32_bf16(Af[m_][k_], Bf[n_][k_], acc[ai][bj][m_][n_], 0, 0, 0); \
    __builtin_amdgcn_s_setprio(0); } while (0)
#define WAIT_V(n) asm volatile("s_waitcnt vmcnt(" #n ")" ::: "memory")
#define WAIT_L(n) asm volatile("s_waitcnt lgkmcnt(" #n ")" ::: "memory")
#define BAR __builtin_amdgcn_s_barrier()
#define SCHED __builtin_amdgcn_sched_barrier(0)
  const int nt = K >> 6;
  STAGE_X(SB(0, 0), 0, 0); STAGE_W(SA(0, 0), 0, 0);
  STAGE_X(SB(0, 1), 1, 0); STAGE_W(SA(0, 1), 1, 0);
  if (wr == 1) BAR;
  WAIT_V(4); BAR;
  STAGE_X(SB(1, 0), 0, 1); STAGE_W(SA(1, 0), 0, 1); STAGE_X(SB(1, 1), 1, 1);
  WAIT_V(6); BAR;
  for (int t = 0; t < nt - 2; t += 2) {
    LDB(B0, 0, 0); SCHED; LDA(At, 0, 0); STAGE_W(SA(1, 1), 1, t + 1);
    WAIT_L(8); BAR; WAIT_L(0); MMA(0, 0, At, B0); BAR; SCHED;
    LDB(B1, 0, 1); STAGE_X(SB(0, 0), 0, t + 2);
    BAR; WAIT_L(0); MMA(0, 1, At, B1); BAR;
    LDA(At, 0, 1); STAGE_W(SA(0, 0), 0, t + 2);
    BAR; WAIT_L(0); MMA(1, 0, At, B0); BAR; SCHED;
    STAGE_X(SB(0, 1), 1, t + 2);
    WAIT_V(6); BAR; MMA(1, 1, At, B1); BAR;
    LDB(B0, 1, 0); SCHED; LDA(At, 1, 0); STAGE_W(SA(0, 1), 1, t + 2);
    WAIT_L(8); BAR; WAIT_L(0); MMA(0, 0, At, B0); BAR; SCHED;
    LDB(B1, 1, 1); STAGE_X(SB(1, 0), 0, t + 3);
    BAR; WAIT_L(0); MMA(0, 1, At, B1); BAR;
    LDA(At, 1, 1); STAGE_W(SA(1, 0), 0, t + 3);
    BAR; WAIT_L(0); MMA(1, 0, At, B0); BAR; SCHED;
    STAGE_X(SB(1, 1), 1, t + 3);
    WAIT_V(6); BAR; MMA(1, 1, At, B1); BAR;
  }
  { LDB(B0, 0, 0); LDA(At, 0, 0); STAGE_W(SA(1, 1), 1, nt - 1);
    BAR; WAIT_L(0); MMA(0, 0, At, B0); BAR;
    LDB(B1, 0, 1); BAR; WAIT_L(0); MMA(0, 1, At, B1); BAR;
    LDA(At, 0, 1); WAIT_V(4); BAR; WAIT_L(0); MMA(1, 0, At, B0); MMA(1, 1, At, B1); BAR; }
  { LDB(B0, 1, 0); LDA(At, 1, 0); WAIT_V(2); BAR; WAIT_L(0); MMA(0, 0, At, B0); BAR;
    LDB(B1, 1, 1); WAIT_V(0); BAR; WAIT_L(0); MMA(0, 1, At, B1); BAR;
    LDA(At, 1, 1); BAR; WAIT_L(0); MMA(1, 0, At, B0); MMA(1, 1, At, B1); BAR; }
  if (wr == 0) BAR;
  gemm_epilogue<EPI>(p, acc, m0, n0, wr, wc, fr, fq);
  __syncthreads();
#undef SA
#undef SB
#undef STAGE_W
#undef STAGE_X
#undef LDA
#undef LDB
#undef MMA
#undef WAIT_V
#undef WAIT_L
#undef BAR
#undef SCHED
}

template <int MODE>
DI void attn_unit(const Params& p, int u, char* lds) {
  constexpr int DQK = (MODE == 0) ? 96 : 64;
  constexpr int NC = DQK / 16;
  constexpr int KSTR = DQK * 2 + 16;
  constexpr int KTILE = 64 * KSTR;
  constexpr int VSTR = 144, VTILE = 64 * VSTR;
  const int tid = fresh_tid(), lane = tid & 63, wid = __builtin_amdgcn_readfirstlane(tid >> 6), ql = lane & 31, h = lane >> 5;

  int T, seq_row0, hh, qblk = 0, kvh = 0;
  int dd = 1, cls = 0, u0 = 0, cfg = 0, U = 0, NB = 1;
  if (MODE == 0) {
    if (u < 512) { const int x = u & 7, j = (u >> 3) & 31, r = u >> 8, g = r * 8 + x;
      T = 8192; hh = g & 7; qblk = j; seq_row0 = (g >> 3) * 8192; }
    else { const int v = u - 512, x = v & 7, j = (v >> 3) & 31, r = v >> 8, g = (r * 8 + x) * 2 + (j >> 4);
      T = 4096; hh = g & 7; qblk = j & 15; seq_row0 = M_PROMPT + (g >> 3) * 4096; }
  } else if (MODE == 1) {
    if (u < 1024) { const int x = u & 7, j = (u >> 3) & 31, r = u >> 8;
      T = 8192; kvh = x & 3; hh = kvh * 4 + r; qblk = j; seq_row0 = (x >> 2) * 8192; }
    else { const int v = u - 1024, x = v & 7, j = (v >> 3) & 31, r = v >> 8, g = 8 * (r >> 1) + x;
      T = 4096; kvh = g & 3; hh = kvh * 4 + (r & 1) * 2 + (j >> 4); qblk = j & 15; seq_row0 = M_PROMPT + (g >> 2) * 4096; }
  } else {
    int r;
    if (u < 512) { T = 8192; seq_row0 = (u >> 8) * 8192; hh = (u >> 5) & 7; r = u & 31;
      if (r < 8) { cfg = 0; cls = 0; NB = 4; u0 = r * 1024; }
      else if (r < 16) { cfg = 1; cls = (r - 8) >> 1; NB = 4; u0 = ((r - 8) & 1) * 1024; }
      else { cfg = 2; cls = r - 16; NB = 2; u0 = 0; } }
    else { const int v = u - 512; T = 4096; seq_row0 = M_PROMPT + (v / 192) * 4096; hh = (v / 24) & 7; r = v % 24;
      if (r < 4) { cfg = 0; cls = 0; NB = 4; u0 = r * 1024; }
      else if (r < 8) { cfg = 1; cls = r - 4; NB = 4; u0 = 0; }
      else { cfg = 2; cls = r - 8; NB = 1; u0 = 0; } }
    dd = 1 << (2 * cfg); U = T >> (2 * cfg);
  }

  int mq = 0;
  bf16x8 qf[NC];
  float c2, slope2 = 0.f;
  if (MODE == 0) c2 = 0.10206207261596577f * LOG2E;
  else c2 = 0.125f * LOG2E;
  if (MODE == 2) slope2 = exp2f(-(float)(hh + 1)) * (float)dd * LOG2E;
  auto load_q = [&](int b) {
    const bf16_t* qp;
    if (MODE == 0) { mq = seq_row0 + qblk * 256 + wid * 32 + ql; qp = p.qb + (size_t)mq * 768 + hh * 96 + 8 * h; }
    else if (MODE == 1) { mq = seq_row0 + qblk * 256 + wid * 32 + ql; qp = p.proj + (size_t)mq * N_C + hh * 64 + 8 * h; }
    else { mq = seq_row0 + (u0 + b * 256 + wid * 32 + ql) * dd + cls; qp = p.proj + (size_t)mq * N_AB + hh * 64 + 8 * h; }
#pragma unroll
    for (int c = 0; c < NC; ++c) {
      u32x4 w = *(const u32x4*)(qp + 16 * c);
#pragma unroll
      for (int j = 0; j < 4; ++j) w[j] = pk_bf16(bflo(w[j]) * c2, bfhi(w[j]) * c2);
      qf[c] = __builtin_bit_cast(bf16x8, w);
    }
  };
  load_q(0);

  int kt_lo = 0, kt_hi;
  if (MODE == 2) { kt_lo = (u0 == 0) ? 0 : -1; kt_hi = (u0 + 256 * NB >= U) ? 4 * NB - 1 : 4 * NB; }
  else kt_hi = (T >> 6) - 1;
  const int n_it = kt_hi - kt_lo + 1;

  unsigned zero_v = 0u;
  asm volatile("" : "+v"(zero_v));
  const u32x4 zero4 = (u32x4){zero_v, zero_v, zero_v, zero_v};
  u32x4 ka0, ka1 = zero4, va, kb0, kb1 = zero4, vb;
  const int key = tid >> 3, kc = tid & 7;
  const int rkey = (tid >> 2) & 63, rc = tid & 3;
  unsigned koffg, roffg = 0, voffg;
  if (MODE == 0) { koffg = (unsigned)(key * 512 + 8 * kc) * 2u; roffg = (unsigned)(rkey * 32 + 8 * rc) * 2u; voffg = (unsigned)(key * T + 8 * kc) * 2u; }
  else if (MODE == 1) { koffg = (unsigned)(key * N_C + 8 * kc) * 2u; voffg = (unsigned)(key * T + 8 * kc) * 2u; }
  else { koffg = (unsigned)(key * dd * N_AB + 8 * kc) * 2u; voffg = koffg; }
  auto gloadK = [&](int kt, u32x4& kr0, u32x4& kr1) {
    if (MODE == 0) {
      const char* kb = (const char*)(p.knope + (size_t)(seq_row0 + 64 * kt) * 512 + hh * 64);
      const char* rb = (const char*)(p.krope + (size_t)(seq_row0 + 64 * kt) * 32);
      kr0 = *(const u32x4*)(kb + koffg);
      if (tid < 256) kr1 = *(const u32x4*)(rb + roffg);
    } else if (MODE == 1) {
      const char* kb = (const char*)(p.proj + (size_t)(seq_row0 + 64 * kt) * N_C + 1024 + kvh * 64);
      kr0 = *(const u32x4*)(kb + koffg);
    } else {
      const char* kb = (const char*)(p.proj + ((size_t)seq_row0 + (size_t)(u0 + 64 * kt) * dd + cls) * N_AB + 512 + hh * 64);
      kr0 = *(const u32x4*)(kb + koffg);
    }
  };
  auto gloadV = [&](int kt, u32x4& vr) {
    if (MODE == 0) {
      const char* vb = (const char*)(p.vbT + (size_t)seq_row0 * 512 + (size_t)(hh * 64) * T + 64 * kt);
      vr = *(const u32x4*)(vb + voffg);
    } else if (MODE == 1) {
      const char* vb = (const char*)(p.v1T + (size_t)seq_row0 * 256 + (size_t)(kvh * 64) * T + 64 * kt);
      vr = *(const u32x4*)(vb + voffg);
    } else {
      const char* vb = (const char*)(p.proj + ((size_t)seq_row0 + (size_t)(u0 + 64 * kt) * dd + cls) * N_AB + 1024 + hh * 64);
      vr = *(const u32x4*)(vb + voffg);
    }
  };
  auto lwriteK = [&](int stg, const u32x4& kr0, const u32x4& kr1) {
    char* ks = lds + stg * KTILE;
    *(u32x4*)(ks + key * KSTR + kc * 16) = kr0;
    if (MODE == 0) { if (tid < 256) *(u32x4*)(ks + rkey * KSTR + 128 + rc * 16) = kr1; }
  };
  auto lwriteV = [&](int slot, const u32x4& vr) {
    char* vs = lds + 3 * KTILE + slot * VTILE;
    if (MODE != 2) {
      *(u32x4*)(vs + key * VSTR + kc * 16) = vr;
    } else {
#pragma unroll
      for (int j = 0; j < 4; ++j) {
        *(bf16_t*)(vs + (8 * kc + 2 * j) * VSTR + key * 2) = (bf16_t)(vr[j] & 0xffffu);
        *(bf16_t*)(vs + (8 * kc + 2 * j + 1) * VSTR + key * 2) = (bf16_t)(vr[j] >> 16);
      }
    }
  };

  f32x16 o0, o1;
#pragma unroll
  for (int i = 0; i < 16; ++i) { o0[i] = 0.f; o1[i] = 0.f; }
  const int sq = (ql & ~12) | ((ql & 4) << 1) | ((ql & 8) >> 1);
  const int koff = sq * KSTR + h * 16, voff = 3 * KTILE + ql * VSTR + h * 16;
  float m_ref = 0.f, l_run = 0.f;
  bool fresh = true;
  bool zref = true;
  int cur_b = (MODE == 2) ? -1 : 0;
  auto qk = [&](int stg, f32x16& s0, f32x16& s1) {
    const char* kp = lds + stg * KTILE + koff;
#pragma unroll
    for (int i = 0; i < 16; ++i) { s0[i] = 0.f; s1[i] = 0.f; }
#pragma unroll
    for (int c = 0; c < NC; ++c) {
      const bf16x8 k0 = *(const bf16x8*)(kp + c * 32);
      const bf16x8 k1 = *(const bf16x8*)(kp + 32 * KSTR + c * 32);
      s0 = MFMA32(k0, qf[c], s0);
      s1 = MFMA32(k1, qf[c], s1);
    }
  };
  auto rowmax = [&](int kt, f32x16& s0, f32x16& s1) -> float {
    float mx = -1e30f;
    if (MODE == 2) {
      const int base = 64 * kt + 8 * h - (256 * cur_b + 32 * wid + ql);
#pragma unroll
      for (int i = 0; i < 16; ++i) {
        const int d0 = base + 16 * (i >> 3) + (i & 7);
        const int d1 = d0 + 32;
        const int a0 = d0 < 0 ? -d0 : d0, a1 = d1 < 0 ? -d1 : d1;
        s0[i] = (a0 <= 64) ? (s0[i] - slope2 * (float)a0) : -1e30f;
        s1[i] = (a1 <= 64) ? (s1[i] - slope2 * (float)a1) : -1e30f;
        mx = fmaxf(mx, fmaxf(s0[i], s1[i]));
      }
    } else {
#pragma unroll
      for (int i = 0; i < 16; ++i) mx = fmaxf(mx, fmaxf(s0[i], s1[i]));
    }
    return fmaxf(mx, __shfl_xor(mx, 32));
  };
  u32x4 pa[2], pb[2];
#pragma unroll
  for (int s = 0; s < 2; ++s) { pa[s] = zero4; pb[s] = zero4; }
  auto pv = [&](int slot) {
    const char* vp = lds + slot * VTILE + voff;
#pragma unroll
    for (int s = 0; s < 2; ++s) {
      const bf16x8 pfa = __builtin_bit_cast(bf16x8, pa[s]), pfb = __builtin_bit_cast(bf16x8, pb[s]);
      const bf16x8 va0 = *(const bf16x8*)(vp + s * 32);
      const bf16x8 va1 = *(const bf16x8*)(vp + 32 * VSTR + s * 32);
      const bf16x8 vb0 = *(const bf16x8*)(vp + 64 + s * 32);
      const bf16x8 vb1 = *(const bf16x8*)(vp + 32 * VSTR + 64 + s * 32);
      o0 = MFMA32(va0, pfa, o0);
      o1 = MFMA32(va1, pfa, o1);
      o0 = MFMA32(vb0, pfb, o0);
      o1 = MFMA32(vb1, pfb, o1);
    }
  };
  auto softmax = [&](f32x16& s0, f32x16& s1, float mxr) {
    const bool upd = fresh ? (__builtin_amdgcn_ballot_w64(fabsf(mxr) > 24.f && mxr > -1e29f) != 0ull)
                           : (__builtin_amdgcn_ballot_w64(mxr - m_ref > 24.f) != 0ull);
    if (upd) {
      const float delta = fresh ? ((mxr > -1e29f) ? mxr : 0.f) : fmaxf(mxr - m_ref, 0.f);
      const float alpha = fresh ? 0.f : __builtin_amdgcn_exp2f(-delta);
      m_ref += delta;
      zref = false;
      l_run *= alpha;
#pragma unroll
      for (int i = 0; i < 16; ++i) { o0[i] *= alpha; o1[i] *= alpha; }
    }
    fresh = false;
    if (!zref) {
#pragma unroll
      for (int i = 0; i < 16; ++i) { s0[i] -= m_ref; s1[i] -= m_ref; }
    }
    float ls = 0.f;
    if (MODE == 2) {
#pragma unroll
      for (int i = 0; i < 16; ++i) {
        s0[i] = (s0[i] > -1e29f) ? __builtin_amdgcn_exp2f(s0[i]) : 0.f;
        s1[i] = (s1[i] > -1e29f) ? __builtin_amdgcn_exp2f(s1[i]) : 0.f;
        ls += s0[i] + s1[i];
      }
    } else {
#pragma unroll
      for (int i = 0; i < 16; ++i) {
        s0[i] = __builtin_amdgcn_exp2f(s0[i]);
        s1[i] = __builtin_amdgcn_exp2f(s1[i]);
        ls += s0[i] + s1[i];
      }
    }
    l_run += ls;
#pragma unroll
    for (int s = 0; s < 2; ++s)
#pragma unroll
      for (int j = 0; j < 4; ++j) {
        pa[s][j] = pk_bf16(s0[8 * s + 2 * j], s0[8 * s + 2 * j + 1]);
        pb[s][j] = pk_bf16(s1[8 * s + 2 * j], s1[8 * s + 2 * j + 1]);
      }
  };
  auto wave_active = [&](int kt) -> bool {
    if (MODE != 2) return true;
    const int wc = wid >> 1;
    return (kt >= wc - 1) && (kt <= wc + 1);
  };
  const bool late = (MODE == 2) ? false : (((wid >> 1) & 1) != 0);

  __syncthreads();
  gloadK(kt_lo, ka0, ka1); gloadV(kt_lo, va);
  lwriteK(0, ka0, ka1); lwriteV(0, va);
  gloadK(kt_lo + 1, ka0, ka1);
  lwriteK(1, ka0, ka1);
  if (MODE != 2) *(u32x4*)(lds + 3 * KTILE + 2 * VTILE + key * VSTR + kc * 16) = zero4;
  gloadK(kt_lo + 2, ka0, ka1);
  gloadV(kt_lo + 1, va);
  __syncthreads();
  f32x16 s0, s1;
#pragma unroll
  for (int i = 0; i < 16; ++i) { s0[i] = 0.f; s1[i] = 0.f; }
  float mx = -1e30f;
  if (late) { qk(0, s0, s1); mx = rowmax(kt_lo, s0, s1); }
  int sl_c = 0;
  auto finalize2 = [&]() {
    const float l_tot = l_run + __shfl_xor(l_run, 32);
    const float inv = 1.f / l_tot;
    bf16_t* dst = p.pA + (size_t)cfg * M_TOK * 512 + (size_t)mq * 512 + hh * 64;
#pragma unroll
    for (int g = 0; g < 4; ++g) {
      const int d = 8 * g + 4 * h;
      u32x2 w0, w1;
      w0[0] = pk_bf16(o0[4 * g] * inv, o0[4 * g + 1] * inv); w0[1] = pk_bf16(o0[4 * g + 2] * inv, o0[4 * g + 3] * inv);
      w1[0] = pk_bf16(o1[4 * g] * inv, o1[4 * g + 1] * inv); w1[1] = pk_bf16(o1[4 * g + 2] * inv, o1[4 * g + 3] * inv);
      *(u32x2*)(dst + d) = w0;
      *(u32x2*)(dst + 32 + d) = w1;
    }
    if (h == 0) p.lse[(size_t)cfg * M_TOK * 8 + (size_t)mq * 8 + hh] = m_ref + __builtin_amdgcn_logf(l_tot);
  };
  auto step = [&](int it, u32x4& nk0, u32x4& nk1, u32x4& nv, const u32x4& ok0, const u32x4& ok1, const u32x4& ov) {
    const int kt = kt_lo + it;
    const int sl_p = (sl_c == 0) ? 2 : sl_c - 1, sl_n = (sl_c == 2) ? 0 : sl_c + 1;
    if (it + 3 < n_it) gloadK(kt + 3, nk0, nk1);
    if (it + 2 < n_it) gloadV(kt + 2, nv);
    if (MODE == 2) {
      const int rel = kt - ((wid >> 1) - 1);
      const int b = rel >> 2, pos = rel & 3;
      if (rel >= 0 && b < NB && pos < 3) {
        if (b != cur_b) {
          cur_b = b;
          load_q(b);
#pragma unroll
          for (int i = 0; i < 16; ++i) { o0[i] = 0.f; o1[i] = 0.f; }
          l_run = 0.f; m_ref = 0.f; fresh = true; zref = true;
        }
        qk(sl_c, s0, s1);
        mx = rowmax(kt, s0, s1);
        softmax(s0, s1, mx);
        pv(sl_c);
        if (pos == 2 || kt == kt_hi) finalize2();
      }
    } else if (late) {
      softmax(s0, s1, mx);
      __builtin_amdgcn_sched_barrier(0);
      pv(sl_c);
      qk(sl_n, s0, s1);
      mx = rowmax(kt + 1, s0, s1);
    } else {
      pv(sl_p);
      qk(sl_c, s0, s1);
      __builtin_amdgcn_sched_barrier(0);
      mx = rowmax(kt, s0, s1);
      softmax(s0, s1, mx);
    }
    if (it + 2 < n_it) lwriteK(sl_p, ok0, ok1);
    if (it + 1 < n_it) lwriteV(sl_n, ov);
    __syncthreads();
    sl_c = sl_n;
  };
  for (int it = 0; it < n_it; it += 2) {
    step(it, kb0, kb1, vb, ka0, ka1, va);
    if (MODE != 2 || it + 1 < n_it) step(it + 1, ka0, ka1, va, kb0, kb1, vb);
  }
  if (MODE != 2 && !late) pv((sl_c == 0) ? 2 : sl_c - 1);
  if (MODE != 2) {
  const float l_tot = l_run + __shfl_xor(l_run, 32);
  const float inv = 1.f / l_tot;
  {
    const bf16_t* gp; bf16_t* dst;
    if (MODE == 0) { gp = p.proj + (size_t)mq * LD0 + (416 + 512) + hh * 64; dst = p.h + (size_t)mq * 1024 + 512 + hh * 64; }
    else { gp = p.proj + (size_t)mq * N_C + 1536 + hh * 64; dst = p.h + (size_t)mq * 1024 + hh * 64; }
#pragma unroll
    for (int g = 0; g < 4; ++g) {
      const int d = 8 * g + 4 * h;
      const u32x2 g0 = *(const u32x2*)(gp + d), g1 = *(const u32x2*)(gp + 32 + d);
      u32x2 w0, w1;
      w0[0] = pk_bf16(o0[4 * g] * inv * bflo(g0[0]), o0[4 * g + 1] * inv * bfhi(g0[0]));
      w0[1] = pk_bf16(o0[4 * g + 2] * inv * bflo(g0[1]), o0[4 * g + 3] * inv * bfhi(g0[1]));
      w1[0] = pk_bf16(o1[4 * g] * inv * bflo(g1[0]), o1[4 * g + 1] * inv * bfhi(g1[0]));
      w1[1] = pk_bf16(o1[4 * g + 2] * inv * bflo(g1[1]), o1[4 * g + 3] * inv * bfhi(g1[1]));
      *(u32x2*)(dst + d) = w0;
      *(u32x2*)(dst + 32 + d) = w1;
    }
  }
  }
}

template <int MODE>
DI void attn_dense(const Params& p, int u, char* lds) {
  constexpr int DQK = (MODE == 0) ? 96 : 64;
  constexpr int NC = DQK / 16;
  constexpr int KSTR = DQK * 2 + 16;
  constexpr int KTILE = 64 * KSTR;
  constexpr int VSTR = 144, VTILE = 64 * VSTR;
  const int tid = fresh_tid(), lane = tid & 63, wid = __builtin_amdgcn_readfirstlane(tid >> 6), ql = lane & 31, h = lane >> 5;

  int T, seq_row0, hh, qblk, kvh = 0;
  if (MODE == 0) {
    if (u < 512) { const int x = u & 7, j = (u >> 3) & 31, r = u >> 8, g = r * 8 + x;
      T = 8192; hh = g & 7; qblk = j; seq_row0 = (g >> 3) * 8192; }
    else { const int v = u - 512, x = v & 7, j = (v >> 3) & 31, r = v >> 8, g = (r * 8 + x) * 2 + (j >> 4);
      T = 4096; hh = g & 7; qblk = j & 15; seq_row0 = M_PROMPT + (g >> 3) * 4096; }
  } else {
    if (u < 1024) { const int x = u & 7, j = (u >> 3) & 31, r = u >> 8;
      T = 8192; kvh = x & 3; hh = kvh * 4 + r; qblk = j; seq_row0 = (x >> 2) * 8192; }
    else { const int v = u - 1024, x = v & 7, j = (v >> 3) & 31, r = v >> 8, g = 8 * (r >> 1) + x;
      T = 4096; kvh = g & 3; hh = kvh * 4 + (r & 1) * 2 + (j >> 4); qblk = j & 15; seq_row0 = M_PROMPT + (g >> 2) * 4096; }
  }
  const int mq = seq_row0 + qblk * 256 + wid * 32 + ql;
  const float c2 = (MODE == 0) ? 0.10206207261596577f * LOG2E : 0.125f * LOG2E;
  bf16x8 qf[NC];
  {
    const bf16_t* qp = (MODE == 0) ? p.qb + (size_t)mq * 768 + hh * 96 + 8 * h : p.proj + (size_t)mq * N_C + hh * 64 + 8 * h;
#pragma unroll
    for (int c = 0; c < NC; ++c) {
      u32x4 w = *(const u32x4*)(qp + 16 * c);
#pragma unroll
      for (int j = 0; j < 4; ++j) w[j] = pk_bf16(bflo(w[j]) * c2, bfhi(w[j]) * c2);
      qf[c] = __builtin_bit_cast(bf16x8, w);
    }
  }
  const int n_it = T >> 6;

  unsigned zero_v = 0u;
  asm volatile("" : "+v"(zero_v));
  const u32x4 zero4 = (u32x4){zero_v, zero_v, zero_v, zero_v};
  u32x4 kr0, kr1 = zero4, vr;
  const int key = tid >> 3, kc = tid & 7;
  const int rkey = (tid >> 2) & 63, rc = tid & 3;
  const unsigned koffg = (MODE == 0) ? (unsigned)(key * 512 + 8 * kc) * 2u : (unsigned)(key * N_C + 8 * kc) * 2u;
  const unsigned roffg = (unsigned)(rkey * 32 + 8 * rc) * 2u;
  const unsigned voffg = (unsigned)(key * T + 8 * kc) * 2u;
  auto gloadK = [&](int kt) {
    if (MODE == 0) {
      const char* kb = (const char*)(p.knope + (size_t)(seq_row0 + 64 * kt) * 512 + hh * 64);
      const char* rb = (const char*)(p.krope + (size_t)(seq_row0 + 64 * kt) * 32);
      kr0 = *(const u32x4*)(kb + koffg);
      if (tid < 256) kr1 = *(const u32x4*)(rb + roffg);
    } else {
      const char* kb = (const char*)(p.proj + (size_t)(seq_row0 + 64 * kt) * N_C + 1024 + kvh * 64);
      kr0 = *(const u32x4*)(kb + koffg);
    }
  };
  auto gloadV = [&](int kt) {
    const char* vb = (MODE == 0) ? (const char*)(p.vbT + (size_t)seq_row0 * 512 + (size_t)(hh * 64) * T + 64 * kt)
                                 : (const char*)(p.v1T + (size_t)seq_row0 * 256 + (size_t)(kvh * 64) * T + 64 * kt);
    vr = *(const u32x4*)(vb + voffg);
  };
  const int lwk = key * KSTR + kc * 16, lwr = rkey * KSTR + 128 + rc * 16, lwv = 3 * KTILE + key * VSTR + kc * 16;
  auto lwriteK = [&](int slot) {
    *(u32x4*)(lds + slot * KTILE + lwk) = kr0;
    if (MODE == 0) { if (tid < 256) *(u32x4*)(lds + slot * KTILE + lwr) = kr1; }
  };
  auto lwriteV = [&](int slot) { *(u32x4*)(lds + slot * VTILE + lwv) = vr; };

  f32x16 o0, o1;
#pragma unroll
  for (int i = 0; i < 16; ++i) { o0[i] = 0.f; o1[i] = 0.f; }
  const int sq = (ql & ~12) | ((ql & 4) << 1) | ((ql & 8) >> 1);
  const int koff = sq * KSTR + h * 16, voff = 3 * KTILE + ql * VSTR + h * 16;
  float m_ref = 0.f, l_run = 0.f;
  bool zref = true;
  u32x4 pa0 = zero4, pa1 = zero4, pb0 = zero4, pb1 = zero4;

  __syncthreads();
  gloadK(0); gloadV(0);
  lwriteK(0); lwriteV(0);
  gloadK(1);
  lwriteK(1);
  *(u32x4*)(lds + 2 * VTILE + lwv) = zero4;
  __syncthreads();
  {
    const char* kp = lds + koff;
    f32x16 t0, t1;
#pragma unroll
    for (int i = 0; i < 16; ++i) { t0[i] = 0.f; t1[i] = 0.f; }
#pragma unroll
    for (int c = 0; c < NC; ++c) {
      t0 = MFMA32(*(const bf16x8*)(kp + c * 32), qf[c], t0);
      t1 = MFMA32(*(const bf16x8*)(kp + 32 * KSTR + c * 32), qf[c], t1);
    }
    float mx = -1e30f;
#pragma unroll
    for (int i = 0; i < 16; ++i) mx = fmax_nc(mx, fmax_nc(t0[i], t1[i]));
    mx = fmax_nc(mx, __shfl_xor(mx, 32));
    if (__builtin_amdgcn_ballot_w64(fabsf(mx) > 24.f) != 0ull) { m_ref = mx; zref = false; }
  }
  int sl_c = 0;
  for (int it = 0; it < n_it; ++it) {
    const int sl_p = (sl_c == 0) ? 2 : sl_c - 1, sl_n = (sl_c == 2) ? 0 : sl_c + 1;
    if (it + 2 < n_it) gloadK(it + 2);
    if (it + 1 < n_it) gloadV(it + 1);
    const char* kp = lds + sl_c * KTILE + koff;
    const char* vp = lds + sl_p * VTILE + voff;
    {
      const bf16x8 pf0 = __builtin_bit_cast(bf16x8, pa0), pf1 = __builtin_bit_cast(bf16x8, pb0);
      const bf16x8 pf2 = __builtin_bit_cast(bf16x8, pa1), pf3 = __builtin_bit_cast(bf16x8, pb1);
      o0 = MFMA32(*(const bf16x8*)(vp), pf0, o0);
      o1 = MFMA32(*(const bf16x8*)(vp + 32 * VSTR), pf0, o1);
      o0 = MFMA32(*(const bf16x8*)(vp + 64), pf1, o0);
      o1 = MFMA32(*(const bf16x8*)(vp + 32 * VSTR + 64), pf1, o1);
      o0 = MFMA32(*(const bf16x8*)(vp + 32), pf2, o0);
      o1 = MFMA32(*(const bf16x8*)(vp + 32 * VSTR + 32), pf2, o1);
      o0 = MFMA32(*(const bf16x8*)(vp + 64 + 32), pf3, o0);
      o1 = MFMA32(*(const bf16x8*)(vp + 32 * VSTR + 64 + 32), pf3, o1);
    }
    f32x16 s0, s1;
#pragma unroll
    for (int i = 0; i < 16; ++i) { s0[i] = 0.f; s1[i] = 0.f; }
#pragma unroll
    for (int c = 0; c < NC; ++c) {
      s0 = MFMA32(*(const bf16x8*)(kp + c * 32), qf[c], s0);
      s1 = MFMA32(*(const bf16x8*)(kp + 32 * KSTR + c * 32), qf[c], s1);
    }
    if (!zref) {
#pragma unroll
      for (int i = 0; i < 16; ++i) { s0[i] -= m_ref; s1[i] -= m_ref; }
    }
    float ls = 0.f;
#pragma unroll
    for (int i = 0; i < 16; ++i) {
      s0[i] = __builtin_amdgcn_exp2f(s0[i]);
      s1[i] = __builtin_amdgcn_exp2f(s1[i]);
      ls += s0[i] + s1[i];
    }
    if (__builtin_amdgcn_ballot_w64(!(ls < 1e30f)) != 0ull) {
#pragma unroll
      for (int i = 0; i < 16; ++i) { s0[i] = 0.f; s1[i] = 0.f; }
#pragma unroll
      for (int c = 0; c < NC; ++c) {
        s0 = MFMA32(*(const bf16x8*)(kp + c * 32), qf[c], s0);
        s1 = MFMA32(*(const bf16x8*)(kp + 32 * KSTR + c * 32), qf[c], s1);
      }
      float mx = -1e30f;
#pragma unroll
      for (int i = 0; i < 16; ++i) mx = fmaxf(mx, fmaxf(s0[i], s1[i]));
      mx = fmaxf(mx, __shfl_xor(mx, 32));
      const float delta = fmaxf(mx - m_ref, 0.f);
      const float alpha = __builtin_amdgcn_exp2f(-delta);
      m_ref += delta;
      zref = false;
      l_run *= alpha;
#pragma unroll
      for (int i = 0; i < 16; ++i) { o0[i] *= alpha; o1[i] *= alpha; }
      ls = 0.f;
#pragma unroll
      for (int i = 0; i < 16; ++i) {
        s0[i] = __builtin_amdgcn_exp2f(s0[i] - m_ref);
        s1[i] = __builtin_amdgcn_exp2f(s1[i] - m_ref);
        ls += s0[i] + s1[i];
      }
    }
    l_run += ls;
#pragma unroll
    for (int j = 0; j < 4; ++j) {
      pa0[j] = pk_bf16(s0[2 * j], s0[2 * j + 1]);
      pa1[j] = pk_bf16(s0[8 + 2 * j], s0[8 + 2 * j + 1]);
      pb0[j] = pk_bf16(s1[2 * j], s1[2 * j + 1]);
      pb1[j] = pk_bf16(s1[8 + 2 * j], s1[8 + 2 * j + 1]);
    }
    if (it + 2 < n_it) lwriteK(sl_p);
    if (it + 1 < n_it) lwriteV(sl_n);
    __syncthreads();
    sl_c = sl_n;
  }
  {
    const char* vp = lds + ((sl_c == 0) ? 2 : sl_c - 1) * VTILE + voff;
    const bf16x8 pf0 = __builtin_bit_cast(bf16x8, pa0), pf1 = __builtin_bit_cast(bf16x8, pb0);
    const bf16x8 pf2 = __builtin_bit_cast(bf16x8, pa1), pf3 = __builtin_bit_cast(bf16x8, pb1);
    o0 = MFMA32(*(const bf16x8*)(vp), pf0, o0);
    o1 = MFMA32(*(const bf16x8*)(vp + 32 * VSTR), pf0, o1);
    o0 = MFMA32(*(const bf16x8*)(vp + 64), pf1, o0);
    o1 = MFMA32(*(const bf16x8*)(vp + 32 * VSTR + 64), pf1, o1);
    o0 = MFMA32(*(const bf16x8*)(vp + 32), pf2, o0);
    o1 = MFMA32(*(const bf16x8*)(vp + 32 * VSTR + 32), pf2, o1);
    o0 = MFMA32(*(const bf16x8*)(vp + 64 + 32), pf3, o0);
    o1 = MFMA32(*(const bf16x8*)(vp + 32 * VSTR + 64 + 32), pf3, o1);
  }
  const float l_tot = l_run + __shfl_xor(l_run, 32);
  const float inv = 1.f / l_tot;
  const bf16_t* gp; bf16_t* dst;
  if (MODE == 0) { gp = p.proj + (size_t)mq * LD0 + (416 + 512) + hh * 64; dst = p.h + (size_t)mq * 1024 + 512 + hh * 64; }
  else { gp = p.proj + (size_t)mq * N_C + 1536 + hh * 64; dst = p.h + (size_t)mq * 1024 + hh * 64; }
#pragma unroll
  for (int g = 0; g < 4; ++g) {
    const int d = 8 * g + 4 * h;
    const u32x2 g0 = *(const u32x2*)(gp + d), g1 = *(const u32x2*)(gp + 32 + d);
    u32x2 w0, w1;
    w0[0] = pk_bf16(o0[4 * g] * inv * bflo(g0[0]), o0[4 * g + 1] * inv * bfhi(g0[0]));
    w0[1] = pk_bf16(o0[4 * g + 2] * inv * bflo(g0[1]), o0[4 * g + 3] * inv * bfhi(g0[1]));
    w1[0] = pk_bf16(o1[4 * g] * inv * bflo(g1[0]), o1[4 * g + 1] * inv * bfhi(g1[0]));
    w1[1] = pk_bf16(o1[4 * g + 2] * inv * bflo(g1[1]), o1[4 * g + 3] * inv * bfhi(g1[1]));
    *(u32x2*)(dst + d) = w0;
    *(u32x2*)(dst + 32 + d) = w1;
  }
}

template <int MODE, bool SPLIT = false, bool PIPE = false>
DI void attn_dense128(const Params& p, int u, char* lds) {
  constexpr int DQK = (MODE == 0) ? 96 : 64;
  constexpr int NC = DQK / 16;
  constexpr int KSTR = DQK * 2 + 16;
  constexpr int KTILE = 128 * KSTR;
  constexpr int VSTR = 272, VTILE = 64 * VSTR;
  const int tid = fresh_tid(), lane = tid & 63, wid = __builtin_amdgcn_readfirstlane(tid >> 6), ql = lane & 31, h = lane >> 5;

  int T, seq_row0, hh, qblk, kvh = 0;
  if (MODE == 0) {
    if (u < 512) { const int x = u & 7, j = (u >> 3) & 31, r = u >> 8, g = r * 8 + x;
      T = 8192; hh = g & 7; qblk = j; seq_row0 = (g >> 3) * 8192; }
    else { const int v = u - 512, x = v & 7, j = (v >> 3) & 31, r = v >> 8, g = (r * 8 + x) * 2 + (j >> 4);
      T = 4096; hh = g & 7; qblk = j & 15; seq_row0 = M_PROMPT + (g >> 3) * 4096; }
  } else {
    if (u < 1024) { const int x = u & 7, j = (u >> 3) & 31, r = u >> 8;
      T = 8192; kvh = x & 3; hh = kvh * 4 + r; qblk = j; seq_row0 = (x >> 2) * 8192; }
    else { const int v = u - 1024, x = v & 7, j = (v >> 3) & 31, r = v >> 8, g = 8 * (r >> 1) + x;
      T = 4096; kvh = g & 3; hh = kvh * 4 + (r & 1) * 2 + (j >> 4); qblk = j & 15; seq_row0 = M_PROMPT + (g >> 2) * 4096; }
  }
  const int mq = seq_row0 + qblk * 256 + wid * 32 + ql;
  const float c2 = (MODE == 0) ? 0.10206207261596577f * LOG2E : 0.125f * LOG2E;
  bf16x8 qf[NC];
  {
    const bf16_t* qp = (MODE == 0) ? p.qb + (size_t)mq * 768 + hh * 96 + 8 * h : p.proj + (size_t)mq * N_C + hh * 64 + 8 * h;
#pragma unroll
    for (int c = 0; c < NC; ++c) {
      u32x4 w = *(const u32x4*)(qp + 16 * c);
#pragma unroll
      for (int j = 0; j < 4; ++j) w[j] = pk_bf16(bflo(w[j]) * c2, bfhi(w[j]) * c2);
      qf[c] = __builtin_bit_cast(bf16x8, w);
    }
  }
  const int n_it = T >> 7;

  unsigned zero_v = 0u;
  asm volatile("" : "+v"(zero_v));
  const u32x4 zero4 = (u32x4){zero_v, zero_v, zero_v, zero_v};
  u32x4 kr0, kr1, kr2 = zero4, vr0, vr1;
  const int key = tid >> 3, kc = tid & 7;
  const int rkey = tid >> 2, rc = tid & 3;
  const int vd = tid >> 4, vc = tid & 15;
  const unsigned koffg = (MODE == 0) ? (unsigned)(key * 512 + 8 * kc) * 2u : (unsigned)(key * N_C + 8 * kc) * 2u;
  const unsigned koffg2 = (MODE == 0) ? 64u * 512u * 2u : 64u * (unsigned)N_C * 2u;
  const unsigned roffg = (unsigned)(rkey * 32 + 8 * rc) * 2u;
  const unsigned voffg = (unsigned)(vd * T + 8 * vc) * 2u, voffg2 = (unsigned)(32 * T) * 2u;
  auto gloadK = [&](int kt) {
    if (MODE == 0) {
      const char* kb = (const char*)(p.knope + (size_t)(seq_row0 + 128 * kt) * 512 + hh * 64);
      const char* rb = (const char*)(p.krope + (size_t)(seq_row0 + 128 * kt) * 32);
      kr0 = *(const u32x4*)(kb + koffg);
      kr1 = *(const u32x4*)(kb + koffg + koffg2);
      kr2 = *(const u32x4*)(rb + roffg);
    } else {
      const char* kb = (const char*)(p.proj + (size_t)(seq_row0 + 128 * kt) * N_C + 1024 + kvh * 64);
      kr0 = *(const u32x4*)(kb + koffg);
      kr1 = *(const u32x4*)(kb + koffg + koffg2);
    }
  };
  auto gloadV = [&](int kt) {
    const char* vb = (MODE == 0) ? (const char*)(p.vbT + (size_t)seq_row0 * 512 + (size_t)(hh * 64) * T + 128 * kt)
                                 : (const char*)(p.v1T + (size_t)seq_row0 * 256 + (size_t)(kvh * 64) * T + 128 * kt);
    vr0 = *(const u32x4*)(vb + voffg);
    vr1 = *(const u32x4*)(vb + voffg + voffg2);
  };
  const int lwk = key * KSTR + kc * 16, lwr = rkey * KSTR + 128 + rc * 16, lwv = 3 * KTILE + vd * VSTR + vc * 16;
  auto lwriteK = [&](int slot) {
    *(u32x4*)(lds + slot * KTILE + lwk) = kr0;
    *(u32x4*)(lds + slot * KTILE + lwk + 64 * KSTR) = kr1;
    if (MODE == 0) *(u32x4*)(lds + slot * KTILE + lwr) = kr2;
  };
  auto lwriteV = [&](int slot) {
    *(u32x4*)(lds + slot * VTILE + lwv) = vr0;
    *(u32x4*)(lds + slot * VTILE + lwv + 32 * VSTR) = vr1;
  };

  f32x16 o0, o1;
#pragma unroll
  for (int i = 0; i < 16; ++i) { o0[i] = 0.f; o1[i] = 0.f; }
  const int sq = (ql & ~12) | ((ql & 4) << 1) | ((ql & 8) >> 1);
  const int koff = sq * KSTR + h * 16, voff = 3 * KTILE + ql * VSTR + h * 16;
  float m_ref = 0.f, l_run = 0.f;
  bool zref = true;
  u32x4 pk[4][2];
#pragma unroll
  for (int b = 0; b < 4; ++b) { pk[b][0] = zero4; pk[b][1] = zero4; }

  __syncthreads();
  gloadK(0); gloadV(0);
  lwriteK(0); lwriteV(0);
  gloadK(1);
  lwriteK(1);
  *(u32x4*)(lds + 2 * VTILE + lwv) = zero4;
  *(u32x4*)(lds + 2 * VTILE + lwv + 32 * VSTR) = zero4;
  __syncthreads();
  f32x16 t0, t1;
  {
    const char* kp = lds + koff;
#pragma unroll
    for (int i = 0; i < 16; ++i) { t0[i] = 0.f; t1[i] = 0.f; }
#pragma unroll
    for (int c = 0; c < NC; ++c) {
      t0 = MFMA32(*(const bf16x8*)(kp + c * 32), qf[c], t0);
      t1 = MFMA32(*(const bf16x8*)(kp + 32 * KSTR + c * 32), qf[c], t1);
    }
    float mx = -1e30f;
#pragma unroll
    for (int i = 0; i < 16; ++i) mx = fmax_nc(mx, fmax_nc(t0[i], t1[i]));
    mx = fmax_nc(mx, __shfl_xor(mx, 32));
    if (__builtin_amdgcn_ballot_w64(fabsf(mx) > 24.f) != 0ull) { m_ref = mx; zref = false; }
  }
  if (PIPE) {
    u32x4 qa0 = zero4, qa1 = zero4, qb0 = zero4, qb1 = zero4;
    f32x16 sA0 = t0, sA1 = t1, sB0, sB1;
    auto half_step = [&](f32x16& c0, f32x16& c1, f32x16& n0, f32x16& n1, const char* kp_next, const char* vp_prev, const char* kp_cur) {
      if (!zref) {
#pragma unroll
        for (int i = 0; i < 16; ++i) { c0[i] -= m_ref; c1[i] -= m_ref; }
      }
      {
        const bf16x8 pf0 = __builtin_bit_cast(bf16x8, qa0), pf1 = __builtin_bit_cast(bf16x8, qb0);
        const bf16x8 pf2 = __builtin_bit_cast(bf16x8, qa1), pf3 = __builtin_bit_cast(bf16x8, qb1);
        o0 = MFMA32(*(const bf16x8*)(vp_prev), pf0, o0);
        o1 = MFMA32(*(const bf16x8*)(vp_prev + 32 * VSTR), pf0, o1);
        o0 = MFMA32(*(const bf16x8*)(vp_prev + 64), pf1, o0);
        o1 = MFMA32(*(const bf16x8*)(vp_prev + 32 * VSTR + 64), pf1, o1);
        o0 = MFMA32(*(const bf16x8*)(vp_prev + 32), pf2, o0);
        o1 = MFMA32(*(const bf16x8*)(vp_prev + 32 * VSTR + 32), pf2, o1);
        o0 = MFMA32(*(const bf16x8*)(vp_prev + 64 + 32), pf3, o0);
        o1 = MFMA32(*(const bf16x8*)(vp_prev + 32 * VSTR + 64 + 32), pf3, o1);
      }
#pragma unroll
      for (int i = 0; i < 16; ++i) { n0[i] = 0.f; n1[i] = 0.f; }
#pragma unroll
      for (int c = 0; c < NC; ++c) {
        n0 = MFMA32(*(const bf16x8*)(kp_next + c * 32), qf[c], n0);
        n1 = MFMA32(*(const bf16x8*)(kp_next + 32 * KSTR + c * 32), qf[c], n1);
      }
      float ls = 0.f;
#pragma unroll
      for (int i = 0; i < 16; ++i) {
        c0[i] = __builtin_amdgcn_exp2f(c0[i]);
        c1[i] = __builtin_amdgcn_exp2f(c1[i]);
        ls += c0[i] + c1[i];
      }
#pragma unroll
      for (int g = 0; g < 2 * NC + 8; ++g) {
        __builtin_amdgcn_sched_group_barrier(0x008, 1, 0);
        __builtin_amdgcn_sched_group_barrier(0x002, (MODE == 0) ? 3 : 4, 0);
      }
      if (__builtin_amdgcn_ballot_w64(!(ls < 1e30f)) != 0ull) {
        const float m_old = m_ref;
#pragma unroll
        for (int i = 0; i < 16; ++i) { c0[i] = 0.f; c1[i] = 0.f; }
#pragma unroll
        for (int c = 0; c < NC; ++c) {
          c0 = MFMA32(*(const bf16x8*)(kp_cur + c * 32), qf[c], c0);
          c1 = MFMA32(*(const bf16x8*)(kp_cur + 32 * KSTR + c * 32), qf[c], c1);
        }
        float mx = -1e30f;
#pragma unroll
        for (int i = 0; i < 16; ++i) mx = fmaxf(mx, fmaxf(c0[i], c1[i]));
        mx = fmaxf(mx, __shfl_xor(mx, 32));
        const float delta = fmaxf(mx - m_ref, 0.f);
        const float alpha = __builtin_amdgcn_exp2f(-delta);
        m_ref += delta;
        zref = false;
        l_run *= alpha;
#pragma unroll
        for (int i = 0; i < 16; ++i) { o0[i] *= alpha; o1[i] *= alpha; }
        ls = 0.f;
#pragma unroll
        for (int i = 0; i < 16; ++i) {
          c0[i] = __builtin_amdgcn_exp2f(c0[i] - m_ref);
          c1[i] = __builtin_amdgcn_exp2f(c1[i] - m_ref);
          ls += c0[i] + c1[i];
        }
        (void)m_old;
      }
      l_run += ls;
#pragma unroll
      for (int j = 0; j < 4; ++j) {
        qa0[j] = pk_bf16(c0[2 * j], c0[2 * j + 1]);
        qa1[j] = pk_bf16(c0[8 + 2 * j], c0[8 + 2 * j + 1]);
        qb0[j] = pk_bf16(c1[2 * j], c1[2 * j + 1]);
        qb1[j] = pk_bf16(c1[8 + 2 * j], c1[8 + 2 * j + 1]);
      }
    };
    int sl_c = 0;
    for (int it = 0; it < n_it; ++it) {
      const int sl_p = (sl_c == 0) ? 2 : sl_c - 1, sl_n = (sl_c == 2) ? 0 : sl_c + 1;
      if (it + 2 < n_it) gloadK(it + 2);
      if (it + 1 < n_it) gloadV(it + 1);
      half_step(sA0, sA1, sB0, sB1, lds + sl_c * KTILE + 64 * KSTR + koff, lds + sl_p * VTILE + voff + 128, lds + sl_c * KTILE + koff);
      half_step(sB0, sB1, sA0, sA1, lds + sl_n * KTILE + koff, lds + sl_c * VTILE + voff, lds + sl_c * KTILE + 64 * KSTR + koff);
      if (it + 2 < n_it) lwriteK(sl_p);
      if (it + 1 < n_it) lwriteV(sl_n);
      __syncthreads();
      sl_c = sl_n;
    }
    {
      const char* vp = lds + ((sl_c == 0) ? 2 : sl_c - 1) * VTILE + voff + 128;
      const bf16x8 pf0 = __builtin_bit_cast(bf16x8, qa0), pf1 = __builtin_bit_cast(bf16x8, qb0);
      const bf16x8 pf2 = __builtin_bit_cast(bf16x8, qa1), pf3 = __builtin_bit_cast(bf16x8, qb1);
      o0 = MFMA32(*(const bf16x8*)(vp), pf0, o0);
      o1 = MFMA32(*(const bf16x8*)(vp + 32 * VSTR), pf0, o1);
      o0 = MFMA32(*(const bf16x8*)(vp + 64), pf1, o0);
      o1 = MFMA32(*(const bf16x8*)(vp + 32 * VSTR + 64), pf1, o1);
      o0 = MFMA32(*(const bf16x8*)(vp + 32), pf2, o0);
      o1 = MFMA32(*(const bf16x8*)(vp + 32 * VSTR + 32), pf2, o1);
      o0 = MFMA32(*(const bf16x8*)(vp + 64 + 32), pf3, o0);
      o1 = MFMA32(*(const bf16x8*)(vp + 32 * VSTR + 64 + 32), pf3, o1);
    }
  } else if (SPLIT) {
    u32x4 qa0 = zero4, qa1 = zero4, qb0 = zero4, qb1 = zero4;
    int sl_c = 0;
    for (int it = 0; it < n_it; ++it) {
      const int sl_p = (sl_c == 0) ? 2 : sl_c - 1, sl_n = (sl_c == 2) ? 0 : sl_c + 1;
      if (it + 2 < n_it) gloadK(it + 2);
      if (it + 1 < n_it) gloadV(it + 1);
#pragma unroll
      for (int hf = 0; hf < 2; ++hf) {
        const char* kp = lds + sl_c * KTILE + hf * 64 * KSTR + koff;
        const char* vp = lds + ((hf == 0) ? sl_p : sl_c) * VTILE + voff + (1 - hf) * 128;
        {
          const bf16x8 pf0 = __builtin_bit_cast(bf16x8, qa0), pf1 = __builtin_bit_cast(bf16x8, qb0);
          const bf16x8 pf2 = __builtin_bit_cast(bf16x8, qa1), pf3 = __builtin_bit_cast(bf16x8, qb1);
          o0 = MFMA32(*(const bf16x8*)(vp), pf0, o0);
          o1 = MFMA32(*(const bf16x8*)(vp + 32 * VSTR), pf0, o1);
          o0 = MFMA32(*(const bf16x8*)(vp + 64), pf1, o0);
          o1 = MFMA32(*(const bf16x8*)(vp + 32 * VSTR + 64), pf1, o1);
          o0 = MFMA32(*(const bf16x8*)(vp + 32), pf2, o0);
          o1 = MFMA32(*(const bf16x8*)(vp + 32 * VSTR + 32), pf2, o1);
          o0 = MFMA32(*(const bf16x8*)(vp + 64 + 32), pf3, o0);
          o1 = MFMA32(*(const bf16x8*)(vp + 32 * VSTR + 64 + 32), pf3, o1);
        }
        f32x16 s0, s1;
#pragma unroll
        for (int i = 0; i < 16; ++i) { s0[i] = 0.f; s1[i] = 0.f; }
#pragma unroll
        for (int c = 0; c < NC; ++c) {
          s0 = MFMA32(*(const bf16x8*)(kp + c * 32), qf[c], s0);
          s1 = MFMA32(*(const bf16x8*)(kp + 32 * KSTR + c * 32), qf[c], s1);
        }
        if (!zref) {
#pragma unroll
          for (int i = 0; i < 16; ++i) { s0[i] -= m_ref; s1[i] -= m_ref; }
        }
        float ls = 0.f;
#pragma unroll
        for (int i = 0; i < 16; ++i) {
          s0[i] = __builtin_amdgcn_exp2f(s0[i]);
          s1[i] = __builtin_amdgcn_exp2f(s1[i]);
          ls += s0[i] + s1[i];
        }
        if (__builtin_amdgcn_ballot_w64(!(ls < 1e30f)) != 0ull) {
#pragma unroll
          for (int i = 0; i < 16; ++i) { s0[i] = 0.f; s1[i] = 0.f; }
#pragma unroll
          for (int c = 0; c < NC; ++c) {
            s0 = MFMA32(*(const bf16x8*)(kp + c * 32), qf[c], s0);
            s1 = MFMA32(*(const bf16x8*)(kp + 32 * KSTR + c * 32), qf[c], s1);
          }
          float mx = -1e30f;
#pragma unroll
          for (int i = 0; i < 16; ++i) mx = fmaxf(mx, fmaxf(s0[i], s1[i]));
          mx = fmaxf(mx, __shfl_xor(mx, 32));
          const float delta = fmaxf(mx - m_ref, 0.f);
          const float alpha = __builtin_amdgcn_exp2f(-delta);
          m_ref += delta;
          zref = false;
          l_run *= alpha;
#pragma unroll
          for (int i = 0; i < 16; ++i) { o0[i] *= alpha; o1[i] *= alpha; }
          ls = 0.f;
#pragma unroll
          for (int i = 0; i < 16; ++i) {
            s0[i] = __builtin_amdgcn_exp2f(s0[i] - m_ref);
            s1[i] = __builtin_amdgcn_exp2f(s1[i] - m_ref);
            ls += s0[i] + s1[i];
          }
        }
        l_run += ls;
#pragma unroll
        for (int j = 0; j < 4; ++j) {
          qa0[j] = pk_bf16(s0[2 * j], s0[2 * j + 1]);
          qa1[j] = pk_bf16(s0[8 + 2 * j], s0[8 + 2 * j + 1]);
          qb0[j] = pk_bf16(s1[2 * j], s1[2 * j + 1]);
          qb1[j] = pk_bf16(s1[8 + 2 * j], s1[8 + 2 * j + 1]);
        }
      }
      if (it + 2 < n_it) lwriteK(sl_p);
      if (it + 1 < n_it) lwriteV(sl_n);
      __syncthreads();
      sl_c = sl_n;
    }
    {
      const char* vp = lds + ((sl_c == 0) ? 2 : sl_c - 1) * VTILE + voff + 128;
      const bf16x8 pf0 = __builtin_bit_cast(bf16x8, qa0), pf1 = __builtin_bit_cast(bf16x8, qb0);
      const bf16x8 pf2 = __builtin_bit_cast(bf16x8, qa1), pf3 = __builtin_bit_cast(bf16x8, qb1);
      o0 = MFMA32(*(const bf16x8*)(vp), pf0, o0);
      o1 = MFMA32(*(const bf16x8*)(vp + 32 * VSTR), pf0, o1);
      o0 = MFMA32(*(const bf16x8*)(vp + 64), pf1, o0);
      o1 = MFMA32(*(const bf16x8*)(vp + 32 * VSTR + 64), pf1, o1);
      o0 = MFMA32(*(const bf16x8*)(vp + 32), pf2, o0);
      o1 = MFMA32(*(const bf16x8*)(vp + 32 * VSTR + 32), pf2, o1);
      o0 = MFMA32(*(const bf16x8*)(vp + 64 + 32), pf3, o0);
      o1 = MFMA32(*(const bf16x8*)(vp + 32 * VSTR + 64 + 32), pf3, o1);
    }
  } else {
  int sl_c = 0;
  for (int it = 0; it < n_it; ++it) {
    const int sl_p = (sl_c == 0) ? 2 : sl_c - 1, sl_n = (sl_c == 2) ? 0 : sl_c + 1;
    if (it + 2 < n_it) gloadK(it + 2);
    if (it + 1 < n_it) gloadV(it + 1);
    const char* kp = lds + sl_c * KTILE + koff;
    const char* vp = lds + sl_p * VTILE + voff;
#pragma unroll
    for (int b = 0; b < 4; ++b)
#pragma unroll
      for (int s = 0; s < 2; ++s) {
        const bf16x8 pf = __builtin_bit_cast(bf16x8, pk[b][s]);
        o0 = MFMA32(*(const bf16x8*)(vp + b * 64 + s * 32), pf, o0);
        o1 = MFMA32(*(const bf16x8*)(vp + 32 * VSTR + b * 64 + s * 32), pf, o1);
      }
    f32x16 sc[4];
#pragma unroll
    for (int b = 0; b < 4; ++b) {
      if (MODE == 0) __builtin_amdgcn_sched_barrier(0);
#pragma unroll
      for (int i = 0; i < 16; ++i) sc[b][i] = 0.f;
#pragma unroll
      for (int c = 0; c < NC; ++c) sc[b] = MFMA32(*(const bf16x8*)(kp + b * 32 * KSTR + c * 32), qf[c], sc[b]);
    }
    if (MODE == 0) __builtin_amdgcn_sched_barrier(0);
    if (!zref) {
#pragma unroll
      for (int b = 0; b < 4; ++b)
#pragma unroll
        for (int i = 0; i < 16; ++i) sc[b][i] -= m_ref;
    }
    float ls = 0.f;
#pragma unroll
    for (int b = 0; b < 4; ++b)
#pragma unroll
      for (int i = 0; i < 16; ++i) { sc[b][i] = __builtin_amdgcn_exp2f(sc[b][i]); ls += sc[b][i]; }
    if (__builtin_amdgcn_ballot_w64(!(ls < 1e30f)) != 0ull) {
      float mx = -1e30f;
#pragma unroll
      for (int b = 0; b < 4; ++b) {
#pragma unroll
        for (int i = 0; i < 16; ++i) sc[b][i] = 0.f;
#pragma unroll
        for (int c = 0; c < NC; ++c) sc[b] = MFMA32(*(const bf16x8*)(kp + b * 32 * KSTR + c * 32), qf[c], sc[b]);
#pragma unroll
        for (int i = 0; i < 16; ++i) mx = fmaxf(mx, sc[b][i]);
      }
      mx = fmaxf(mx, __shfl_xor(mx, 32));
      const float delta = fmaxf(mx - m_ref, 0.f);
      const float alpha = __builtin_amdgcn_exp2f(-delta);
      m_ref += delta;
      zref = false;
      l_run *= alpha;
#pragma unroll
      for (int i = 0; i < 16; ++i) { o0[i] *= alpha; o1[i] *= alpha; }
      ls = 0.f;
#pragma unroll
      for (int b = 0; b < 4; ++b)
#pragma unroll
        for (int i = 0; i < 16; ++i) { sc[b][i] = __builtin_amdgcn_exp2f(sc[b][i] - m_ref); ls += sc[b][i]; }
    }
    l_run += ls;
#pragma unroll
    for (int b = 0; b < 4; ++b)
#pragma unroll
      for (int s = 0; s < 2; ++s)
#pragma unroll
        for (int j = 0; j < 4; ++j) pk[b][s][j] = pk_bf16(sc[b][8 * s + 2 * j], sc[b][8 * s + 2 * j + 1]);
    if (it + 2 < n_it) lwriteK(sl_p);
    if (it + 1 < n_it) lwriteV(sl_n);
    __syncthreads();
    sl_c = sl_n;
  }
  {
    const char* vp = lds + ((sl_c == 0) ? 2 : sl_c - 1) * VTILE + voff;
#pragma unroll
    for (int b = 0; b < 4; ++b)
#pragma unroll
      for (int s = 0; s < 2; ++s) {
        const bf16x8 pf = __builtin_bit_cast(bf16x8, pk[b][s]);
        o0 = MFMA32(*(const bf16x8*)(vp + b * 64 + s * 32), pf, o0);
        o1 = MFMA32(*(const bf16x8*)(vp + 32 * VSTR + b * 64 + s * 32), pf, o1);
      }
  }
  }
  const float l_tot = l_run + __shfl_xor(l_run, 32);
  const float inv = 1.f / l_tot;
  const bf16_t* gp; bf16_t* dst;
  if (MODE == 0) { gp = p.proj + (size_t)mq * LD0 + (416 + 512) + hh * 64; dst = p.h + (size_t)mq * 1024 + 512 + hh * 64; }
  else { gp = p.proj + (size_t)mq * N_C + 1536 + hh * 64; dst = p.h + (size_t)mq * 1024 + hh * 64; }
#pragma unroll
  for (int g = 0; g < 4; ++g) {
    const int d = 8 * g + 4 * h;
    const u32x2 g0 = *(const u32x2*)(gp + d), g1 = *(const u32x2*)(gp + 32 + d);
    u32x2 w0, w1;
    w0[0] = pk_bf16(o0[4 * g] * inv * bflo(g0[0]), o0[4 * g + 1] * inv * bfhi(g0[0]));
    w0[1] = pk_bf16(o0[4 * g + 2] * inv * bflo(g0[1]), o0[4 * g + 3] * inv * bfhi(g0[1]));
    w1[0] = pk_bf16(o1[4 * g] * inv * bflo(g1[0]), o1[4 * g + 1] * inv * bfhi(g1[0]));
    w1[1] = pk_bf16(o1[4 * g + 2] * inv * bflo(g1[1]), o1[4 * g + 3] * inv * bfhi(g1[1]));
    *(u32x2*)(dst + d) = w0;
    *(u32x2*)(dst + 32 + d) = w1;
  }
}

DI void attn_dilated(const Params& p, int u, char* lds) {
  constexpr int KSTR = 144, KBYTES = 384 * KSTR;
  constexpr int VSTR = 192;
  const int tid = fresh_tid(), lane = tid & 63, wid = __builtin_amdgcn_readfirstlane(tid >> 6), ql = lane & 31, h = lane >> 5;
  int T, seq_row0, hh, cfg, cls, u0, NB;
  {
    int r;
    if (u < 512) { T = 8192; seq_row0 = (u >> 8) * 8192; hh = (u >> 5) & 7; r = u & 31;
      if (r < 8) { cfg = 0; cls = 0; NB = 4; u0 = r * 1024; }
      else if (r < 16) { cfg = 1; cls = (r - 8) >> 1; NB = 4; u0 = ((r - 8) & 1) * 1024; }
      else { cfg = 2; cls = r - 16; NB = 2; u0 = 0; } }
    else { const int v = u - 512; T = 4096; seq_row0 = M_PROMPT + (v / 192) * 4096; hh = (v / 24) & 7; r = v % 24;
      if (r < 4) { cfg = 0; cls = 0; NB = 4; u0 = r * 1024; }
      else if (r < 8) { cfg = 1; cls = r - 4; NB = 4; u0 = 0; }
      else { cfg = 2; cls = r - 8; NB = 1; u0 = 0; } }
  }
  const int dd = 1 << (2 * cfg), U = T >> (2 * cfg);
  const float c2 = 0.125f * LOG2E;
  const float slope2 = exp2f(-(float)(hh + 1)) * (float)dd * LOG2E;

  u32x4 kr[6], vr[6];
  const int wrow = tid >> 3, kc = tid & 7;
  auto gload = [&](int b) {
    const int ub = u0 + 256 * b;
#pragma unroll
    for (int i = 0; i < 6; ++i) {
      int uk = ub - 64 + wrow + 64 * i;
      uk = uk < 0 ? 0 : (uk >= U ? U - 1 : uk);
      const char* kbase = (const char*)(p.qkva + ((size_t)(8 + hh) * M_TOK + seq_row0) * 64);
      const char* vbase = (const char*)(p.qkva + ((size_t)(16 + hh) * M_TOK + seq_row0) * 64);
      const unsigned off = ((unsigned)(uk * dd + cls) * 64u + 8u * kc) * 2u;
      kr[i] = *(const u32x4*)(kbase + off);
      vr[i] = *(const u32x4*)(vbase + off);
    }
  };
  auto lwrite = [&]() {
#pragma unroll
    for (int i = 0; i < 6; ++i) {
      const int w = wrow + 64 * i;
      *(u32x4*)(lds + w * KSTR + kc * 16) = kr[i];
      *(u32x4*)(lds + KBYTES + w * VSTR + kc * 16) = vr[i];
    }
  };
  const int sq = (ql & ~12) | ((ql & 4) << 1) | ((ql & 8) >> 1);
  const int koff = sq * KSTR + h * 16;
  const int voff = KBYTES + (8 * h + ((lane & 15) >> 2)) * VSTR + 32 * ((lane >> 4) & 1) + 8 * (lane & 3);
  const int wc = wid >> 1;

  __syncthreads();
  gload(0);
  lwrite();
  __syncthreads();
  for (int b = 0; b < NB; ++b) {
    if (b + 1 < NB) gload(b + 1);
    const int ub = u0 + 256 * b;
    const int mq = seq_row0 + (ub + wid * 32 + ql) * dd + cls;
    bf16x8 qf[4];
    {
      const bf16_t* qp = p.qkva + ((size_t)hh * M_TOK + mq) * 64 + 8 * h;
#pragma unroll
      for (int c = 0; c < 4; ++c) {
        u32x4 w = *(const u32x4*)(qp + 16 * c);
#pragma unroll
        for (int j = 0; j < 4; ++j) w[j] = pk_bf16(bflo(w[j]) * c2, bfhi(w[j]) * c2);
        qf[c] = __builtin_bit_cast(bf16x8, w);
      }
    }
    f32x16 o0, o1;
#pragma unroll
    for (int i = 0; i < 16; ++i) { o0[i] = 0.f; o1[i] = 0.f; }
    float m_ref = 0.f, l_run = 0.f;
#pragma unroll 1
    for (int ord = 0; ord < 3; ++ord) {
      const int j = (ord == 0) ? wc + 1 : (ord == 1 ? wc : wc + 2);
      const int ut = ub - 64 + 64 * j;
      if (ut >= 0 && ut < U) {
        const char* kp = lds + (64 * j) * KSTR + koff;
        const char* vp = lds + voff + (64 * j) * VSTR;
        f32x16 s0, s1;
#pragma unroll
        for (int i = 0; i < 16; ++i) { s0[i] = 0.f; s1[i] = 0.f; }
#pragma unroll
        for (int c = 0; c < 4; ++c) {
          s0 = MFMA32(*(const bf16x8*)(kp + c * 32), qf[c], s0);
          s1 = MFMA32(*(const bf16x8*)(kp + 32 * KSTR + c * 32), qf[c], s1);
        }
        const float fb = (float)(64 * j - 64 + 8 * h - (32 * wid + ql));
        float mx = -1e30f;
#pragma unroll
        for (int i = 0; i < 16; ++i) {
          const float d0 = fb + (float)(16 * (i >> 3) + (i & 7)), d1 = d0 + 32.f;
          const float a0 = fabsf(d0), a1 = fabsf(d1);
          s0[i] = (a0 <= 64.f) ? __builtin_fmaf(-slope2, a0, s0[i]) : -1e30f;
          s1[i] = (a1 <= 64.f) ? __builtin_fmaf(-slope2, a1, s1[i]) : -1e30f;
          if (ord == 0) mx = fmaxf(mx, fmaxf(s0[i], s1[i]));
        }
        if (ord == 0) { mx = fmaxf(mx, __shfl_xor(mx, 32)); m_ref = mx; }
        float ls = 0.f;
#pragma unroll
        for (int i = 0; i < 16; ++i) {
          s0[i] = (s0[i] > -1e29f) ? __builtin_amdgcn_exp2f(s0[i] - m_ref) : 0.f;
          s1[i] = (s1[i] > -1e29f) ? __builtin_amdgcn_exp2f(s1[i] - m_ref) : 0.f;
          ls += s0[i] + s1[i];
        }
        if (ord != 0 && __builtin_amdgcn_ballot_w64(!(ls < 1e30f)) != 0ull) {
#pragma unroll
          for (int i = 0; i < 16; ++i) { s0[i] = 0.f; s1[i] = 0.f; }
#pragma unroll
          for (int c = 0; c < 4; ++c) {
            s0 = MFMA32(*(const bf16x8*)(kp + c * 32), qf[c], s0);
            s1 = MFMA32(*(const bf16x8*)(kp + 32 * KSTR + c * 32), qf[c], s1);
          }
          float m2 = -1e30f;
#pragma unroll
          for (int i = 0; i < 16; ++i) {
            const float d0 = fb + (float)(16 * (i >> 3) + (i & 7)), d1 = d0 + 32.f;
            const float a0 = fabsf(d0), a1 = fabsf(d1);
            s0[i] = (a0 <= 64.f) ? __builtin_fmaf(-slope2, a0, s0[i]) : -1e30f;
            s1[i] = (a1 <= 64.f) ? __builtin_fmaf(-slope2, a1, s1[i]) : -1e30f;
            m2 = fmaxf(m2, fmaxf(s0[i], s1[i]));
          }
          m2 = fmaxf(m2, __shfl_xor(m2, 32));
          const float delta = fmaxf(m2 - m_ref, 0.f);
          const float alpha = __builtin_amdgcn_exp2f(-delta);
          m_ref += delta;
          l_run *= alpha;
#pragma unroll
          for (int i = 0; i < 16; ++i) { o0[i] *= alpha; o1[i] *= alpha; }
          ls = 0.f;
#pragma unroll
          for (int i = 0; i < 16; ++i) {
            s0[i] = (s0[i] > -1e29f) ? __builtin_amdgcn_exp2f(s0[i] - m_ref) : 0.f;
            s1[i] = (s1[i] > -1e29f) ? __builtin_amdgcn_exp2f(s1[i] - m_ref) : 0.f;
            ls += s0[i] + s1[i];
          }
        }
        l_run += ls;
#pragma unroll
        for (int s = 0; s < 2; ++s) {
          u32x4 pa, pb;
#pragma unroll
          for (int jj = 0; jj < 4; ++jj) {
            pa[jj] = pk_bf16(s0[8 * s + 2 * jj], s0[8 * s + 2 * jj + 1]);
            pb[jj] = pk_bf16(s1[8 * s + 2 * jj], s1[8 * s + 2 * jj + 1]);
          }
          const bf16x8 pfa = __builtin_bit_cast(bf16x8, pa), pfb = __builtin_bit_cast(bf16x8, pb);
          auto vfrag = [&](int k0, int db) -> bf16x8 {
            const s16x4 lo = __builtin_amdgcn_ds_read_tr16_b64_v4i16((LAS s16x4*)(vp + k0 * VSTR + db * 64));
            const s16x4 hi = __builtin_amdgcn_ds_read_tr16_b64_v4i16((LAS s16x4*)(vp + (k0 + 4) * VSTR + db * 64));
            return __builtin_shufflevector(lo, hi, 0, 1, 2, 3, 4, 5, 6, 7);
          };
          o0 = MFMA32(vfrag(16 * s, 0), pfa, o0);
          o1 = MFMA32(vfrag(16 * s, 1), pfa, o1);
          o0 = MFMA32(vfrag(32 + 16 * s, 0), pfb, o0);
          o1 = MFMA32(vfrag(32 + 16 * s, 1), pfb, o1);
        }
      }
    }
    {
      const float l_tot = l_run + __shfl_xor(l_run, 32);
      const float inv = 1.f / l_tot;
      bf16_t* dst = p.pA + (size_t)cfg * M_TOK * 512 + (size_t)mq * 512 + hh * 64;
#pragma unroll
      for (int g = 0; g < 4; ++g) {
        const int d = 8 * g + 4 * h;
        u32x2 w0, w1;
        w0[0] = pk_bf16(o0[4 * g] * inv, o0[4 * g + 1] * inv); w0[1] = pk_bf16(o0[4 * g + 2] * inv, o0[4 * g + 3] * inv);
        w1[0] = pk_bf16(o1[4 * g] * inv, o1[4 * g + 1] * inv); w1[1] = pk_bf16(o1[4 * g + 2] * inv, o1[4 * g + 3] * inv);
        *(u32x2*)(dst + d) = w0;
        *(u32x2*)(dst + 32 + d) = w1;
      }
      if (h == 0) p.lse[(size_t)cfg * M_TOK * 8 + (size_t)mq * 8 + hh] = m_ref + __builtin_amdgcn_logf(l_tot);
    }
    __syncthreads();
    if (b + 1 < NB) { lwrite(); __syncthreads(); }
  }
}

DI void phase_merge(const Params& p) {
  const int nthr = gridDim.x * 512;
  for (int e = blockIdx.x * 512 + threadIdx.x; e < M_TOK * 64; e += nthr) {
    const int m = e >> 6, c = e & 63, hh = c >> 3;
    const float l0 = p.lse[(size_t)m * 8 + hh], l1 = p.lse[(size_t)M_TOK * 8 + (size_t)m * 8 + hh], l2 = p.lse[(size_t)2 * M_TOK * 8 + (size_t)m * 8 + hh];
    const float mx = fmaxf(l0, fmaxf(l1, l2));
    float w0 = __builtin_amdgcn_exp2f(l0 - mx), w1 = __builtin_amdgcn_exp2f(l1 - mx), w2 = __builtin_amdgcn_exp2f(l2 - mx);
    const float inv = 1.f / (w0 + w1 + w2);
    w0 *= inv; w1 *= inv; w2 *= inv;
    const u32x4 a = __builtin_nontemporal_load((const u32x4*)(p.pA + (size_t)m * 512 + c * 8));
    const u32x4 b = __builtin_nontemporal_load((const u32x4*)(p.pA + (size_t)M_TOK * 512 + (size_t)m * 512 + c * 8));
    const u32x4 d = __builtin_nontemporal_load((const u32x4*)(p.pA + (size_t)2 * M_TOK * 512 + (size_t)m * 512 + c * 8));
    const u32x4 g = *(const u32x4*)(p.proj + (size_t)m * LD0 + 416 + c * 8);
    u32x4 o;
#pragma unroll
    for (int j = 0; j < 4; ++j) {
      const float lo = (bflo(a[j]) * w0 + bflo(b[j]) * w1 + bflo(d[j]) * w2) * bflo(g[j]);
      const float hi = (bfhi(a[j]) * w0 + bfhi(b[j]) * w1 + bfhi(d[j]) * w2) * bfhi(g[j]);
      o[j] = pk_bf16(lo, hi);
    }
    *(u32x4*)(p.h + (size_t)m * 1024 + c * 8) = o;
  }
}

template <int PH>
DI void run_phase(const Params& p, char* lds) {
  const int bid = blockIdx.x, nblk = gridDim.x;
  if (PH == 0) phase_prep(p, lds);
  else if (PH == 1) { for (int t = bid; t < 320 * 12; t += nblk) { int pm, pn; g8_tile(t, 320, 12, pm, pn); gemm_tile<0>(p, p.h, 1024, p.wt_in_ab, 1024, pm * 256, pn * 256, lds); } }
  else if (PH == 2) phase_mlanorm(p);
  else if (PH == 3) {
    for (int t = bid; t < 960 + 1280; t += nblk) {
      int pm, pn;
      if (t < 960) { g8_tile(t, 320, 3, pm, pn); gemm_tile<1>(p, p.proj, LD0, p.wt_uq, 256, pm * 256, pn * 256, lds); }
      else { g8_tile(t - 960, 320, 4, pm, pn); gemm_tile<2>(p, p.proj + 256, LD0, p.wt_ukv, 128, pm * 256, pn * 256, lds); }
    }
  }
  else if (PH == 4) {
    for (int u = bid; u < 2560; u += nblk) attn_dense128<0>(p, u, lds);
    for (int u = bid; u < 3584; u += nblk) attn_dilated(p, u, lds);
  }
  else if (PH == 5) phase_merge(p);
  else if (PH == 6) { for (int t = bid; t < 1280; t += nblk) { int pm, pn; g8_tile(t, 320, 4, pm, pn); gemm_tile<3>(p, p.h, 1024, p.wt_out_ab, 1024, pm * 256, pn * 256, lds); } }
  else if (PH == 7) phase_postnorm<false>(p, p.proj, p.norm_post, p.norm_pre + 1024);
  else if (PH == 8) { for (int t = bid; t < 3200; t += nblk) { int pm, pn; g8_tile(t, 320, 10, pm, pn); gemm_tile<4>(p, p.h, 1024, p.wt_in_c, 1024, pm * 256, pn * 256, lds); } }
  else if (PH == 9) { for (int u = bid; u < 5120; u += nblk) attn_dense128<1, false, true>(p, u, lds); }
  else if (PH == 10) { for (int t = bid; t < 1280; t += nblk) { int pm, pn; g8_tile(t, 320, 4, pm, pn); gemm_tile<5>(p, p.h, 1024, p.wt_out_c, 1024, pm * 256, pn * 256, lds); } }
  else if (PH == 11) phase_postnorm<true>(p, p.yout1, p.norm_post + 1024, nullptr);
}

template <int PH>
__global__ void __launch_bounds__(512) k_phase(Params p) {
  __shared__ __attribute__((aligned(16))) char lds[LDS_BYTES];
  run_phase<PH>(p, lds);
}

__global__ void __launch_bounds__(512) k_mega(Params p) {
  __shared__ __attribute__((aligned(16))) char lds[LDS_BYTES];
  cg::grid_group grid = cg::this_grid();
  run_phase<0>(p, lds); grid.sync();
  run_phase<1>(p, lds); grid.sync();
  run_phase<3>(p, lds); grid.sync();
  run_phase<4>(p, lds); grid.sync();
  run_phase<5>(p, lds); grid.sync();
  run_phase<6>(p, lds); grid.sync();
  run_phase<7>(p, lds); grid.sync();
  run_phase<8>(p, lds); grid.sync();
#ifdef PROBE_GEMM
  run_phase<8>(p, lds); grid.sync();
#endif
  run_phase<9>(p, lds); grid.sync();
#ifdef PROBE_ATT
  run_phase<9>(p, lds); grid.sync();
#endif
  run_phase<10>(p, lds); grid.sync();
  run_phase<11>(p, lds);
}

extern "C" void kernel_launch(void* const* d_in, const int* in_sizes, int n_in, void* d_out, int out_size, void* d_ws,
                              size_t ws_size, hipStream_t stream) {
  Params p{};
  p.x_prompt = (const float*)d_in[0]; p.x_sample = (const float*)d_in[1];
  p.norm_pre = (const float*)d_in[2]; p.norm_post = (const float*)d_in[3];
  p.w_in_ab = (const float*)d_in[4]; p.mla_q_norm = (const float*)d_in[5]; p.w_uq = (const float*)d_in[6];
  p.mla_kv_norm = (const float*)d_in[7]; p.w_ukv = (const float*)d_in[8]; p.w_out_ab = (const float*)d_in[9];
  p.w_in_c = (const float*)d_in[10]; p.c_q_norm = (const float*)d_in[11]; p.c_k_norm = (const float*)d_in[12];
  p.w_out_c = (const float*)d_in[13];
  p.out = (float*)d_out;
  char* ws = (char*)d_ws;
  const size_t MiB = 1ull << 20;
  p.wt_in_ab = (bf16_t*)(ws + 0 * MiB);
  p.wt_out_ab = (bf16_t*)(ws + 6 * MiB);
  p.wt_in_c = (bf16_t*)(ws + 8 * MiB);
  p.wt_out_c = (bf16_t*)(ws + 13 * MiB);
  p.rope = (float2*)(ws + 15 * MiB);
  p.wt_uq = (bf16_t*)(ws + 16 * MiB);
  p.wt_ukv = (bf16_t*)(ws + 16 * MiB + 512 * 1024);
  p.h = (bf16_t*)(ws + 20 * MiB);
  p.proj = (bf16_t*)(ws + 180 * MiB);
  p.qb = (bf16_t*)(ws + 645 * MiB);
  p.knope = (bf16_t*)(ws + 765 * MiB);
  p.vbT = (bf16_t*)(ws + 845 * MiB);
  p.krope = (bf16_t*)(ws + 925 * MiB);
  p.v1T = (bf16_t*)(ws + 645 * MiB);
  p.yout1 = (bf16_t*)(ws + 700 * MiB);
  p.pA = (bf16_t*)d_out;
  p.lse = (float*)((char*)d_out + 240 * MiB);
  p.qkva = (bf16_t*)(ws + 405 * MiB);
  p.rss_q = (float*)(ws + 931 * MiB);
  p.rss_kv = (float*)(ws + 932 * MiB);
#if N_LAUNCH_MODE == 1
  static int grid_blocks = 0;
  if (!grid_blocks) {
    int dev = 0, cus = 0, per_cu = 0;
    hipGetDevice(&dev);
    hipDeviceGetAttribute(&cus, hipDeviceAttributeMultiprocessorCount, dev);
    hipOccupancyMaxActiveBlocksPerMultiprocessor(&per_cu, k_mega, 512, 0);
    if (per_cu < 1) per_cu = 1;
    if (per_cu > 1) per_cu = 1;
    grid_blocks = cus * per_cu;
  }
  void* args[] = {&p};
  hipError_t e = hipLaunchCooperativeKernel((void*)k_mega, dim3(grid_blocks), dim3(512), args, 0, stream);
  if (e != hipSuccess) fprintf(stderr, "cooperative launch failed: %s (grid %d)\n", hipGetErrorString(e), grid_blocks);
#else
  const dim3 g(256), b(512);
  k_phase<0><<<g, b, 0, stream>>>(p);
  k_phase<1><<<g, b, 0, stream>>>(p);
  k_phase<3><<<g, b, 0, stream>>>(p);
  k_phase<4><<<g, b, 0, stream>>>(p);
  k_phase<5><<<g, b, 0, stream>>>(p);
  k_phase<6><<<g, b, 0, stream>>>(p);
  k_phase<7><<<g, b, 0, stream>>>(p);
  k_phase<8><<<g, b, 0, stream>>>(p);
  k_phase<9><<<g, b, 0, stream>>>(p);
  k_phase<10><<<g, b, 0, stream>>>(p);
  k_phase<11><<<g, b, 0, stream>>>(p);
#endif
}
```

```cpp
#include <hip/hip_runtime.h>
#include <hip/hip_cooperative_groups.h>
#include <cstdint>
#include <cstdio>
namespace cg = cooperative_groups;

#ifndef N_LAUNCH_MODE
#define N_LAUNCH_MODE 1
#endif

typedef unsigned short bf16_t;
typedef short bf16x8 __attribute__((ext_vector_type(8)));
typedef float f32x16 __attribute__((ext_vector_type(16)));
typedef float f32x4 __attribute__((ext_vector_type(4)));
typedef float f32x2 __attribute__((ext_vector_type(2)));
typedef unsigned u32x4 __attribute__((ext_vector_type(4)));
typedef unsigned u32x2 __attribute__((ext_vector_type(2)));
typedef __bf16 bf16x2_t __attribute__((ext_vector_type(2)));
typedef short s16x4 __attribute__((ext_vector_type(4)));

#define DI __device__ __forceinline__
#define MFMA32(a, b, c) __builtin_amdgcn_mfma_f32_32x32x16_bf16((a), (b), (c), 0, 0, 0)

constexpr int M_TOK = 81920, M_PROMPT = 16384;
constexpr int N_AB = 2976, N_C = 2560;
constexpr int LD0 = 1440;
constexpr float EPS = 1e-6f;
constexpr float LOG2E = 1.4426950408889634f;
constexpr int LDS_BYTES = 147456;

struct Params {
  const float *x_prompt, *x_sample, *norm_pre, *norm_post, *w_in_ab, *mla_q_norm, *w_uq, *mla_kv_norm, *w_ukv,
      *w_out_ab, *w_in_c, *c_q_norm, *c_k_norm, *w_out_c;
  float* out;
  bf16_t *wt_in_ab, *wt_out_ab, *wt_in_c, *wt_out_c, *wt_uq, *wt_ukv;
  float2* rope;
  bf16_t *h;
  bf16_t *proj;
  bf16_t *qb;
  bf16_t *knope;
  bf16_t *vbT;
  bf16_t *krope;
  bf16_t *v1T;
  bf16_t *yout1;
  bf16_t *pA;
  float *lse;
  bf16_t *qkva;
  float *rss_q, *rss_kv;
};

DI unsigned pk_bf16(float lo, float hi) {
  f32x2 v = {lo, hi};
  bf16x2_t b = __builtin_convertvector(v, bf16x2_t);
  return __builtin_bit_cast(unsigned, b);
}
DI bf16_t f2bf(float x) { return (bf16_t)(pk_bf16(x, 0.f) & 0xffffu); }
DI float bflo(unsigned u) { return __uint_as_float(u << 16); }
DI float bfhi(unsigned u) { return __uint_as_float(u & 0xffff0000u); }
DI float bf2f(bf16_t v) { return __uint_as_float(((unsigned)v) << 16); }
DI float silu_f(float v) { return v * __builtin_amdgcn_rcpf(1.f + __builtin_amdgcn_exp2f(-v * LOG2E)); }
DI float wave_sum(float v) {
  v += __shfl_xor(v, 32); v += __shfl_xor(v, 16); v += __shfl_xor(v, 8);
  v += __shfl_xor(v, 4); v += __shfl_xor(v, 2); v += __shfl_xor(v, 1);
  return v;
}
DI int fresh_tid() { int t = threadIdx.x; asm volatile("" : "+v"(t)); return t; }
DI float fmax_nc(float a, float b) { return __builtin_amdgcn_fmed3f(a, b, __builtin_inff()); }
DI void st_pair16(bf16_t* row32, int g, int h, const u32x2& a, const u32x2& b) {
  const auto r0 = __builtin_amdgcn_permlane32_swap(a[0], b[0], false, false);
  const auto r1 = __builtin_amdgcn_permlane32_swap(a[1], b[1], false, false);
  u32x4 v; v[0] = r0[0]; v[1] = r1[0]; v[2] = r0[1]; v[3] = r1[1];
  *(u32x4*)(row32 + 8 * g + 8 * h) = v;
}
DI int crow(int i, int h) { return (i & 3) + 8 * (i >> 2) + 4 * h; }
DI const float* xrow(const Params& p, int m) {
  return (m < M_PROMPT) ? p.x_prompt + (size_t)m * 1024 : p.x_sample + (size_t)(m - M_PROMPT) * 1024;
}

DI void phase_prep(const Params& p, char* lds) {
  const int tid = fresh_tid(), nblk = gridDim.x, bid = blockIdx.x, lane = tid & 63, wid = __builtin_amdgcn_readfirstlane(tid >> 6);
  float (*tile)[65] = (float (*)[65])lds;
  for (int t0 = bid; t0 < 2000; t0 += nblk) {
    const float* src; bf16_t* dst; int K, N, tt = t0; const float* kg = nullptr;
    if (tt < 768) { src = p.w_in_ab; dst = p.wt_in_ab; K = 1024; N = 2976; }
    else if ((tt -= 768) < 256) { src = p.w_out_ab; dst = p.wt_out_ab; K = 1024; N = 1024; }
    else if ((tt -= 256) < 640) { src = p.w_in_c; dst = p.wt_in_c; K = 1024; N = 2560; }
    else if ((tt -= 640) < 256) { src = p.w_out_c; dst = p.wt_out_c; K = 1024; N = 1024; }
    else if ((tt -= 256) < 48) { src = p.w_uq; dst = p.wt_uq; K = 256; N = 768; kg = p.mla_q_norm; }
    else { tt -= 48; src = p.w_ukv; dst = p.wt_ukv; K = 128; N = 1024; kg = p.mla_kv_norm; }
    const int nkt = K >> 6;
    const int k0 = (tt % nkt) * 64, n0 = (tt / nkt) * 64;
    __syncthreads();
    {
      const int tx = tid & 63, ty = tid >> 6;
#pragma unroll
      for (int i = 0; i < 8; ++i) {
        const int k = ty + 8 * i, n = n0 + tx;
        tile[k][tx] = (n < N) ? src[(size_t)(k0 + k) * N + n] * (kg ? kg[k0 + k] : 1.f) : 0.f;
      }
    }
    __syncthreads();
    {
      const int kx = tid & 63, ny = tid >> 6;
#pragma unroll
      for (int i = 0; i < 8; ++i) {
        const int n = ny + 8 * i;
        dst[(size_t)(n0 + n) * K + k0 + kx] = f2bf(tile[kx][n]);
      }
    }
  }
  for (int e = bid * 512 + tid; e < M_TOK; e += nblk * 512) { p.rss_q[e] = 0.f; p.rss_kv[e] = 0.f; }
  for (int e = bid * 512 + tid; e < 8192 * 16; e += nblk * 512) {
    const int pos = e >> 4, i = e & 15;
    const double freq = exp2(-(double)i * (13.287712379549449 / 16.0));
    const double ang = (double)pos * freq;
    const double kk = rint(ang * 0.15915494309189535);
    const float rf = (float)(ang - kk * 6.283185307179586);
    p.rope[e] = make_float2(cosf(rf), sinf(rf));
  }
  for (int m = bid * 8 + wid; m < M_TOK; m += nblk * 8) {
    const float* xr = xrow(p, m);
    f32x4 v[4]; float ss = 0.f;
#pragma unroll
    for (int i = 0; i < 4; ++i) {
      v[i] = *(const f32x4*)(xr + i * 256 + lane * 4);
      ss += v[i][0] * v[i][0] + v[i][1] * v[i][1] + v[i][2] * v[i][2] + v[i][3] * v[i][3];
    }
    ss = wave_sum(ss);
    const float rinv = rsqrtf(ss * (1.f / 1024.f) + EPS);
#pragma unroll
    for (int i = 0; i < 4; ++i) {
      const f32x4 g = *(const f32x4*)(p.norm_pre + i * 256 + lane * 4);
      u32x2 w;
      w[0] = pk_bf16(v[i][0] * rinv * g[0], v[i][1] * rinv * g[1]);
      w[1] = pk_bf16(v[i][2] * rinv * g[2], v[i][3] * rinv * g[3]);
      *(u32x2*)(p.h + (size_t)m * 1024 + i * 256 + lane * 4) = w;
    }
  }
}

template <bool LAST>
DI void phase_postnorm(const Params& p, const bf16_t* yout, const float* gpost, const float* gpre) {
  const int tid = fresh_tid(), nblk = gridDim.x, bid = blockIdx.x, lane = tid & 63, wid = __builtin_amdgcn_readfirstlane(tid >> 6);
  for (int m = bid * 8 + wid; m < M_TOK; m += nblk * 8) {
    const float* xr = LAST ? (const float*)(p.out + (size_t)m * 1024) : xrow(p, m);
    f32x4 y[4], x[4]; float ss = 0.f;
#pragma unroll
    for (int i = 0; i < 4; ++i) {
      const u32x2 w = *(const u32x2*)(yout + (size_t)m * 1024 + i * 256 + lane * 4);
      y[i][0] = bflo(w[0]); y[i][1] = bfhi(w[0]); y[i][2] = bflo(w[1]); y[i][3] = bfhi(w[1]);
      x[i] = *(const f32x4*)(xr + i * 256 + lane * 4);
      ss += y[i][0] * y[i][0] + y[i][1] * y[i][1] + y[i][2] * y[i][2] + y[i][3] * y[i][3];
    }
    ss = wave_sum(ss);
    const float rinv = rsqrtf(ss * (1.f / 1024.f) + EPS);
    float ss2 = 0.f;
#pragma unroll
    for (int i = 0; i < 4; ++i) {
      const f32x4 g = *(const f32x4*)(gpost + i * 256 + lane * 4);
#pragma unroll
      for (int j = 0; j < 4; ++j) { x[i][j] = x[i][j] + y[i][j] * rinv * g[j]; ss2 += x[i][j] * x[i][j]; }
      *(f32x4*)(p.out + (size_t)m * 1024 + i * 256 + lane * 4) = x[i];
    }
    if (!LAST) {
      ss2 = wave_sum(ss2);
      const float rinv2 = rsqrtf(ss2 * (1.f / 1024.f) + EPS);
#pragma unroll
      for (int i = 0; i < 4; ++i) {
        const f32x4 g = *(const f32x4*)(gpre + i * 256 + lane * 4);
        u32x2 w;
        w[0] = pk_bf16(x[i][0] * rinv2 * g[0], x[i][1] * rinv2 * g[1]);
        w[1] = pk_bf16(x[i][2] * rinv2 * g[2], x[i][3] * rinv2 * g[3]);
        *(u32x2*)(p.h + (size_t)m * 1024 + i * 256 + lane * 4) = w;
      }
    }
  }
}

DI void phase_mlanorm(const Params& p) {
  const int tid = fresh_tid(), nblk = gridDim.x, bid = blockIdx.x, lane = tid & 63, wid = __builtin_amdgcn_readfirstlane(tid >> 6);
  for (int m = bid * 8 + wid; m < M_TOK; m += nblk * 8) {
    bf16_t* pr = p.proj + (size_t)m * LD0 - 1536;
    const int T = (m < M_PROMPT) ? 8192 : 4096, t = m & (T - 1);
    {
      const u32x2 w = *(const u32x2*)(pr + 1536 + lane * 4);
      float v0 = bflo(w[0]), v1 = bfhi(w[0]), v2 = bflo(w[1]), v3 = bfhi(w[1]);
      float ss = wave_sum(v0 * v0 + v1 * v1 + v2 * v2 + v3 * v3);
      const float rinv = rsqrtf(ss * (1.f / 256.f) + EPS);
      const f32x4 g = *(const f32x4*)(p.mla_q_norm + lane * 4);
      u32x2 o; o[0] = pk_bf16(v0 * rinv * g[0], v1 * rinv * g[1]); o[1] = pk_bf16(v2 * rinv * g[2], v3 * rinv * g[3]);
      *(u32x2*)(pr + 1536 + lane * 4) = o;
    }
    {
      const unsigned w = *(const unsigned*)(pr + 1792 + lane * 2);
      float v0 = bflo(w), v1 = bfhi(w);
      float ss = wave_sum(v0 * v0 + v1 * v1);
      const float rinv = rsqrtf(ss * (1.f / 128.f) + EPS);
      const f32x2 g = *(const f32x2*)(p.mla_kv_norm + lane * 2);
      *(unsigned*)(pr + 1792 + lane * 2) = pk_bf16(v0 * rinv * g[0], v1 * rinv * g[1]);
    }
    {
      const float xv = bf2f(pr[1920 + (lane & 31)]);
      const float pv = __shfl_xor(xv, 16);
      const float2 cs = p.rope[t * 16 + (lane & 15)];
      const float o = (lane & 16) ? (xv * cs.x + pv * cs.y) : (xv * cs.x - pv * cs.y);
      if (lane < 32) p.krope[(size_t)m * 32 + lane] = f2bf(o);
    }
  }
}

#define LAS __attribute__((address_space(3)))
#define GAS __attribute__((address_space(1)))
DI void g8_stage_rc(int b, int& R, int& C) {
  const int st = b / 1024, sb = b % 1024, swz = sb ^ (((sb >> 9) & 1) << 5);
  R = (st >> 1) * 16 + swz / 64; C = (st & 1) * 32 + (swz % 64) / 2;
}
DI void g8_tile(int L, int nM, int nN, int& pm, int& pn) {
  const int nwg = nM * nN, q = nwg / 8, r = nwg % 8, xcd = L % 8, off = L / 8;
  const int wg = (xcd < r ? xcd * (q + 1) : r * (q + 1) + (xcd - r) * q) + off;
  const int nig = 8 * nN, gid = wg / nig, fm = gid * 8, gsz = (nM - fm) < 8 ? (nM - fm) : 8;
  pm = fm + (wg % nig) % gsz; pn = (wg % nig) / gsz;
}
DI void st4(bf16_t* dst, const f32x4& v) {
  u32x2 w; w[0] = pk_bf16(v[0], v[1]); w[1] = pk_bf16(v[2], v[3]);
  *(u32x2*)dst = w;
}

template <int EPI>
DI void gemm_epilogue(const Params& p, f32x4 (&acc)[2][2][4][2], int m0, int n0, int wr, int wc, int fr, int fq) {
#pragma unroll
  for (int bj = 0; bj < 2; ++bj)
#pragma unroll
    for (int ni = 0; ni < 2; ++ni) {
      const int m = m0 + bj * 128 + wc * 32 + ni * 16 + fr;
      const int T = (m < M_PROMPT) ? 8192 : 4096, t = m & (T - 1);
      float ssq = 0.f;
#pragma unroll
      for (int ai = 0; ai < 2; ++ai) {
        const int nb = n0 + ai * 128 + wr * 64;
        if (EPI == 0) {
#pragma unroll
          for (int mi = 0; mi < 4; ++mi) {
            const int n = nb + mi * 16 + fq * 4;
            if (n < 1536) {
              st4(p.qkva + ((size_t)(n >> 6) * M_TOK + m) * 64 + (n & 63), acc[ai][bj][mi][ni]);
            } else if (n < N_AB) {
              f32x4 v = acc[ai][bj][mi][ni];
              if (n >= 1952) { v[0] = silu_f(v[0]); v[1] = silu_f(v[1]); v[2] = silu_f(v[2]); v[3] = silu_f(v[3]); }
              if (n < 1920 || n >= 1952) st4(p.proj + (size_t)m * LD0 + (n - 1536), v);
            }
          }
          if (nb >= 1536 && nb < 1920) {
#pragma unroll
            for (int mi = 0; mi < 4; ++mi)
#pragma unroll
              for (int j = 0; j < 4; ++j) { const float v = acc[ai][bj][mi][ni][j]; ssq += v * v; }
          } else if (nb == 1920) {
            const f32x4* rp = (const f32x4*)(p.rope + t * 16 + fq * 4);
            const f32x4 r0 = rp[0], r1 = rp[1];
            const float cs[4] = {r0[0], r0[2], r1[0], r1[2]}, sn[4] = {r0[1], r0[3], r1[1], r1[3]};
            f32x4 y1, y2;
#pragma unroll
            for (int j = 0; j < 4; ++j) {
              const float x1 = acc[ai][bj][0][ni][j], x2 = acc[ai][bj][1][ni][j];
              y1[j] = x1 * cs[j] - x2 * sn[j];
              y2[j] = x2 * cs[j] + x1 * sn[j];
            }
            st4(p.krope + (size_t)m * 32 + fq * 4, y1);
            st4(p.krope + (size_t)m * 32 + 16 + fq * 4, y2);
          }
        } else if (EPI == 1) {
          {
            const float rinv = rsqrtf(p.rss_q[m] * (1.f / 256.f) + EPS);
#pragma unroll
            for (int mi = 0; mi < 4; ++mi) acc[ai][bj][mi][ni] *= rinv;
          }
#pragma unroll
          for (int blk = 0; blk < 2; ++blk) {
            const int nblk = nb + 32 * blk;
            if (((nblk >> 5) % 3) == 2) {
              const f32x4* rp = (const f32x4*)(p.rope + t * 16 + fq * 4);
              const f32x4 r0 = rp[0], r1 = rp[1];
              const float cs[4] = {r0[0], r0[2], r1[0], r1[2]}, sn[4] = {r0[1], r0[3], r1[1], r1[3]};
#pragma unroll
              for (int j = 0; j < 4; ++j) {
                const float x1 = acc[ai][bj][2 * blk][ni][j], x2 = acc[ai][bj][2 * blk + 1][ni][j];
                acc[ai][bj][2 * blk][ni][j] = x1 * cs[j] - x2 * sn[j];
                acc[ai][bj][2 * blk + 1][ni][j] = x2 * cs[j] + x1 * sn[j];
              }
            }
          }
#pragma unroll
          for (int mi = 0; mi < 4; ++mi) st4(p.qb + (size_t)m * 768 + nb + mi * 16 + fq * 4, acc[ai][bj][mi][ni]);
        } else if (EPI == 2) {
          {
            const float rinv = rsqrtf(p.rss_kv[m] * (1.f / 128.f) + EPS);
#pragma unroll
            for (int mi = 0; mi < 4; ++mi) acc[ai][bj][mi][ni] *= rinv;
          }
          const int hh = (n0 + ai * 128) >> 7;
          if (wr == 0) {
#pragma unroll
            for (int mi = 0; mi < 4; ++mi) st4(p.knope + (size_t)m * 512 + hh * 64 + mi * 16 + fq * 4, acc[ai][bj][mi][ni]);
          } else {
            bf16_t* vb = p.vbT + (size_t)(m - t) * 512 + t;
#pragma unroll
            for (int mi = 0; mi < 4; ++mi)
#pragma unroll
              for (int j = 0; j < 4; ++j) vb[(size_t)(hh * 64 + mi * 16 + fq * 4 + j) * T] = f2bf(acc[ai][bj][mi][ni][j]);
          }
        } else if (EPI == 3 || EPI == 5) {
          bf16_t* dst = (EPI == 3) ? p.proj : p.yout1;
#pragma unroll
          for (int mi = 0; mi < 4; ++mi) st4(dst + (size_t)m * 1024 + nb + mi * 16 + fq * 4, acc[ai][bj][mi][ni]);
        } else if (EPI == 4) {
          if (n0 < 1280) {
            const float* gain = (n0 < 1024) ? p.c_q_norm : p.c_k_norm;
            float ss = 0.f;
#pragma unroll
            for (int mi = 0; mi < 4; ++mi)
#pragma unroll
              for (int j = 0; j < 4; ++j) { const float v = acc[ai][bj][mi][ni][j]; ss += v * v; }
            ss += __shfl_xor(ss, 16);
            ss += __shfl_xor(ss, 32);
            const float rinv = rsqrtf(ss * (1.f / 64.f) + EPS);
#pragma unroll
            for (int blk = 0; blk < 2; ++blk) {
              const int pos = (blk == 0) ? (t >> 6) : (t & 63);
              const f32x4* rp = (const f32x4*)(p.rope + pos * 16 + fq * 4);
              const f32x4 r0 = rp[0], r1 = rp[1];
              const float cs[4] = {r0[0], r0[2], r1[0], r1[2]}, sn[4] = {r0[1], r0[3], r1[1], r1[3]};
              const f32x4 g1 = *(const f32x4*)(gain + blk * 32 + fq * 4), g2 = *(const f32x4*)(gain + blk * 32 + 16 + fq * 4);
#pragma unroll
              for (int j = 0; j < 4; ++j) {
                const float x1 = acc[ai][bj][2 * blk][ni][j] * rinv * g1[j], x2 = acc[ai][bj][2 * blk + 1][ni][j] * rinv * g2[j];
                acc[ai][bj][2 * blk][ni][j] = x1 * cs[j] - x2 * sn[j];
                acc[ai][bj][2 * blk + 1][ni][j] = x2 * cs[j] + x1 * sn[j];
              }
            }
#pragma unroll
            for (int mi = 0; mi < 4; ++mi) st4(p.proj + (size_t)m * N_C + nb + mi * 16 + fq * 4, acc[ai][bj][mi][ni]);
          } else if (n0 < 1536) {
            bf16_t* vb = p.v1T + (size_t)(m - t) * 256 + t;
#pragma unroll
            for (int mi = 0; mi < 4; ++mi)
#pragma unroll
              for (int j = 0; j < 4; ++j) vb[(size_t)(nb - 1280 + mi * 16 + fq * 4 + j) * T] = f2bf(acc[ai][bj][mi][ni][j]);
          } else {
#pragma unroll
            for (int mi = 0; mi < 4; ++mi) {
              f32x4 v = acc[ai][bj][mi][ni];
              v[0] = silu_f(v[0]); v[1] = silu_f(v[1]); v[2] = silu_f(v[2]); v[3] = silu_f(v[3]);
              st4(p.proj + (size_t)m * N_C + nb + mi * 16 + fq * 4, v);
            }
          }
        }
      }
      if (EPI == 0 && (n0 == 1536 || n0 == 1792)) {
        ssq += __shfl_xor(ssq, 16);
        ssq += __shfl_xor(ssq, 32);
        if (fq == 0) atomicAdd((n0 == 1536) ? p.rss_q + m : p.rss_kv + m, ssq);
      }
    }
}

template <int EPI>
DI void gemm_tile(const Params& p, const bf16_t* __restrict__ X, int ldx, const bf16_t* __restrict__ Wt, int K,
                  int m0, int n0, char* lds) {
  constexpr int HTB = 16384;
  const int tid = fresh_tid(), lane = tid & 63, wid = __builtin_amdgcn_readfirstlane(tid >> 6);
  const int wr = wid >> 2, wc = wid & 3, fr = lane & 15, fq = lane >> 4;
  f32x4 acc[2][2][4][2];
#pragma unroll
  for (int a = 0; a < 2; ++a)
#pragma unroll
    for (int b = 0; b < 2; ++b)
#pragma unroll
      for (int c = 0; c < 4; ++c)
#pragma unroll
        for (int d = 0; d < 2; ++d) acc[a][b][c][d] = (f32x4){0.f, 0.f, 0.f, 0.f};
  bf16x8 At[4][2], B0[2][2], B1[2][2];
  int sr0, sc0, sr1, sc1;
  g8_stage_rc(tid * 16, sr0, sc0);
  g8_stage_rc(tid * 16 + 8192, sr1, sc1);
  const unsigned gw0 = (unsigned)(sr0 * K + sc0) * 2u, gw1 = (unsigned)(sr1 * K + sc1) * 2u, gx0 = (unsigned)(sr0 * ldx + sc0) * 2u, gx1 = (unsigned)(sr1 * ldx + sc1) * 2u;
  const bf16_t* wbase = Wt + (size_t)n0 * K;
  const bf16_t* xbase = X + (size_t)m0 * ldx;
  const int lw = tid * 16;
  const int lo = (fr * 64 + fq * 16) ^ ((fr >> 3) << 5);
  const int la = wr * 8 * 1024 + lo, lb = wc * 4 * 1024 + lo;
#define SA(b, h) (lds + ((b) * 2 + (h)) * HTB)
#define SB(b, h) (lds + (4 + (b) * 2 + (h)) * HTB)
#define STAGE_W(P, half, kt) do { const bf16_t* g_ = wbase + (size_t)(half) * 128 * K + (kt) * 64; \
    __builtin_amdgcn_global_load_lds((const GAS unsigned*)((const char*)g_ + gw0), (LAS unsigned*)((P) + lw), 16, 0, 0); \
    __builtin_amdgcn_global_load_lds((const GAS unsigned*)((const char*)g_ + gw1), (LAS unsigned*)((P) + lw + 8192), 16, 0, 0); } while (0)
#define STAGE_X(P, half, kt) do { const bf16_t* g_ = xbase + (size_t)(half) * 128 * ldx + (kt) * 64; \
    __builtin_amdgcn_global_load_lds((const GAS unsigned*)((const char*)g_ + gx0), (LAS unsigned*)((P) + lw), 16, 0, 0); \
    __builtin_amdgcn_global_load_lds((const GAS unsigned*)((const char*)g_ + gx1), (LAS unsigned*)((P) + lw + 8192), 16, 0, 0); } while (0)
#define LDA(dst, b, h) _Pragma("unroll") for (int m_ = 0; m_ < 4; ++m_) _Pragma("unroll") for (int k_ = 0; k_ < 2; ++k_) \
    dst[m_][k_] = *(const bf16x8*)(SA(b, h) + la + (m_ * 2 + k_) * 1024)
#define LDB(dst, b, h) _Pragma("unroll") for (int n_ = 0; n_ < 2; ++n_) _Pragma("unroll") for (int k_ = 0; k_ < 2; ++k_) \
    dst[n_][k_] = *(const bf16x8*)(SB(b, h) + lb + (n_ * 2 + k_) * 1024)
#define MMA(ai, bj, Af, Bf) do { __builtin_amdgcn_s_setprio(1); \
    _Pragma("unroll") for (int m_ = 0; m_ < 4; ++m_) _Pragma("unroll") for (int n_ = 0; n_ < 2; ++n_) _Pragma("unroll") for (int k_ = 0; k_ < 2; ++k_) \
      acc[ai][bj][m_][n_] = __builtin_amdgcn_mfma_f32_16x16x32_bf16(Af[m_][k_], Bf[n_][k_], acc[ai][bj][m_][n_], 0, 0, 0); \
    __builtin_amdgcn_s_setprio(0); } while (0)
#define WAIT_V(n) asm volatile("s_waitcnt vmcnt(" #n ")" ::: "memory")
#define WAIT_L(n) asm volatile("s_waitcnt lgkmcnt(" #n ")" ::: "memory")
#define BAR __builtin_amdgcn_s_barrier()
#define SCHED __builtin_amdgcn_sched_barrier(0)
  const int nt = K >> 6;
  STAGE_X(SB(0, 0), 0, 0); STAGE_W(SA(0, 0), 0, 0);
  STAGE_X(SB(0, 1), 1, 0); STAGE_W(SA(0, 1), 1, 0);
  if (wr == 1) BAR;
  WAIT_V(4); BAR;
  STAGE_X(SB(1, 0), 0, 1); STAGE_W(SA(1, 0), 0, 1); STAGE_X(SB(1, 1), 1, 1);
  WAIT_V(6); BAR;
  for (int t = 0; t < nt - 2; t += 2) {
    LDB(B0, 0, 0); SCHED; LDA(At, 0, 0); STAGE_W(SA(1, 1), 1, t + 1);
    WAIT_L(8); BAR; WAIT_L(0); MMA(0, 0, At, B0); BAR; SCHED;
    LDB(B1, 0, 1); STAGE_X(SB(0, 0), 0, t + 2);
    BAR; WAIT_L(0); MMA(0, 1, At, B1); BAR;
    LDA(At, 0, 1); STAGE_W(SA(0, 0), 0, t + 2);
    BAR; WAIT_L(0); MMA(1, 0, At, B0); BAR; SCHED;
    STAGE_X(SB(0, 1), 1, t + 2);
    WAIT_V(6); BAR; MMA(1, 1, At, B1); BAR;
    LDB(B0, 1, 0); SCHED; LDA(At, 1, 0); STAGE_W(SA(0, 1), 1, t + 2);
    WAIT_L(8); BAR; WAIT_L(0); MMA(0, 0, At, B0); BAR; SCHED;
    LDB(B1, 1, 1); STAGE_X(SB(1, 0), 0, t + 3);
    BAR; WAIT_L(0); MMA(0, 1, At, B1); BAR;
    LDA(At, 1, 1); STAGE_W(SA(1, 0), 0, t + 3);
    BAR; WAIT_L(0); MMA(1, 0, At, B0); BAR; SCHED;
    STAGE_X(SB(1, 1), 1, t + 3);
    WAIT_V(6); BAR; MMA(1, 1, At, B1); BAR;
  }
  { LDB(B0, 0, 0); LDA(At, 0, 0); STAGE_W(SA(1, 1), 1, nt - 1);
    BAR; WAIT_L(0); MMA(0, 0, At, B0); BAR;
    LDB(B1, 0, 1); BAR; WAIT_L(0); MMA(0, 1, At, B1); BAR;
    LDA(At, 0, 1); WAIT_V(4); BAR; WAIT_L(0); MMA(1, 0, At, B0); MMA(1, 1, At, B1); BAR; }
  { LDB(B0, 1, 0); LDA(At, 1, 0); WAIT_V(2); BAR; WAIT_L(0); MMA(0, 0, At, B0); BAR;
    LDB(B1, 1, 1); WAIT_V(0); BAR; WAIT_L(0); MMA(0, 1, At, B1); BAR;
    LDA(At, 1, 1); BAR; WAIT_L(0); MMA(1, 0, At, B0); MMA(1, 1, At, B1); BAR; }
  if (wr == 0) BAR;
  gemm_epilogue<EPI>(p, acc, m0, n0, wr, wc, fr, fq);
  __syncthreads();
#undef SA
#undef SB
#undef STAGE_W
#undef STAGE_X
#undef LDA
#undef LDB
#undef MMA
#undef WAIT_V
#undef WAIT_L
#undef BAR
#undef SCHED
}

template <int MODE>
DI void attn_unit(const Params& p, int u, char* lds) {
  constexpr int DQK = (MODE == 0) ? 96 : 64;
  constexpr int NC = DQK / 16;
  constexpr int KSTR = DQK * 2 + 16;
  constexpr int KTILE = 64 * KSTR;
  constexpr int VSTR = 144, VTILE = 64 * VSTR;
  const int tid = fresh_tid(), lane = tid & 63, wid = __builtin_amdgcn_readfirstlane(tid >> 6), ql = lane & 31, h = lane >> 5;

  int T, seq_row0, hh, qblk = 0, kvh = 0;
  int dd = 1, cls = 0, u0 = 0, cfg = 0, U = 0, NB = 1;
  if (MODE == 0) {
    if (u < 512) { const int x = u & 7, j = (u >> 3) & 31, r = u >> 8, g = r * 8 + x;
      T = 8192; hh = g & 7; qblk = j; seq_row0 = (g >> 3) * 8192; }
    else { const int v = u - 512, x = v & 7, j = (v >> 3) & 31, r = v >> 8, g = (r * 8 + x) * 2 + (j >> 4);
      T = 4096; hh = g & 7; qblk = j & 15; seq_row0 = M_PROMPT + (g >> 3) * 4096; }
  } else if (MODE == 1) {
    if (u < 1024) { const int x = u & 7, j = (u >> 3) & 31, r = u >> 8;
      T = 8192; kvh = x & 3; hh = kvh * 4 + r; qblk = j; seq_row0 = (x >> 2) * 8192; }
    else { const int v = u - 1024, x = v & 7, j = (v >> 3) & 31, r = v >> 8, g = 8 * (r >> 1) + x;
      T = 4096; kvh = g & 3; hh = kvh * 4 + (r & 1) * 2 + (j >> 4); qblk = j & 15; seq_row0 = M_PROMPT + (g >> 2) * 4096; }
  } else {
    int r;
    if (u < 512) { T = 8192; seq_row0 = (u >> 8) * 8192; hh = (u >> 5) & 7; r = u & 31;
      if (r < 8) { cfg = 0; cls = 0; NB = 4; u0 = r * 1024; }
      else if (r < 16) { cfg = 1; cls = (r - 8) >> 1; NB = 4; u0 = ((r - 8) & 1) * 1024; }
      else { cfg = 2; cls = r - 16; NB = 2; u0 = 0; } }
    else { const int v = u - 512; T = 4096; seq_row0 = M_PROMPT + (v / 192) * 4096; hh = (v / 24) & 7; r = v % 24;
      if (r < 4) { cfg = 0; cls = 0; NB = 4; u0 = r * 1024; }
      else if (r < 8) { cfg = 1; cls = r - 4; NB = 4; u0 = 0; }
      else { cfg = 2; cls = r - 8; NB = 1; u0 = 0; } }
    dd = 1 << (2 * cfg); U = T >> (2 * cfg);
  }

  int mq = 0;
  bf16x8 qf[NC];
  float c2, slope2 = 0.f;
  if (MODE == 0) c2 = 0.10206207261596577f * LOG2E;
  else c2 = 0.125f * LOG2E;
  if (MODE == 2) slope2 = exp2f(-(float)(hh + 1)) * (float)dd * LOG2E;
  auto load_q = [&](int b) {
    const bf16_t* qp;
    if (MODE == 0) { mq = seq_row0 + qblk * 256 + wid * 32 + ql; qp = p.qb + (size_t)mq * 768 + hh * 96 + 8 * h; }
    else if (MODE == 1) { mq = seq_row0 + qblk * 256 + wid * 32 + ql; qp = p.proj + (size_t)mq * N_C + hh * 64 + 8 * h; }
    else { mq = seq_row0 + (u0 + b * 256 + wid * 32 + ql) * dd + cls; qp = p.proj + (size_t)mq * N_AB + hh * 64 + 8 * h; }
#pragma unroll
    for (int c = 0; c < NC; ++c) {
      u32x4 w = *(const u32x4*)(qp + 16 * c);
#pragma unroll
      for (int j = 0; j < 4; ++j) w[j] = pk_bf16(bflo(w[j]) * c2, bfhi(w[j]) * c2);
      qf[c] = __builtin_bit_cast(bf16x8, w);
    }
  };
  load_q(0);

  int kt_lo = 0, kt_hi;
  if (MODE == 2) { kt_lo = (u0 == 0) ? 0 : -1; kt_hi = (u0 + 256 * NB >= U) ? 4 * NB - 1 : 4 * NB; }
  else kt_hi = (T >> 6) - 1;
  const int n_it = kt_hi - kt_lo + 1;

  unsigned zero_v = 0u;
  asm volatile("" : "+v"(zero_v));
  const u32x4 zero4 = (u32x4){zero_v, zero_v, zero_v, zero_v};
  u32x4 ka0, ka1 = zero4, va, kb0, kb1 = zero4, vb;
  const int key = tid >> 3, kc = tid & 7;
  const int rkey = (tid >> 2) & 63, rc = tid & 3;
  unsigned koffg, roffg = 0, voffg;
  if (MODE == 0) { koffg = (unsigned)(key * 512 + 8 * kc) * 2u; roffg = (unsigned)(rkey * 32 + 8 * rc) * 2u; voffg = (unsigned)(key * T + 8 * kc) * 2u; }
  else if (MODE == 1) { koffg = (unsigned)(key * N_C + 8 * kc) * 2u; voffg = (unsigned)(key * T + 8 * kc) * 2u; }
  else { koffg = (unsigned)(key * dd * N_AB + 8 * kc) * 2u; voffg = koffg; }
  auto gloadK = [&](int kt, u32x4& kr0, u32x4& kr1) {
    if (MODE == 0) {
      const char* kb = (const char*)(p.knope + (size_t)(seq_row0 + 64 * kt) * 512 + hh * 64);
      const char* rb = (const char*)(p.krope + (size_t)(seq_row0 + 64 * kt) * 32);
      kr0 = *(const u32x4*)(kb + koffg);
      if (tid < 256) kr1 = *(const u32x4*)(rb + roffg);
    } else if (MODE == 1) {
      const char* kb = (const char*)(p.proj + (size_t)(seq_row0 + 64 * kt) * N_C + 1024 + kvh * 64);
      kr0 = *(const u32x4*)(kb + koffg);
    } else {
      const char* kb = (const char*)(p.proj + ((size_t)seq_row0 + (size_t)(u0 + 64 * kt) * dd + cls) * N_AB + 512 + hh * 64);
      kr0 = *(const u32x4*)(kb + koffg);
    }
  };
  auto gloadV = [&](int kt, u32x4& vr) {
    if (MODE == 0) {
      const char* vb = (const char*)(p.vbT + (size_t)seq_row0 * 512 + (size_t)(hh * 64) * T + 64 * kt);
      vr = *(const u32x4*)(vb + voffg);
    } else if (MODE == 1) {
      const char* vb = (const char*)(p.v1T + (size_t)seq_row0 * 256 + (size_t)(kvh * 64) * T + 64 * kt);
      vr = *(const u32x4*)(vb + voffg);
    } else {
      const char* vb = (const char*)(p.proj + ((size_t)seq_row0 + (size_t)(u0 + 64 * kt) * dd + cls) * N_AB + 1024 + hh * 64);
      vr = *(const u32x4*)(vb + voffg);
    }
  };
  auto lwriteK = [&](int stg, const u32x4& kr0, const u32x4& kr1) {
    char* ks = lds + stg * KTILE;
    *(u32x4*)(ks + key * KSTR + kc * 16) = kr0;
    if (MODE == 0) { if (tid < 256) *(u32x4*)(ks + rkey * KSTR + 128 + rc * 16) = kr1; }
  };
  auto lwriteV = [&](int slot, const u32x4& vr) {
    char* vs = lds + 3 * KTILE + slot * VTILE;
    if (MODE != 2) {
      *(u32x4*)(vs + key * VSTR + kc * 16) = vr;
    } else {
#pragma unroll
      for (int j = 0; j < 4; ++j) {
        *(bf16_t*)(vs + (8 * kc + 2 * j) * VSTR + key * 2) = (bf16_t)(vr[j] & 0xffffu);
        *(bf16_t*)(vs + (8 * kc + 2 * j + 1) * VSTR + key * 2) = (bf16_t)(vr[j] >> 16);
      }
    }
  };

  f32x16 o0, o1;
#pragma unroll
  for (int i = 0; i < 16; ++i) { o0[i] = 0.f; o1[i] = 0.f; }
  const int sq = (ql & ~12) | ((ql & 4) << 1) | ((ql & 8) >> 1);
  const int koff = sq * KSTR + h * 16, voff = 3 * KTILE + ql * VSTR + h * 16;
  float m_ref = 0.f, l_run = 0.f;
  bool fresh = true;
  bool zref = true;
  int cur_b = (MODE == 2) ? -1 : 0;
  auto qk = [&](int stg, f32x16& s0, f32x16& s1) {
    const char* kp = lds + stg * KTILE + koff;
#pragma unroll
    for (int i = 0; i < 16; ++i) { s0[i] = 0.f; s1[i] = 0.f; }
#pragma unroll
    for (int c = 0; c < NC; ++c) {
      const bf16x8 k0 = *(const bf16x8*)(kp + c * 32);
      const bf16x8 k1 = *(const bf16x8*)(kp + 32 * KSTR + c * 32);
      s0 = MFMA32(k0, qf[c], s0);
      s1 = MFMA32(k1, qf[c], s1);
    }
  };
  auto rowmax = [&](int kt, f32x16& s0, f32x16& s1) -> float {
    float mx = -1e30f;
    if (MODE == 2) {
      const int base = 64 * kt + 8 * h - (256 * cur_b + 32 * wid + ql);
#pragma unroll
      for (int i = 0; i < 16; ++i) {
        const int d0 = base + 16 * (i >> 3) + (i & 7);
        const int d1 = d0 + 32;
        const int a0 = d0 < 0 ? -d0 : d0, a1 = d1 < 0 ? -d1 : d1;
        s0[i] = (a0 <= 64) ? (s0[i] - slope2 * (float)a0) : -1e30f;
        s1[i] = (a1 <= 64) ? (s1[i] - slope2 * (float)a1) : -1e30f;
        mx = fmaxf(mx, fmaxf(s0[i], s1[i]));
      }
    } else {
#pragma unroll
      for (int i = 0; i < 16; ++i) mx = fmaxf(mx, fmaxf(s0[i], s1[i]));
    }
    return fmaxf(mx, __shfl_xor(mx, 32));
  };
  u32x4 pa[2], pb[2];
#pragma unroll
  for (int s = 0; s < 2; ++s) { pa[s] = zero4; pb[s] = zero4; }
  auto pv = [&](int slot) {
    const char* vp = lds + slot * VTILE + voff;
#pragma unroll
    for (int s = 0; s < 2; ++s) {
      const bf16x8 pfa = __builtin_bit_cast(bf16x8, pa[s]), pfb = __builtin_bit_cast(bf16x8, pb[s]);
      const bf16x8 va0 = *(const bf16x8*)(vp + s * 32);
      const bf16x8 va1 = *(const bf16x8*)(vp + 32 * VSTR + s * 32);
      const bf16x8 vb0 = *(const bf16x8*)(vp + 64 + s * 32);
      const bf16x8 vb1 = *(const bf16x8*)(vp + 32 * VSTR + 64 + s * 32);
      o0 = MFMA32(va0, pfa, o0);
      o1 = MFMA32(va1, pfa, o1);
      o0 = MFMA32(vb0, pfb, o0);
      o1 = MFMA32(vb1, pfb, o1);
    }
  };
  auto softmax = [&](f32x16& s0, f32x16& s1, float mxr) {
    const bool upd = fresh ? (__builtin_amdgcn_ballot_w64(fabsf(mxr) > 24.f && mxr > -1e29f) != 0ull)
                           : (__builtin_amdgcn_ballot_w64(mxr - m_ref > 24.f) != 0ull);
    if (upd) {
      const float delta = fresh ? ((mxr > -1e29f) ? mxr : 0.f) : fmaxf(mxr - m_ref, 0.f);
      const float alpha = fresh ? 0.f : __builtin_amdgcn_exp2f(-delta);
      m_ref += delta;
      zref = false;
      l_run *= alpha;
#pragma unroll
      for (int i = 0; i < 16; ++i) { o0[i] *= alpha; o1[i] *= alpha; }
    }
    fresh = false;
    if (!zref) {
#pragma unroll
      for (int i = 0; i < 16; ++i) { s0[i] -= m_ref; s1[i] -= m_ref; }
    }
    float ls = 0.f;
    if (MODE == 2) {
#pragma unroll
      for (int i = 0; i < 16; ++i) {
        s0[i] = (s0[i] > -1e29f) ? __builtin_amdgcn_exp2f(s0[i]) : 0.f;
        s1[i] = (s1[i] > -1e29f) ? __builtin_amdgcn_exp2f(s1[i]) : 0.f;
        ls += s0[i] + s1[i];
      }
    } else {
#pragma unroll
      for (int i = 0; i < 16; ++i) {
        s0[i] = __builtin_amdgcn_exp2f(s0[i]);
        s1[i] = __builtin_amdgcn_exp2f(s1[i]);
        ls += s0[i] + s1[i];
      }
    }
    l_run += ls;
#pragma unroll
    for (int s = 0; s < 2; ++s)
#pragma unroll
      for (int j = 0; j < 4; ++j) {
        pa[s][j] = pk_bf16(s0[8 * s + 2 * j], s0[8 * s + 2 * j + 1]);
        pb[s][j] = pk_bf16(s1[8 * s + 2 * j], s1[8 * s + 2 * j + 1]);
      }
  };
  auto wave_active = [&](int kt) -> bool {
    if (MODE != 2) return true;
    const int wc = wid >> 1;
    return (kt >= wc - 1) && (kt <= wc + 1);
  };
  const bool late = (MODE == 2) ? false : (((wid >> 1) & 1) != 0);

  __syncthreads();
  gloadK(kt_lo, ka0, ka1); gloadV(kt_lo, va);
  lwriteK(0, ka0, ka1); lwriteV(0, va);
  gloadK(kt_lo + 1, ka0, ka1);
  lwriteK(1, ka0, ka1);
  if (MODE != 2) *(u32x4*)(lds + 3 * KTILE + 2 * VTILE + key * VSTR + kc * 16) = zero4;
  gloadK(kt_lo + 2, ka0, ka1);
  gloadV(kt_lo + 1, va);
  __syncthreads();
  f32x16 s0, s1;
#pragma unroll
  for (int i = 0; i < 16; ++i) { s0[i] = 0.f; s1[i] = 0.f; }
  float mx = -1e30f;
  if (late) { qk(0, s0, s1); mx = rowmax(kt_lo, s0, s1); }
  int sl_c = 0;
  auto finalize2 = [&]() {
    const float l_tot = l_run + __shfl_xor(l_run, 32);
    const float inv = 1.f / l_tot;
    bf16_t* dst = p.pA + (size_t)cfg * M_TOK * 512 + (size_t)mq * 512 + hh * 64;
#pragma unroll
    for (int g = 0; g < 4; ++g) {
      const int d = 8 * g + 4 * h;
      u32x2 w0, w1;
      w0[0] = pk_bf16(o0[4 * g] * inv, o0[4 * g + 1] * inv); w0[1] = pk_bf16(o0[4 * g + 2] * inv, o0[4 * g + 3] * inv);
      w1[0] = pk_bf16(o1[4 * g] * inv, o1[4 * g + 1] * inv); w1[1] = pk_bf16(o1[4 * g + 2] * inv, o1[4 * g + 3] * inv);
      *(u32x2*)(dst + d) = w0;
      *(u32x2*)(dst + 32 + d) = w1;
    }
    if (h == 0) p.lse[(size_t)cfg * M_TOK * 8 + (size_t)mq * 8 + hh] = m_ref + __builtin_amdgcn_logf(l_tot);
  };
  auto step = [&](int it, u32x4& nk0, u32x4& nk1, u32x4& nv, const u32x4& ok0, const u32x4& ok1, const u32x4& ov) {
    const int kt = kt_lo + it;
    const int sl_p = (sl_c == 0) ? 2 : sl_c - 1, sl_n = (sl_c == 2) ? 0 : sl_c + 1;
    if (it + 3 < n_it) gloadK(kt + 3, nk0, nk1);
    if (it + 2 < n_it) gloadV(kt + 2, nv);
    if (MODE == 2) {
      const int rel = kt - ((wid >> 1) - 1);
      const int b = rel >> 2, pos = rel & 3;
      if (rel >= 0 && b < NB && pos < 3) {
        if (b != cur_b) {
          cur_b = b;
          load_q(b);
#pragma unroll
          for (int i = 0; i < 16; ++i) { o0[i] = 0.f; o1[i] = 0.f; }
          l_run = 0.f; m_ref = 0.f; fresh = true; zref = true;
        }
        qk(sl_c, s0, s1);
        mx = rowmax(kt, s0, s1);
        softmax(s0, s1, mx);
        pv(sl_c);
        if (pos == 2 || kt == kt_hi) finalize2();
      }
    } else if (late) {
      softmax(s0, s1, mx);
      __builtin_amdgcn_sched_barrier(0);
      pv(sl_c);
      qk(sl_n, s0, s1);
      mx = rowmax(kt + 1, s0, s1);
    } else {
      pv(sl_p);
      qk(sl_c, s0, s1);
      __builtin_amdgcn_sched_barrier(0);
      mx = rowmax(kt, s0, s1);
      softmax(s0, s1, mx);
    }
    if (it + 2 < n_it) lwriteK(sl_p, ok0, ok1);
    if (it + 1 < n_it) lwriteV(sl_n, ov);
    __syncthreads();
    sl_c = sl_n;
  };
  for (int it = 0; it < n_it; it += 2) {
    step(it, kb0, kb1, vb, ka0, ka1, va);
    if (MODE != 2 || it + 1 < n_it) step(it + 1, ka0, ka1, va, kb0, kb1, vb);
  }
  if (MODE != 2 && !late) pv((sl_c == 0) ? 2 : sl_c - 1);
  if (MODE != 2) {
  const float l_tot = l_run + __shfl_xor(l_run, 32);
  const float inv = 1.f / l_tot;
  {
    const bf16_t* gp; bf16_t* dst;
    if (MODE == 0) { gp = p.proj + (size_t)mq * LD0 + (416 + 512) + hh * 64; dst = p.h + (size_t)mq * 1024 + 512 + hh * 64; }
    else { gp = p.proj + (size_t)mq * N_C + 1536 + hh * 64; dst = p.h + (size_t)mq * 1024 + hh * 64; }
#pragma unroll
    for (int g = 0; g < 4; ++g) {
      const int d = 8 * g + 4 * h;
      const u32x2 g0 = *(const u32x2*)(gp + d), g1 = *(const u32x2*)(gp + 32 + d);
      u32x2 w0, w1;
      w0[0] = pk_bf16(o0[4 * g] * inv * bflo(g0[0]), o0[4 * g + 1] * inv * bfhi(g0[0]));
      w0[1] = pk_bf16(o0[4 * g + 2] * inv * bflo(g0[1]), o0[4 * g + 3] * inv * bfhi(g0[1]));
      w1[0] = pk_bf16(o1[4 * g] * inv * bflo(g1[0]), o1[4 * g + 1] * inv * bfhi(g1[0]));
      w1[1] = pk_bf16(o1[4 * g + 2] * inv * bflo(g1[1]), o1[4 * g + 3] * inv * bfhi(g1[1]));
      *(u32x2*)(dst + d) = w0;
      *(u32x2*)(dst + 32 + d) = w1;
    }
  }
  }
}

template <int MODE>
DI void attn_dense(const Params& p, int u, char* lds) {
  constexpr int DQK = (MODE == 0) ? 96 : 64;
  constexpr int NC = DQK / 16;
  constexpr int KSTR = DQK * 2 + 16;
  constexpr int KTILE = 64 * KSTR;
  constexpr int VSTR = 144, VTILE = 64 * VSTR;
  const int tid = fresh_tid(), lane = tid & 63, wid = __builtin_amdgcn_readfirstlane(tid >> 6), ql = lane & 31, h = lane >> 5;

  int T, seq_row0, hh, qblk, kvh = 0;
  if (MODE == 0) {
    if (u < 512) { const int x = u & 7, j = (u >> 3) & 31, r = u >> 8, g = r * 8 + x;
      T = 8192; hh = g & 7; qblk = j; seq_row0 = (g >> 3) * 8192; }
    else { const int v = u - 512, x = v & 7, j = (v >> 3) & 31, r = v >> 8, g = (r * 8 + x) * 2 + (j >> 4);
      T = 4096; hh = g & 7; qblk = j & 15; seq_row0 = M_PROMPT + (g >> 3) * 4096; }
  } else {
    if (u < 1024) { const int x = u & 7, j = (u >> 3) & 31, r = u >> 8;
      T = 8192; kvh = x & 3; hh = kvh * 4 + r; qblk = j; seq_row0 = (x >> 2) * 8192; }
    else { const int v = u - 1024, x = v & 7, j = (v >> 3) & 31, r = v >> 8, g = 8 * (r >> 1) + x;
      T = 4096; kvh = g & 3; hh = kvh * 4 + (r & 1) * 2 + (j >> 4); qblk = j & 15; seq_row0 = M_PROMPT + (g >> 2) * 4096; }
  }
  const int mq = seq_row0 + qblk * 256 + wid * 32 + ql;
  const float c2 = (MODE == 0) ? 0.10206207261596577f * LOG2E : 0.125f * LOG2E;
  bf16x8 qf[NC];
  {
    const bf16_t* qp = (MODE == 0) ? p.qb + (size_t)mq * 768 + hh * 96 + 8 * h : p.proj + (size_t)mq * N_C + hh * 64 + 8 * h;
#pragma unroll
    for (int c = 0; c < NC; ++c) {
      u32x4 w = *(const u32x4*)(qp + 16 * c);
#pragma unroll
      for (int j = 0; j < 4; ++j) w[j] = pk_bf16(bflo(w[j]) * c2, bfhi(w[j]) * c2);
      qf[c] = __builtin_bit_cast(bf16x8, w);
    }
  }
  const int n_it = T >> 6;

  unsigned zero_v = 0u;
  asm volatile("" : "+v"(zero_v));
  const u32x4 zero4 = (u32x4){zero_v, zero_v, zero_v, zero_v};
  u32x4 kr0, kr1 = zero4, vr;
  const int key = tid >> 3, kc = tid & 7;
  const int rkey = (tid >> 2) & 63, rc = tid & 3;
  const unsigned koffg = (MODE == 0) ? (unsigned)(key * 512 + 8 * kc) * 2u : (unsigned)(key * N_C + 8 * kc) * 2u;
  const unsigned roffg = (unsigned)(rkey * 32 + 8 * rc) * 2u;
  const unsigned voffg = (unsigned)(key * T + 8 * kc) * 2u;
  auto gloadK = [&](int kt) {
    if (MODE == 0) {
      const char* kb = (const char*)(p.knope + (size_t)(seq_row0 + 64 * kt) * 512 + hh * 64);
      const char* rb = (const char*)(p.krope + (size_t)(seq_row0 + 64 * kt) * 32);
      kr0 = *(const u32x4*)(kb + koffg);
      if (tid < 256) kr1 = *(const u32x4*)(rb + roffg);
    } else {
      const char* kb = (const char*)(p.proj + (size_t)(seq_row0 + 64 * kt) * N_C + 1024 + kvh * 64);
      kr0 = *(const u32x4*)(kb + koffg);
    }
  };
  auto gloadV = [&](int kt) {
    const char* vb = (MODE == 0) ? (const char*)(p.vbT + (size_t)seq_row0 * 512 + (size_t)(hh * 64) * T + 64 * kt)
                                 : (const char*)(p.v1T + (size_t)seq_row0 * 256 + (size_t)(kvh * 64) * T + 64 * kt);
    vr = *(const u32x4*)(vb + voffg);
  };
  const int lwk = key * KSTR + kc * 16, lwr = rkey * KSTR + 128 + rc * 16, lwv = 3 * KTILE + key * VSTR + kc * 16;
  auto lwriteK = [&](int slot) {
    *(u32x4*)(lds + slot * KTILE + lwk) = kr0;
    if (MODE == 0) { if (tid < 256) *(u32x4*)(lds + slot * KTILE + lwr) = kr1; }
  };
  auto lwriteV = [&](int slot) { *(u32x4*)(lds + slot * VTILE + lwv) = vr; };

  f32x16 o0, o1;
#pragma unroll
  for (int i = 0; i < 16; ++i) { o0[i] = 0.f; o1[i] = 0.f; }
  const int sq = (ql & ~12) | ((ql & 4) << 1) | ((ql & 8) >> 1);
  const int koff = sq * KSTR + h * 16, voff = 3 * KTILE + ql * VSTR + h * 16;
  float m_ref = 0.f, l_run = 0.f;
  bool zref = true;
  u32x4 pa0 = zero4, pa1 = zero4, pb0 = zero4, pb1 = zero4;

  __syncthreads();
  gloadK(0); gloadV(0);
  lwriteK(0); lwriteV(0);
  gloadK(1);
  lwriteK(1);
  *(u32x4*)(lds + 2 * VTILE + lwv) = zero4;
  __syncthreads();
  {
    const char* kp = lds + koff;
    f32x16 t0, t1;
#pragma unroll
    for (int i = 0; i < 16; ++i) { t0[i] = 0.f; t1[i] = 0.f; }
#pragma unroll
    for (int c = 0; c < NC; ++c) {
      t0 = MFMA32(*(const bf16x8*)(kp + c * 32), qf[c], t0);
      t1 = MFMA32(*(const bf16x8*)(kp + 32 * KSTR + c * 32), qf[c], t1);
    }
    float mx = -1e30f;
#pragma unroll
    for (int i = 0; i < 16; ++i) mx = fmax_nc(mx, fmax_nc(t0[i], t1[i]));
    mx = fmax_nc(mx, __shfl_xor(mx, 32));
    if (__builtin_amdgcn_ballot_w64(fabsf(mx) > 24.f) != 0ull) { m_ref = mx; zref = false; }
  }
  int sl_c = 0;
  for (int it = 0; it < n_it; ++it) {
    const int sl_p = (sl_c == 0) ? 2 : sl_c - 1, sl_n = (sl_c == 2) ? 0 : sl_c + 1;
    if (it + 2 < n_it) gloadK(it + 2);
    if (it + 1 < n_it) gloadV(it + 1);
    const char* kp = lds + sl_c * KTILE + koff;
    const char* vp = lds + sl_p * VTILE + voff;
    {
      const bf16x8 pf0 = __builtin_bit_cast(bf16x8, pa0), pf1 = __builtin_bit_cast(bf16x8, pb0);
      const bf16x8 pf2 = __builtin_bit_cast(bf16x8, pa1), pf3 = __builtin_bit_cast(bf16x8, pb1);
      o0 = MFMA32(*(const bf16x8*)(vp), pf0, o0);
      o1 = MFMA32(*(const bf16x8*)(vp + 32 * VSTR), pf0, o1);
      o0 = MFMA32(*(const bf16x8*)(vp + 64), pf1, o0);
      o1 = MFMA32(*(const bf16x8*)(vp + 32 * VSTR + 64), pf1, o1);
      o0 = MFMA32(*(const bf16x8*)(vp + 32), pf2, o0);
      o1 = MFMA32(*(const bf16x8*)(vp + 32 * VSTR + 32), pf2, o1);
      o0 = MFMA32(*(const bf16x8*)(vp + 64 + 32), pf3, o0);
      o1 = MFMA32(*(const bf16x8*)(vp + 32 * VSTR + 64 + 32), pf3, o1);
    }
    f32x16 s0, s1;
#pragma unroll
    for (int i = 0; i < 16; ++i) { s0[i] = 0.f; s1[i] = 0.f; }
#pragma unroll
    for (int c = 0; c < NC; ++c) {
      s0 = MFMA32(*(const bf16x8*)(kp + c * 32), qf[c], s0);
      s1 = MFMA32(*(const bf16x8*)(kp + 32 * KSTR + c * 32), qf[c], s1);
    }
    if (!zref) {
#pragma unroll
      for (int i = 0; i < 16; ++i) { s0[i] -= m_ref; s1[i] -= m_ref; }
    }
    float ls = 0.f;
#pragma unroll
    for (int i = 0; i < 16; ++i) {
      s0[i] = __builtin_amdgcn_exp2f(s0[i]);
      s1[i] = __builtin_amdgcn_exp2f(s1[i]);
      ls += s0[i] + s1[i];
    }
    if (__builtin_amdgcn_ballot_w64(!(ls < 1e30f)) != 0ull) {
#pragma unroll
      for (int i = 0; i < 16; ++i) { s0[i] = 0.f; s1[i] = 0.f; }
#pragma unroll
      for (int c = 0; c < NC; ++c) {
        s0 = MFMA32(*(const bf16x8*)(kp + c * 32), qf[c], s0);
        s1 = MFMA32(*(const bf16x8*)(kp + 32 * KSTR + c * 32), qf[c], s1);
      }
      float mx = -1e30f;
#pragma unroll
      for (int i = 0; i < 16; ++i) mx = fmaxf(mx, fmaxf(s0[i], s1[i]));
      mx = fmaxf(mx, __shfl_xor(mx, 32));
      const float delta = fmaxf(mx - m_ref, 0.f);
      const float alpha = __builtin_amdgcn_exp2f(-delta);
      m_ref += delta;
      zref = false;
      l_run *= alpha;
#pragma unroll
      for (int i = 0; i < 16; ++i) { o0[i] *= alpha; o1[i] *= alpha; }
      ls = 0.f;
#pragma unroll
      for (int i = 0; i < 16; ++i) {
        s0[i] = __builtin_amdgcn_exp2f(s0[i] - m_ref);
        s1[i] = __builtin_amdgcn_exp2f(s1[i] - m_ref);
        ls += s0[i] + s1[i];
      }
    }
    l_run += ls;
#pragma unroll
    for (int j = 0; j < 4; ++j) {
      pa0[j] = pk_bf16(s0[2 * j], s0[2 * j + 1]);
      pa1[j] = pk_bf16(s0[8 + 2 * j], s0[8 + 2 * j + 1]);
      pb0[j] = pk_bf16(s1[2 * j], s1[2 * j + 1]);
      pb1[j] = pk_bf16(s1[8 + 2 * j], s1[8 + 2 * j + 1]);
    }
    if (it + 2 < n_it) lwriteK(sl_p);
    if (it + 1 < n_it) lwriteV(sl_n);
    __syncthreads();
    sl_c = sl_n;
  }
  {
    const char* vp = lds + ((sl_c == 0) ? 2 : sl_c - 1) * VTILE + voff;
    const bf16x8 pf0 = __builtin_bit_cast(bf16x8, pa0), pf1 = __builtin_bit_cast(bf16x8, pb0);
    const bf16x8 pf2 = __builtin_bit_cast(bf16x8, pa1), pf3 = __builtin_bit_cast(bf16x8, pb1);
    o0 = MFMA32(*(const bf16x8*)(vp), pf0, o0);
    o1 = MFMA32(*(const bf16x8*)(vp + 32 * VSTR), pf0, o1);
    o0 = MFMA32(*(const bf16x8*)(vp + 64), pf1, o0);
    o1 = MFMA32(*(const bf16x8*)(vp + 32 * VSTR + 64), pf1, o1);
    o0 = MFMA32(*(const bf16x8*)(vp + 32), pf2, o0);
    o1 = MFMA32(*(const bf16x8*)(vp + 32 * VSTR + 32), pf2, o1);
    o0 = MFMA32(*(const bf16x8*)(vp + 64 + 32), pf3, o0);
    o1 = MFMA32(*(const bf16x8*)(vp + 32 * VSTR + 64 + 32), pf3, o1);
  }
  const float l_tot = l_run + __shfl_xor(l_run, 32);
  const float inv = 1.f / l_tot;
  const bf16_t* gp; bf16_t* dst;
  if (MODE == 0) { gp = p.proj + (size_t)mq * LD0 + (416 + 512) + hh * 64; dst = p.h + (size_t)mq * 1024 + 512 + hh * 64; }
  else { gp = p.proj + (size_t)mq * N_C + 1536 + hh * 64; dst = p.h + (size_t)mq * 1024 + hh * 64; }
#pragma unroll
  for (int g = 0; g < 4; ++g) {
    const int d = 8 * g + 4 * h;
    const u32x2 g0 = *(const u32x2*)(gp + d), g1 = *(const u32x2*)(gp + 32 + d);
    u32x2 w0, w1;
    w0[0] = pk_bf16(o0[4 * g] * inv * bflo(g0[0]), o0[4 * g + 1] * inv * bfhi(g0[0]));
    w0[1] = pk_bf16(o0[4 * g + 2] * inv * bflo(g0[1]), o0[4 * g + 3] * inv * bfhi(g0[1]));
    w1[0] = pk_bf16(o1[4 * g] * inv * bflo(g1[0]), o1[4 * g + 1] * inv * bfhi(g1[0]));
    w1[1] = pk_bf16(o1[4 * g + 2] * inv * bflo(g1[1]), o1[4 * g + 3] * inv * bfhi(g1[1]));
    *(u32x2*)(dst + d) = w0;
    *(u32x2*)(dst + 32 + d) = w1;
  }
}

template <int MODE, bool SPLIT = false, bool PIPE = false>
DI void attn_dense128(const Params& p, int u, char* lds) {
  constexpr int DQK = (MODE == 0) ? 96 : 64;
  constexpr int NC = DQK / 16;
  constexpr int KSTR = DQK * 2 + 16;
  constexpr int KTILE = 128 * KSTR;
  constexpr int VSTR = 272, VTILE = 64 * VSTR;
  const int tid = fresh_tid(), lane = tid & 63, wid = __builtin_amdgcn_readfirstlane(tid >> 6), ql = lane & 31, h = lane >> 5;

  int T, seq_row0, hh, qblk, kvh = 0;
  if (MODE == 0) {
    if (u < 512) { const int x = u & 7, j = (u >> 3) & 31, r = u >> 8, g = r * 8 + x;
      T = 8192; hh = g & 7; qblk = j; seq_row0 = (g >> 3) * 8192; }
    else { const int v = u - 512, x = v & 7, j = (v >> 3) & 31, r = v >> 8, g = (r * 8 + x) * 2 + (j >> 4);
      T = 4096; hh = g & 7; qblk = j & 15; seq_row0 = M_PROMPT + (g >> 3) * 4096; }
  } else {
    if (u < 1024) { const int x = u & 7, j = (u >> 3) & 31, r = u >> 8;
      T = 8192; kvh = x & 3; hh = kvh * 4 + r; qblk = j; seq_row0 = (x >> 2) * 8192; }
    else { const int v = u - 1024, x = v & 7, j = (v >> 3) & 31, r = v >> 8, g = 8 * (r >> 1) + x;
      T = 4096; kvh = g & 3; hh = kvh * 4 + (r & 1) * 2 + (j >> 4); qblk = j & 15; seq_row0 = M_PROMPT + (g >> 2) * 4096; }
  }
  const int mq = seq_row0 + qblk * 256 + wid * 32 + ql;
  const float c2 = (MODE == 0) ? 0.10206207261596577f * LOG2E : 0.125f * LOG2E;
  bf16x8 qf[NC];
  {
    const bf16_t* qp = (MODE == 0) ? p.qb + (size_t)mq * 768 + hh * 96 + 8 * h : p.proj + (size_t)mq * N_C + hh * 64 + 8 * h;
#pragma unroll
    for (int c = 0; c < NC; ++c) {
      u32x4 w = *(const u32x4*)(qp + 16 * c);
#pragma unroll
      for (int j = 0; j < 4; ++j) w[j] = pk_bf16(bflo(w[j]) * c2, bfhi(w[j]) * c2);
      qf[c] = __builtin_bit_cast(bf16x8, w);
    }
  }
  const int n_it = T >> 7;

  unsigned zero_v = 0u;
  asm volatile("" : "+v"(zero_v));
  const u32x4 zero4 = (u32x4){zero_v, zero_v, zero_v, zero_v};
  u32x4 kr0, kr1, kr2 = zero4, vr0, vr1;
  const int key = tid >> 3, kc = tid & 7;
  const int rkey = tid >> 2, rc = tid & 3;
  const int vd = tid >> 4, vc = tid & 15;
  const unsigned koffg = (MODE == 0) ? (unsigned)(key * 512 + 8 * kc) * 2u : (unsigned)(key * N_C + 8 * kc) * 2u;
  const unsigned koffg2 = (MODE == 0) ? 64u * 512u * 2u : 64u * (unsigned)N_C * 2u;
  const unsigned roffg = (unsigned)(rkey * 32 + 8 * rc) * 2u;
  const unsigned voffg = (unsigned)(vd * T + 8 * vc) * 2u, voffg2 = (unsigned)(32 * T) * 2u;
  auto gloadK = [&](int kt) {
    if (MODE == 0) {
      const char* kb = (const char*)(p.knope + (size_t)(seq_row0 + 128 * kt) * 512 + hh * 64);
      const char* rb = (const char*)(p.krope + (size_t)(seq_row0 + 128 * kt) * 32);
      kr0 = *(const u32x4*)(kb + koffg);
      kr1 = *(const u32x4*)(kb + koffg + koffg2);
      kr2 = *(const u32x4*)(rb + roffg);
    } else {
      const char* kb = (const char*)(p.proj + (size_t)(seq_row0 + 128 * kt) * N_C + 1024 + kvh * 64);
      kr0 = *(const u32x4*)(kb + koffg);
      kr1 = *(const u32x4*)(kb + koffg + koffg2);
    }
  };
  auto gloadV = [&](int kt) {
    const char* vb = (MODE == 0) ? (const char*)(p.vbT + (size_t)seq_row0 * 512 + (size_t)(hh * 64) * T + 128 * kt)
                                 : (const char*)(p.v1T + (size_t)seq_row0 * 256 + (size_t)(kvh * 64) * T + 128 * kt);
    vr0 = *(const u32x4*)(vb + voffg);
    vr1 = *(const u32x4*)(vb + voffg + voffg2);
  };
  const int lwk = key * KSTR + kc * 16, lwr = rkey * KSTR + 128 + rc * 16, lwv = 3 * KTILE + vd * VSTR + vc * 16;
  auto lwriteK = [&](int slot) {
    *(u32x4*)(lds + slot * KTILE + lwk) = kr0;
    *(u32x4*)(lds + slot * KTILE + lwk + 64 * KSTR) = kr1;
    if (MODE == 0) *(u32x4*)(lds + slot * KTILE + lwr) = kr2;
  };
  auto lwriteV = [&](int slot) {
    *(u32x4*)(lds + slot * VTILE + lwv) = vr0;
    *(u32x4*)(lds + slot * VTILE + lwv + 32 * VSTR) = vr1;
  };

  f32x16 o0, o1;
#pragma unroll
  for (int i = 0; i < 16; ++i) { o0[i] = 0.f; o1[i] = 0.f; }
  const int sq = (ql & ~12) | ((ql & 4) << 1) | ((ql & 8) >> 1);
  const int koff = sq * KSTR + h * 16, voff = 3 * KTILE + ql * VSTR + h * 16;
  float m_ref = 0.f, l_run = 0.f;
  bool zref = true;
  u32x4 pk[4][2];
#pragma unroll
  for (int b = 0; b < 4; ++b) { pk[b][0] = zero4; pk[b][1] = zero4; }

  __syncthreads();
  gloadK(0); gloadV(0);
  lwriteK(0); lwriteV(0);
  gloadK(1);
  lwriteK(1);
  *(u32x4*)(lds + 2 * VTILE + lwv) = zero4;
  *(u32x4*)(lds + 2 * VTILE + lwv + 32 * VSTR) = zero4;
  __syncthreads();
  f32x16 t0, t1;
  {
    const char* kp = lds + koff;
#pragma unroll
    for (int i = 0; i < 16; ++i) { t0[i] = 0.f; t1[i] = 0.f; }
#pragma unroll
    for (int c = 0; c < NC; ++c) {
      t0 = MFMA32(*(const bf16x8*)(kp + c * 32), qf[c], t0);
      t1 = MFMA32(*(const bf16x8*)(kp + 32 * KSTR + c * 32), qf[c], t1);
    }
    float mx = -1e30f;
#pragma unroll
    for (int i = 0; i < 16; ++i) mx = fmax_nc(mx, fmax_nc(t0[i], t1[i]));
    mx = fmax_nc(mx, __shfl_xor(mx, 32));
    if (__builtin_amdgcn_ballot_w64(fabsf(mx) > 24.f) != 0ull) { m_ref = mx; zref = false; }
  }
  if (PIPE) {
    u32x4 qa0 = zero4, qa1 = zero4, qb0 = zero4, qb1 = zero4;
    f32x16 sA0 = t0, sA1 = t1, sB0, sB1;
    auto half_step = [&](f32x16& c0, f32x16& c1, f32x16& n0, f32x16& n1, const char* kp_next, const char* vp_prev, const char* kp_cur) {
      if (!zref) {
#pragma unroll
        for (int i = 0; i < 16; ++i) { c0[i] -= m_ref; c1[i] -= m_ref; }
      }
      {
        const bf16x8 pf0 = __builtin_bit_cast(bf16x8, qa0), pf1 = __builtin_bit_cast(bf16x8, qb0);
        const bf16x8 pf2 = __builtin_bit_cast(bf16x8, qa1), pf3 = __builtin_bit_cast(bf16x8, qb1);
        o0 = MFMA32(*(const bf16x8*)(vp_prev), pf0, o0);
        o1 = MFMA32(*(const bf16x8*)(vp_prev + 32 * VSTR), pf0, o1);
        o0 = MFMA32(*(const bf16x8*)(vp_prev + 64), pf1, o0);
        o1 = MFMA32(*(const bf16x8*)(vp_prev + 32 * VSTR + 64), pf1, o1);
        o0 = MFMA32(*(const bf16x8*)(vp_prev + 32), pf2, o0);
        o1 = MFMA32(*(const bf16x8*)(vp_prev + 32 * VSTR + 32), pf2, o1);
        o0 = MFMA32(*(const bf16x8*)(vp_prev + 64 + 32), pf3, o0);
        o1 = MFMA32(*(const bf16x8*)(vp_prev + 32 * VSTR + 64 + 32), pf3, o1);
      }
#pragma unroll
      for (int i = 0; i < 16; ++i) { n0[i] = 0.f; n1[i] = 0.f; }
#pragma unroll
      for (int c = 0; c < NC; ++c) {
        n0 = MFMA32(*(const bf16x8*)(kp_next + c * 32), qf[c], n0);
        n1 = MFMA32(*(const bf16x8*)(kp_next + 32 * KSTR + c * 32), qf[c], n1);
      }
      float ls = 0.f;
#pragma unroll
      for (int i = 0; i < 16; ++i) {
        c0[i] = __builtin_amdgcn_exp2f(c0[i]);
        c1[i] = __builtin_amdgcn_exp2f(c1[i]);
        ls += c0[i] + c1[i];
      }
#pragma unroll
      for (int g = 0; g < 2 * NC + 8; ++g) {
        __builtin_amdgcn_sched_group_barrier(0x008, 1, 0);
        __builtin_amdgcn_sched_group_barrier(0x002, (MODE == 0) ? 3 : 4, 0);
      }
      if (__builtin_amdgcn_ballot_w64(!(ls < 1e30f)) != 0ull) {
        const float m_old = m_ref;
#pragma unroll
        for (int i = 0; i < 16; ++i) { c0[i] = 0.f; c1[i] = 0.f; }
#pragma unroll
        for (int c = 0; c < NC; ++c) {
          c0 = MFMA32(*(const bf16x8*)(kp_cur + c * 32), qf[c], c0);
          c1 = MFMA32(*(const bf16x8*)(kp_cur + 32 * KSTR + c * 32), qf[c], c1);
        }
        float mx = -1e30f;
#pragma unroll
        for (int i = 0; i < 16; ++i) mx = fmaxf(mx, fmaxf(c0[i], c1[i]));
        mx = fmaxf(mx, __shfl_xor(mx, 32));
        const float delta = fmaxf(mx - m_ref, 0.f);
        const float alpha = __builtin_amdgcn_exp2f(-delta);
        m_ref += delta;
        zref = false;
        l_run *= alpha;
#pragma unroll
        for (int i = 0; i < 16; ++i) { o0[i] *= alpha; o1[i] *= alpha; }
        ls = 0.f;
#pragma unroll
        for (int i = 0; i < 16; ++i) {
          c0[i] = __builtin_amdgcn_exp2f(c0[i] - m_ref);
          c1[i] = __builtin_amdgcn_exp2f(c1[i] - m_ref);
          ls += c0[i] + c1[i];
        }
        (void)m_old;
      }
      l_run += ls;
#pragma unroll
      for (int j = 0; j < 4; ++j) {
        qa0[j] = pk_bf16(c0[2 * j], c0[2 * j + 1]);
        qa1[j] = pk_bf16(c0[8 + 2 * j], c0[8 + 2 * j + 1]);
        qb0[j] = pk_bf16(c1[2 * j], c1[2 * j + 1]);
        qb1[j] = pk_bf16(c1[8 + 2 * j], c1[8 + 2 * j + 1]);
      }
    };
    int sl_c = 0;
    for (int it = 0; it < n_it; ++it) {
      const int sl_p = (sl_c == 0) ? 2 : sl_c - 1, sl_n = (sl_c == 2) ? 0 : sl_c + 1;
      if (it + 2 < n_it) gloadK(it + 2);
      if (it + 1 < n_it) gloadV(it + 1);
      half_step(sA0, sA1, sB0, sB1, lds + sl_c * KTILE + 64 * KSTR + koff, lds + sl_p * VTILE + voff + 128, lds + sl_c * KTILE + koff);
      half_step(sB0, sB1, sA0, sA1, lds + sl_n * KTILE + koff, lds + sl_c * VTILE + voff, lds + sl_c * KTILE + 64 * KSTR + koff);
      if (it + 2 < n_it) lwriteK(sl_p);
      if (it + 1 < n_it) lwriteV(sl_n);
      __syncthreads();
      sl_c = sl_n;
    }
    {
      const char* vp = lds + ((sl_c == 0) ? 2 : sl_c - 1) * VTILE + voff + 128;
      const bf16x8 pf0 = __builtin_bit_cast(bf16x8, qa0), pf1 = __builtin_bit_cast(bf16x8, qb0);
      const bf16x8 pf2 = __builtin_bit_cast(bf16x8, qa1), pf3 = __builtin_bit_cast(bf16x8, qb1);
      o0 = MFMA32(*(const bf16x8*)(vp), pf0, o0);
      o1 = MFMA32(*(const bf16x8*)(vp + 32 * VSTR), pf0, o1);
      o0 = MFMA32(*(const bf16x8*)(vp + 64), pf1, o0);
      o1 = MFMA32(*(const bf16x8*)(vp + 32 * VSTR + 64), pf1, o1);
      o0 = MFMA32(*(const bf16x8*)(vp + 32), pf2, o0);
      o1 = MFMA32(*(const bf16x8*)(vp + 32 * VSTR + 32), pf2, o1);
      o0 = MFMA32(*(const bf16x8*)(vp + 64 + 32), pf3, o0);
      o1 = MFMA32(*(const bf16x8*)(vp + 32 * VSTR + 64 + 32), pf3, o1);
    }
  } else if (SPLIT) {
    u32x4 qa0 = zero4, qa1 = zero4, qb0 = zero4, qb1 = zero4;
    int sl_c = 0;
    for (int it = 0; it < n_it; ++it) {
      const int sl_p = (sl_c == 0) ? 2 : sl_c - 1, sl_n = (sl_c == 2) ? 0 : sl_c + 1;
      if (it + 2 < n_it) gloadK(it + 2);
      if (it + 1 < n_it) gloadV(it + 1);
#pragma unroll
      for (int hf = 0; hf < 2; ++hf) {
        const char* kp = lds + sl_c * KTILE + hf * 64 * KSTR + koff;
        const char* vp = lds + ((hf == 0) ? sl_p : sl_c) * VTILE + voff + (1 - hf) * 128;
        {
          const bf16x8 pf0 = __builtin_bit_cast(bf16x8, qa0), pf1 = __builtin_bit_cast(bf16x8, qb0);
          const bf16x8 pf2 = __builtin_bit_cast(bf16x8, qa1), pf3 = __builtin_bit_cast(bf16x8, qb1);
          o0 = MFMA32(*(const bf16x8*)(vp), pf0, o0);
          o1 = MFMA32(*(const bf16x8*)(vp + 32 * VSTR), pf0, o1);
          o0 = MFMA32(*(const bf16x8*)(vp + 64), pf1, o0);
          o1 = MFMA32(*(const bf16x8*)(vp + 32 * VSTR + 64), pf1, o1);
          o0 = MFMA32(*(const bf16x8*)(vp + 32), pf2, o0);
          o1 = MFMA32(*(const bf16x8*)(vp + 32 * VSTR + 32), pf2, o1);
          o0 = MFMA32(*(const bf16x8*)(vp + 64 + 32), pf3, o0);
          o1 = MFMA32(*(const bf16x8*)(vp + 32 * VSTR + 64 + 32), pf3, o1);
        }
        f32x16 s0, s1;
#pragma unroll
        for (int i = 0; i < 16; ++i) { s0[i] = 0.f; s1[i] = 0.f; }
#pragma unroll
        for (int c = 0; c < NC; ++c) {
          s0 = MFMA32(*(const bf16x8*)(kp + c * 32), qf[c], s0);
          s1 = MFMA32(*(const bf16x8*)(kp + 32 * KSTR + c * 32), qf[c], s1);
        }
        if (!zref) {
#pragma unroll
          for (int i = 0; i < 16; ++i) { s0[i] -= m_ref; s1[i] -= m_ref; }
        }
        float ls = 0.f;
#pragma unroll
        for (int i = 0; i < 16; ++i) {
          s0[i] = __builtin_amdgcn_exp2f(s0[i]);
          s1[i] = __builtin_amdgcn_exp2f(s1[i]);
          ls += s0[i] + s1[i];
        }
        if (__builtin_amdgcn_ballot_w64(!(ls < 1e30f)) != 0ull) {
#pragma unroll
          for (int i = 0; i < 16; ++i) { s0[i] = 0.f; s1[i] = 0.f; }
#pragma unroll
          for (int c = 0; c < NC; ++c) {
            s0 = MFMA32(*(const bf16x8*)(kp + c * 32), qf[c], s0);
            s1 = MFMA32(*(const bf16x8*)(kp + 32 * KSTR + c * 32), qf[c], s1);
          }
          float mx = -1e30f;
#pragma unroll
          for (int i = 0; i < 16; ++i) mx = fmaxf(mx, fmaxf(s0[i], s1[i]));
          mx = fmaxf(mx, __shfl_xor(mx, 32));
          const float delta = fmaxf(mx - m_ref, 0.f);
          const float alpha = __builtin_amdgcn_exp2f(-delta);
          m_ref += delta;
          zref = false;
          l_run *= alpha;
#pragma unroll
          for (int i = 0; i < 16; ++i) { o0[i] *= alpha; o1[i] *= alpha; }
          ls = 0.f;
#pragma unroll
          for (int i = 0; i < 16; ++i) {
            s0[i] = __builtin_amdgcn_exp2f(s0[i] - m_ref);
            s1[i] = __builtin_amdgcn_exp2f(s1[i] - m_ref);
            ls += s0[i] + s1[i];
          }
        }
        l_run += ls;
#pragma unroll
        for (int j = 0; j < 4; ++j) {
          qa0[j] = pk_bf16(s0[2 * j], s0[2 * j + 1]);
          qa1[j] = pk_bf16(s0[8 + 2 * j], s0[8 + 2 * j + 1]);
          qb0[j] = pk_bf16(s1[2 * j], s1[2 * j + 1]);
          qb1[j] = pk_bf16(s1[8 + 2 * j], s1[8 + 2 * j + 1]);
        }
      }
      if (it + 2 < n_it) lwriteK(sl_p);
      if (it + 1 < n_it) lwriteV(sl_n);
      __syncthreads();
      sl_c = sl_n;
    }
    {
      const char* vp = lds + ((sl_c == 0) ? 2 : sl_c - 1) * VTILE + voff + 128;
      const bf16x8 pf0 = __builtin_bit_cast(bf16x8, qa0), pf1 = __builtin_bit_cast(bf16x8, qb0);
      const bf16x8 pf2 = __builtin_bit_cast(bf16x8, qa1), pf3 = __builtin_bit_cast(bf16x8, qb1);
      o0 = MFMA32(*(const bf16x8*)(vp), pf0, o0);
      o1 = MFMA32(*(const bf16x8*)(vp + 32 * VSTR), pf0, o1);
      o0 = MFMA32(*(const bf16x8*)(vp + 64), pf1, o0);
      o1 = MFMA32(*(const bf16x8*)(vp + 32 * VSTR + 64), pf1, o1);
      o0 = MFMA32(*(const bf16x8*)(vp + 32), pf2, o0);
      o1 = MFMA32(*(const bf16x8*)(vp + 32 * VSTR + 32), pf2, o1);
      o0 = MFMA32(*(const bf16x8*)(vp + 64 + 32), pf3, o0);
      o1 = MFMA32(*(const bf16x8*)(vp + 32 * VSTR + 64 + 32), pf3, o1);
    }
  } else {
  int sl_c = 0;
  for (int it = 0; it < n_it; ++it) {
    const int sl_p = (sl_c == 0) ? 2 : sl_c - 1, sl_n = (sl_c == 2) ? 0 : sl_c + 1;
    if (it + 2 < n_it) gloadK(it + 2);
    if (it + 1 < n_it) gloadV(it + 1);
    const char* kp = lds + sl_c * KTILE + koff;
    const char* vp = lds + sl_p * VTILE + voff;
#pragma unroll
    for (int b = 0; b < 4; ++b)
#pragma unroll
      for (int s = 0; s < 2; ++s) {
        const bf16x8 pf = __builtin_bit_cast(bf16x8, pk[b][s]);
        o0 = MFMA32(*(const bf16x8*)(vp + b * 64 + s * 32), pf, o0);
        o1 = MFMA32(*(const bf16x8*)(vp + 32 * VSTR + b * 64 + s * 32), pf, o1);
      }
    f32x16 sc[4];
#pragma unroll
    for (int b = 0; b < 4; ++b) {
      if (MODE == 0) __builtin_amdgcn_sched_barrier(0);
#pragma unroll
      for (int i = 0; i < 16; ++i) sc[b][i] = 0.f;
#pragma unroll
      for (int c = 0; c < NC; ++c) sc[b] = MFMA32(*(const bf16x8*)(kp + b * 32 * KSTR + c * 32), qf[c], sc[b]);
    }
    if (MODE == 0) __builtin_amdgcn_sched_barrier(0);
    if (!zref) {
#pragma unroll
      for (int b = 0; b < 4; ++b)
#pragma unroll
        for (int i = 0; i < 16; ++i) sc[b][i] -= m_ref;
    }
    float ls = 0.f;
#pragma unroll
    for (int b = 0; b < 4; ++b)
#pragma unroll
      for (int i = 0; i < 16; ++i) { sc[b][i] = __builtin_amdgcn_exp2f(sc[b][i]); ls += sc[b][i]; }
    if (__builtin_amdgcn_ballot_w64(!(ls < 1e30f)) != 0ull) {
      float mx = -1e30f;
#pragma unroll
      for (int b = 0; b < 4; ++b) {
#pragma unroll
        for (int i = 0; i < 16; ++i) sc[b][i] = 0.f;
#pragma unroll
        for (int c = 0; c < NC; ++c) sc[b] = MFMA32(*(const bf16x8*)(kp + b * 32 * KSTR + c * 32), qf[c], sc[b]);
#pragma unroll
        for (int i = 0; i < 16; ++i) mx = fmaxf(mx, sc[b][i]);
      }
      mx = fmaxf(mx, __shfl_xor(mx, 32));
      const float delta = fmaxf(mx - m_ref, 0.f);
      const float alpha = __builtin_amdgcn_exp2f(-delta);
      m_ref += delta;
      zref = false;
      l_run *= alpha;
#pragma unroll
      for (int i = 0; i < 16; ++i) { o0[i] *= alpha; o1[i] *= alpha; }
      ls = 0.f;
#pragma unroll
      for (int b = 0; b < 4; ++b)
#pragma unroll
        for (int i = 0; i < 16; ++i) { sc[b][i] = __builtin_amdgcn_exp2f(sc[b][i] - m_ref); ls += sc[b][i]; }
    }
    l_run += ls;
#pragma unroll
    for (int b = 0; b < 4; ++b)
#pragma unroll
      for (int s = 0; s < 2; ++s)
#pragma unroll
        for (int j = 0; j < 4; ++j) pk[b][s][j] = pk_bf16(sc[b][8 * s + 2 * j], sc[b][8 * s + 2 * j + 1]);
    if (it + 2 < n_it) lwriteK(sl_p);
    if (it + 1 < n_it) lwriteV(sl_n);
    __syncthreads();
    sl_c = sl_n;
  }
  {
    const char* vp = lds + ((sl_c == 0) ? 2 : sl_c - 1) * VTILE + voff;
#pragma unroll
    for (int b = 0; b < 4; ++b)
#pragma unroll
      for (int s = 0; s < 2; ++s) {
        const bf16x8 pf = __builtin_bit_cast(bf16x8, pk[b][s]);
        o0 = MFMA32(*(const bf16x8*)(vp + b * 64 + s * 32), pf, o0);
        o1 = MFMA32(*(const bf16x8*)(vp + 32 * VSTR + b * 64 + s * 32), pf, o1);
      }
  }
  }
  const float l_tot = l_run + __shfl_xor(l_run, 32);
  const float inv = 1.f / l_tot;
  const bf16_t* gp; bf16_t* dst;
  if (MODE == 0) { gp = p.proj + (size_t)mq * LD0 + (416 + 512) + hh * 64; dst = p.h + (size_t)mq * 1024 + 512 + hh * 64; }
  else { gp = p.proj + (size_t)mq * N_C + 1536 + hh * 64; dst = p.h + (size_t)mq * 1024 + hh * 64; }
  u32x2 w0[4], w1[4];
#pragma unroll
  for (int g = 0; g < 4; ++g) {
    const int d = 8 * g + 4 * h;
    const u32x2 g0 = *(const u32x2*)(gp + d), g1 = *(const u32x2*)(gp + 32 + d);
    w0[g][0] = pk_bf16(o0[4 * g] * inv * bflo(g0[0]), o0[4 * g + 1] * inv * bfhi(g0[0]));
    w0[g][1] = pk_bf16(o0[4 * g + 2] * inv * bflo(g0[1]), o0[4 * g + 3] * inv * bfhi(g0[1]));
    w1[g][0] = pk_bf16(o1[4 * g] * inv * bflo(g1[0]), o1[4 * g + 1] * inv * bfhi(g1[0]));
    w1[g][1] = pk_bf16(o1[4 * g + 2] * inv * bflo(g1[1]), o1[4 * g + 3] * inv * bfhi(g1[1]));
  }
  st_pair16(dst, 0, h, w0[0], w0[1]);
  st_pair16(dst, 2, h, w0[2], w0[3]);
  st_pair16(dst + 32, 0, h, w1[0], w1[1]);
  st_pair16(dst + 32, 2, h, w1[2], w1[3]);
}

DI void attn_dilated(const Params& p, int u, char* lds) {
  constexpr int KSTR = 144, KBYTES = 384 * KSTR;
  constexpr int VSTR = 192;
  const int tid = fresh_tid(), lane = tid & 63, wid = __builtin_amdgcn_readfirstlane(tid >> 6), ql = lane & 31, h = lane >> 5;
  int T, seq_row0, hh, cfg, cls, u0, NB;
  {
    int r;
    if (u < 512) { T = 8192; seq_row0 = (u >> 8) * 8192; hh = (u >> 5) & 7; r = u & 31;
      if (r < 8) { cfg = 0; cls = 0; NB = 4; u0 = r * 1024; }
      else if (r < 16) { cfg = 1; cls = (r - 8) >> 1; NB = 4; u0 = ((r - 8) & 1) * 1024; }
      else { cfg = 2; cls = r - 16; NB = 2; u0 = 0; } }
    else { const int v = u - 512; T = 4096; seq_row0 = M_PROMPT + (v / 192) * 4096; hh = (v / 24) & 7; r = v % 24;
      if (r < 4) { cfg = 0; cls = 0; NB = 4; u0 = r * 1024; }
      else if (r < 8) { cfg = 1; cls = r - 4; NB = 4; u0 = 0; }
      else { cfg = 2; cls = r - 8; NB = 1; u0 = 0; } }
  }
  const int dd = 1 << (2 * cfg), U = T >> (2 * cfg);
  const float c2 = 0.125f * LOG2E;
  const float slope2 = exp2f(-(float)(hh + 1)) * (float)dd * LOG2E;

  u32x4 kr[6], vr[6];
  const int wrow = tid >> 3, kc = tid & 7;
  auto gload = [&](int b) {
    const int ub = u0 + 256 * b;
#pragma unroll
    for (int i = 0; i < 6; ++i) {
      int uk = ub - 64 + wrow + 64 * i;
      uk = uk < 0 ? 0 : (uk >= U ? U - 1 : uk);
      const char* kbase = (const char*)(p.qkva + ((size_t)(8 + hh) * M_TOK + seq_row0) * 64);
      const char* vbase = (const char*)(p.qkva + ((size_t)(16 + hh) * M_TOK + seq_row0) * 64);
      const unsigned off = ((unsigned)(uk * dd + cls) * 64u + 8u * kc) * 2u;
      kr[i] = *(const u32x4*)(kbase + off);
      vr[i] = *(const u32x4*)(vbase + off);
    }
  };
  auto lwrite = [&]() {
#pragma unroll
    for (int i = 0; i < 6; ++i) {
      const int w = wrow + 64 * i;
      *(u32x4*)(lds + w * KSTR + kc * 16) = kr[i];
      *(u32x4*)(lds + KBYTES + w * VSTR + kc * 16) = vr[i];
    }
  };
  const int sq = (ql & ~12) | ((ql & 4) << 1) | ((ql & 8) >> 1);
  const int koff = sq * KSTR + h * 16;
  const int voff = KBYTES + (8 * h + ((lane & 15) >> 2)) * VSTR + 32 * ((lane >> 4) & 1) + 8 * (lane & 3);
  const int wc = wid >> 1;

  __syncthreads();
  gload(0);
  lwrite();
  __syncthreads();
  for (int b = 0; b < NB; ++b) {
    if (b + 1 < NB) gload(b + 1);
    const int ub = u0 + 256 * b;
    const int mq = seq_row0 + (ub + wid * 32 + ql) * dd + cls;
    bf16x8 qf[4];
    {
      const bf16_t* qp = p.qkva + ((size_t)hh * M_TOK + mq) * 64 + 8 * h;
#pragma unroll
      for (int c = 0; c < 4; ++c) {
        u32x4 w = *(const u32x4*)(qp + 16 * c);
#pragma unroll
        for (int j = 0; j < 4; ++j) w[j] = pk_bf16(bflo(w[j]) * c2, bfhi(w[j]) * c2);
        qf[c] = __builtin_bit_cast(bf16x8, w);
      }
    }
    f32x16 o0, o1;
#pragma unroll
    for (int i = 0; i < 16; ++i) { o0[i] = 0.f; o1[i] = 0.f; }
    float m_ref = 0.f, l_run = 0.f;
#pragma unroll 1
    for (int ord = 0; ord < 3; ++ord) {
      const int j = (ord == 0) ? wc + 1 : (ord == 1 ? wc : wc + 2);
      const int ut = ub - 64 + 64 * j;
      if (ut >= 0 && ut < U) {
        const char* kp = lds + (64 * j) * KSTR + koff;
        const char* vp = lds + voff + (64 * j) * VSTR;
        f32x16 s0, s1;
#pragma unroll
        for (int i = 0; i < 16; ++i) { s0[i] = 0.f; s1[i] = 0.f; }
#pragma unroll
        for (int c = 0; c < 4; ++c) {
          s0 = MFMA32(*(const bf16x8*)(kp + c * 32), qf[c], s0);
          s1 = MFMA32(*(const bf16x8*)(kp + 32 * KSTR + c * 32), qf[c], s1);
        }
        const float fb = (float)(64 * j - 64 + 8 * h - (32 * wid + ql));
        float mx = -1e30f;
#pragma unroll
        for (int i = 0; i < 16; ++i) {
          const float d0 = fb + (float)(16 * (i >> 3) + (i & 7)), d1 = d0 + 32.f;
          const float a0 = fabsf(d0), a1 = fabsf(d1);
          s0[i] = (a0 <= 64.f) ? __builtin_fmaf(-slope2, a0, s0[i]) : -1e30f;
          s1[i] = (a1 <= 64.f) ? __builtin_fmaf(-slope2, a1, s1[i]) : -1e30f;
          if (ord == 0) mx = fmaxf(mx, fmaxf(s0[i], s1[i]));
        }
        if (ord == 0) { mx = fmaxf(mx, __shfl_xor(mx, 32)); m_ref = mx; }
        float ls = 0.f;
#pragma unroll
        for (int i = 0; i < 16; ++i) {
          s0[i] = (s0[i] > -1e29f) ? __builtin_amdgcn_exp2f(s0[i] - m_ref) : 0.f;
          s1[i] = (s1[i] > -1e29f) ? __builtin_amdgcn_exp2f(s1[i] - m_ref) : 0.f;
          ls += s0[i] + s1[i];
        }
        if (ord != 0 && __builtin_amdgcn_ballot_w64(!(ls < 1e30f)) != 0ull) {
#pragma unroll
          for (int i = 0; i < 16; ++i) { s0[i] = 0.f; s1[i] = 0.f; }
#pragma unroll
          for (int c = 0; c < 4; ++c) {
            s0 = MFMA32(*(const bf16x8*)(kp + c * 32), qf[c], s0);
            s1 = MFMA32(*(const bf16x8*)(kp + 32 * KSTR + c * 32), qf[c], s1);
          }
          float m2 = -1e30f;
#pragma unroll
          for (int i = 0; i < 16; ++i) {
            const float d0 = fb + (float)(16 * (i >> 3) + (i & 7)), d1 = d0 + 32.f;
            const float a0 = fabsf(d0), a1 = fabsf(d1);
            s0[i] = (a0 <= 64.f) ? __builtin_fmaf(-slope2, a0, s0[i]) : -1e30f;
            s1[i] = (a1 <= 64.f) ? __builtin_fmaf(-slope2, a1, s1[i]) : -1e30f;
            m2 = fmaxf(m2, fmaxf(s0[i], s1[i]));
          }
          m2 = fmaxf(m2, __shfl_xor(m2, 32));
          const float delta = fmaxf(m2 - m_ref, 0.f);
          const float alpha = __builtin_amdgcn_exp2f(-delta);
          m_ref += delta;
          l_run *= alpha;
#pragma unroll
          for (int i = 0; i < 16; ++i) { o0[i] *= alpha; o1[i] *= alpha; }
          ls = 0.f;
#pragma unroll
          for (int i = 0; i < 16; ++i) {
            s0[i] = (s0[i] > -1e29f) ? __builtin_amdgcn_exp2f(s0[i] - m_ref) : 0.f;
            s1[i] = (s1[i] > -1e29f) ? __builtin_amdgcn_exp2f(s1[i] - m_ref) : 0.f;
            ls += s0[i] + s1[i];
          }
        }
        l_run += ls;
#pragma unroll
        for (int s = 0; s < 2; ++s) {
          u32x4 pa, pb;
#pragma unroll
          for (int jj = 0; jj < 4; ++jj) {
            pa[jj] = pk_bf16(s0[8 * s + 2 * jj], s0[8 * s + 2 * jj + 1]);
            pb[jj] = pk_bf16(s1[8 * s + 2 * jj], s1[8 * s + 2 * jj + 1]);
          }
          const bf16x8 pfa = __builtin_bit_cast(bf16x8, pa), pfb = __builtin_bit_cast(bf16x8, pb);
          auto vfrag = [&](int k0, int db) -> bf16x8 {
            const s16x4 lo = __builtin_amdgcn_ds_read_tr16_b64_v4i16((LAS s16x4*)(vp + k0 * VSTR + db * 64));
            const s16x4 hi = __builtin_amdgcn_ds_read_tr16_b64_v4i16((LAS s16x4*)(vp + (k0 + 4) * VSTR + db * 64));
            return __builtin_shufflevector(lo, hi, 0, 1, 2, 3, 4, 5, 6, 7);
          };
          o0 = MFMA32(vfrag(16 * s, 0), pfa, o0);
          o1 = MFMA32(vfrag(16 * s, 1), pfa, o1);
          o0 = MFMA32(vfrag(32 + 16 * s, 0), pfb, o0);
          o1 = MFMA32(vfrag(32 + 16 * s, 1), pfb, o1);
        }
      }
    }
    {
      const float l_tot = l_run + __shfl_xor(l_run, 32);
      const float inv = 1.f / l_tot;
      bf16_t* dst = p.pA + (size_t)cfg * M_TOK * 512 + (size_t)mq * 512 + hh * 64;
      u32x2 w0[4], w1[4];
#pragma unroll
      for (int g = 0; g < 4; ++g) {
        w0[g][0] = pk_bf16(o0[4 * g] * inv, o0[4 * g + 1] * inv); w0[g][1] = pk_bf16(o0[4 * g + 2] * inv, o0[4 * g + 3] * inv);
        w1[g][0] = pk_bf16(o1[4 * g] * inv, o1[4 * g + 1] * inv); w1[g][1] = pk_bf16(o1[4 * g + 2] * inv, o1[4 * g + 3] * inv);
      }
      st_pair16(dst, 0, h, w0[0], w0[1]);
      st_pair16(dst, 2, h, w0[2], w0[3]);
      st_pair16(dst + 32, 0, h, w1[0], w1[1]);
      st_pair16(dst + 32, 2, h, w1[2], w1[3]);
      if (h == 0) p.lse[(size_t)cfg * M_TOK * 8 + (size_t)mq * 8 + hh] = m_ref + __builtin_amdgcn_logf(l_tot);
    }
    __syncthreads();
    if (b + 1 < NB) { lwrite(); __syncthreads(); }
  }
}

DI void phase_merge(const Params& p) {
  const int nthr = gridDim.x * 512;
  for (int e = blockIdx.x * 512 + threadIdx.x; e < M_TOK * 64; e += nthr) {
    const int m = e >> 6, c = e & 63, hh = c >> 3;
    const float l0 = p.lse[(size_t)m * 8 + hh], l1 = p.lse[(size_t)M_TOK * 8 + (size_t)m * 8 + hh], l2 = p.lse[(size_t)2 * M_TOK * 8 + (size_t)m * 8 + hh];
    const float mx = fmaxf(l0, fmaxf(l1, l2));
    float w0 = __builtin_amdgcn_exp2f(l0 - mx), w1 = __builtin_amdgcn_exp2f(l1 - mx), w2 = __builtin_amdgcn_exp2f(l2 - mx);
    const float inv = 1.f / (w0 + w1 + w2);
    w0 *= inv; w1 *= inv; w2 *= inv;
    const u32x4 a = *(const u32x4*)(p.pA + (size_t)m * 512 + c * 8);
    const u32x4 b = *(const u32x4*)(p.pA + (size_t)M_TOK * 512 + (size_t)m * 512 + c * 8);
    const u32x4 d = *(const u32x4*)(p.pA + (size_t)2 * M_TOK * 512 + (size_t)m * 512 + c * 8);
    const u32x4 g = *(const u32x4*)(p.proj + (size_t)m * LD0 + 416 + c * 8);
    u32x4 o;
#pragma unroll
    for (int j = 0; j < 4; ++j) {
      const float lo = (bflo(a[j]) * w0 + bflo(b[j]) * w1 + bflo(d[j]) * w2) * bflo(g[j]);
      const float hi = (bfhi(a[j]) * w0 + bfhi(b[j]) * w1 + bfhi(d[j]) * w2) * bfhi(g[j]);
      o[j] = pk_bf16(lo, hi);
    }
    *(u32x4*)(p.h + (size_t)m * 1024 + c * 8) = o;
  }
}

template <int PH>
DI void run_phase(const Params& p, char* lds) {
  const int bid = blockIdx.x, nblk = gridDim.x;
  if (PH == 0) phase_prep(p, lds);
  else if (PH == 1) { for (int t = bid; t < 320 * 12; t += nblk) { int pm, pn; g8_tile(t, 320, 12, pm, pn); gemm_tile<0>(p, p.h, 1024, p.wt_in_ab, 1024, pm * 256, pn * 256, lds); } }
  else if (PH == 2) phase_mlanorm(p);
  else if (PH == 3) {
    for (int t = bid; t < 960 + 1280; t += nblk) {
      int pm, pn;
      if (t < 960) { g8_tile(t, 320, 3, pm, pn); gemm_tile<1>(p, p.proj, LD0, p.wt_uq, 256, pm * 256, pn * 256, lds); }
      else { g8_tile(t - 960, 320, 4, pm, pn); gemm_tile<2>(p, p.proj + 256, LD0, p.wt_ukv, 128, pm * 256, pn * 256, lds); }
    }
  }
  else if (PH == 4) {
    for (int u = bid; u < 2560; u += nblk) attn_dense128<0>(p, u, lds);
    for (int u = bid; u < 3584; u += nblk) attn_dilated(p, u, lds);
  }
  else if (PH == 5) phase_merge(p);
  else if (PH == 6) { for (int t = bid; t < 1280; t += nblk) { int pm, pn; g8_tile(t, 320, 4, pm, pn); gemm_tile<3>(p, p.h, 1024, p.wt_out_ab, 1024, pm * 256, pn * 256, lds); } }
  else if (PH == 7) phase_postnorm<false>(p, p.proj, p.norm_post, p.norm_pre + 1024);
  else if (PH == 8) { for (int t = bid; t < 3200; t += nblk) { int pm, pn; g8_tile(t, 320, 10, pm, pn); gemm_tile<4>(p, p.h, 1024, p.wt_in_c, 1024, pm * 256, pn * 256, lds); } }
  else if (PH == 9) { for (int u = bid; u < 5120; u += nblk) attn_dense128<1, false, true>(p, u, lds); }
  else if (PH == 10) { for (int t = bid; t < 1280; t += nblk) { int pm, pn; g8_tile(t, 320, 4, pm, pn); gemm_tile<5>(p, p.h, 1024, p.wt_out_c, 1024, pm * 256, pn * 256, lds); } }
  else if (PH == 11) phase_postnorm<true>(p, p.yout1, p.norm_post + 1024, nullptr);
}

template <int PH>
__global__ void __launch_bounds__(512) k_phase(Params p) {
  __shared__ __attribute__((aligned(16))) char lds[LDS_BYTES];
  run_phase<PH>(p, lds);
}

__global__ void __launch_bounds__(512) k_mega(Params p) {
  __shared__ __attribute__((aligned(16))) char lds[LDS_BYTES];
  cg::grid_group grid = cg::this_grid();
  run_phase<0>(p, lds); grid.sync();
  run_phase<1>(p, lds); grid.sync();
  run_phase<3>(p, lds); grid.sync();
  run_phase<4>(p, lds); grid.sync();
  run_phase<5>(p, lds); grid.sync();
  run_phase<6>(p, lds); grid.sync();
  run_phase<7>(p, lds); grid.sync();
  run_phase<8>(p, lds); grid.sync();
#ifdef PROBE_GEMM
  run_phase<8>(p, lds); grid.sync();
#endif
  run_phase<9>(p, lds); grid.sync();
#ifdef PROBE_ATT
  run_phase<9>(p, lds); grid.sync();
#endif
  run_phase<10>(p, lds); grid.sync();
  run_phase<11>(p, lds);
}

extern "C" void kernel_launch(void* const* d_in, const int* in_sizes, int n_in, void* d_out, int out_size, void* d_ws,
                              size_t ws_size, hipStream_t stream) {
  Params p{};
  p.x_prompt = (const float*)d_in[0]; p.x_sample = (const float*)d_in[1];
  p.norm_pre = (const float*)d_in[2]; p.norm_post = (const float*)d_in[3];
  p.w_in_ab = (const float*)d_in[4]; p.mla_q_norm = (const float*)d_in[5]; p.w_uq = (const float*)d_in[6];
  p.mla_kv_norm = (const float*)d_in[7]; p.w_ukv = (const float*)d_in[8]; p.w_out_ab = (const float*)d_in[9];
  p.w_in_c = (const float*)d_in[10]; p.c_q_norm = (const float*)d_in[11]; p.c_k_norm = (const float*)d_in[12];
  p.w_out_c = (const float*)d_in[13];
  p.out = (float*)d_out;
  char* ws = (char*)d_ws;
  const size_t MiB = 1ull << 20;
  p.wt_in_ab = (bf16_t*)(ws + 0 * MiB);
  p.wt_out_ab = (bf16_t*)(ws + 6 * MiB);
  p.wt_in_c = (bf16_t*)(ws + 8 * MiB);
  p.wt_out_c = (bf16_t*)(ws + 13 * MiB);
  p.rope = (float2*)(ws + 15 * MiB);
  p.wt_uq = (bf16_t*)(ws + 16 * MiB);
  p.wt_ukv = (bf16_t*)(ws + 16 * MiB + 512 * 1024);
  p.h = (bf16_t*)(ws + 20 * MiB);
  p.proj = (bf16_t*)(ws + 180 * MiB);
  p.qb = (bf16_t*)(ws + 645 * MiB);
  p.knope = (bf16_t*)(ws + 765 * MiB);
  p.vbT = (bf16_t*)(ws + 845 * MiB);
  p.krope = (bf16_t*)(ws + 925 * MiB);
  p.v1T = (bf16_t*)(ws + 645 * MiB);
  p.yout1 = (bf16_t*)(ws + 700 * MiB);
  p.pA = (bf16_t*)d_out;
  p.lse = (float*)((char*)d_out + 240 * MiB);
  p.qkva = (bf16_t*)(ws + 405 * MiB);
  p.rss_q = (float*)(ws + 931 * MiB);
  p.rss_kv = (float*)(ws + 932 * MiB);
#if N_LAUNCH_MODE == 1
  static int grid_blocks = 0;
  if (!grid_blocks) {
    int dev = 0, cus = 0, per_cu = 0;
    hipGetDevice(&dev);
    hipDeviceGetAttribute(&cus, hipDeviceAttributeMultiprocessorCount, dev);
    hipOccupancyMaxActiveBlocksPerMultiprocessor(&per_cu, k_mega, 512, 0);
    if (per_cu < 1) per_cu = 1;
    if (per_cu > 1) per_cu = 1;
    grid_blocks = cus * per_cu;
  }
  void* args[] = {&p};
  hipError_t e = hipLaunchCooperativeKernel((void*)k_mega, dim3(grid_blocks), dim3(512), args, 0, stream);
  if (e != hipSuccess) fprintf(stderr, "cooperative launch failed: %s (grid %d)\n", hipGetErrorString(e), grid_blocks);
#else
  const dim3 g(256), b(512);
  k_phase<0><<<g, b, 0, stream>>>(p);
  k_phase<1><<<g, b, 0, stream>>>(p);
  k_phase<3><<<g, b, 0, stream>>>(p);
  k_phase<4><<<g, b, 0, stream>>>(p);
  k_phase<5><<<g, b, 0, stream>>>(p);
  k_phase<6><<<g, b, 0, stream>>>(p);
  k_phase<7><<<g, b, 0, stream>>>(p);
  k_phase<8><<<g, b, 0, stream>>>(p);
  k_phase<9><<<g, b, 0, stream>>>(p);
  k_phase<10><<<g, b, 0, stream>>>(p);
  k_phase<11><<<g, b, 0, stream>>>(p);
#endif
}
```

```cpp
#include <hip/hip_runtime.h>
#include <hip/hip_cooperative_groups.h>
#include <cstdint>
#include <cstdio>
namespace cg = cooperative_groups;

#ifndef N_LAUNCH_MODE
#define N_LAUNCH_MODE 1
#endif

typedef unsigned short bf16_t;
typedef short bf16x8 __attribute__((ext_vector_type(8)));
typedef float f32x16 __attribute__((ext_vector_type(16)));
typedef float f32x4 __attribute__((ext_vector_type(4)));
typedef float f32x2 __attribute__((ext_vector_type(2)));
typedef unsigned u32x4 __attribute__((ext_vector_type(4)));
typedef unsigned u32x2 __attribute__((ext_vector_type(2)));
typedef __bf16 bf16x2_t __attribute__((ext_vector_type(2)));
typedef short s16x4 __attribute__((ext_vector_type(4)));

#define DI __device__ __forceinline__
#define MFMA32(a, b, c) __builtin_amdgcn_mfma_f32_32x32x16_bf16((a), (b), (c), 0, 0, 0)

constexpr int M_TOK = 81920, M_PROMPT = 16384;
constexpr int N_AB = 2976, N_C = 2560;
constexpr int LD0 = 1440;
constexpr float EPS = 1e-6f;
constexpr float LOG2E = 1.4426950408889634f;
constexpr int LDS_BYTES = 147456;

struct Params {
  const float *x_prompt, *x_sample, *norm_pre, *norm_post, *w_in_ab, *mla_q_norm, *w_uq, *mla_kv_norm, *w_ukv,
      *w_out_ab, *w_in_c, *c_q_norm, *c_k_norm, *w_out_c;
  float* out;
  bf16_t *wt_in_ab, *wt_out_ab, *wt_in_c, *wt_out_c, *wt_uq, *wt_ukv;
  float2* rope;
  bf16_t *h;
  bf16_t *proj;
  bf16_t *qb;
  bf16_t *knope;
  bf16_t *vbT;
  bf16_t *krope;
  bf16_t *v1T;
  bf16_t *yout1;
  bf16_t *pA;
  float *lse;
  bf16_t *qkva;
  float *rss_q, *rss_kv;
};

DI unsigned pk_bf16(float lo, float hi) {
  f32x2 v = {lo, hi};
  bf16x2_t b = __builtin_convertvector(v, bf16x2_t);
  return __builtin_bit_cast(unsigned, b);
}
DI bf16_t f2bf(float x) { return (bf16_t)(pk_bf16(x, 0.f) & 0xffffu); }
DI float bflo(unsigned u) { return __uint_as_float(u << 16); }
DI float bfhi(unsigned u) { return __uint_as_float(u & 0xffff0000u); }
DI float bf2f(bf16_t v) { return __uint_as_float(((unsigned)v) << 16); }
DI float silu_f(float v) { return v * __builtin_amdgcn_rcpf(1.f + __builtin_amdgcn_exp2f(-v * LOG2E)); }
DI float wave_sum(float v) {
  v += __shfl_xor(v, 32); v += __shfl_xor(v, 16); v += __shfl_xor(v, 8);
  v += __shfl_xor(v, 4); v += __shfl_xor(v, 2); v += __shfl_xor(v, 1);
  return v;
}
DI int fresh_tid() { int t = threadIdx.x; asm volatile("" : "+v"(t)); return t; }
DI float fmax_nc(float a, float b) { return __builtin_amdgcn_fmed3f(a, b, __builtin_inff()); }
DI void st_pair16(bf16_t* row32, int g, int h, const u32x2& a, const u32x2& b) {
  const auto r0 = __builtin_amdgcn_permlane32_swap(a[0], b[0], false, false);
  const auto r1 = __builtin_amdgcn_permlane32_swap(a[1], b[1], false, false);
  u32x4 v; v[0] = r0[0]; v[1] = r1[0]; v[2] = r0[1]; v[3] = r1[1];
  *(u32x4*)(row32 + 8 * g + 8 * h) = v;
}
DI int crow(int i, int h) { return (i & 3) + 8 * (i >> 2) + 4 * h; }
DI const float* xrow(const Params& p, int m) {
  return (m < M_PROMPT) ? p.x_prompt + (size_t)m * 1024 : p.x_sample + (size_t)(m - M_PROMPT) * 1024;
}

DI void phase_prep(const Params& p, char* lds) {
  const int tid = fresh_tid(), nblk = gridDim.x, bid = blockIdx.x, lane = tid & 63, wid = __builtin_amdgcn_readfirstlane(tid >> 6);
  float (*tile)[65] = (float (*)[65])lds;
  for (int t0 = bid; t0 < 2000; t0 += nblk) {
    const float* src; bf16_t* dst; int K, N, tt = t0; const float* kg = nullptr;
    if (tt < 768) { src = p.w_in_ab; dst = p.wt_in_ab; K = 1024; N = 2976; }
    else if ((tt -= 768) < 256) { src = p.w_out_ab; dst = p.wt_out_ab; K = 1024; N = 1024; }
    else if ((tt -= 256) < 640) { src = p.w_in_c; dst = p.wt_in_c; K = 1024; N = 2560; }
    else if ((tt -= 640) < 256) { src = p.w_out_c; dst = p.wt_out_c; K = 1024; N = 1024; }
    else if ((tt -= 256) < 48) { src = p.w_uq; dst = p.wt_uq; K = 256; N = 768; kg = p.mla_q_norm; }
    else { tt -= 48; src = p.w_ukv; dst = p.wt_ukv; K = 128; N = 1024; kg = p.mla_kv_norm; }
    const int nkt = K >> 6;
    const int k0 = (tt % nkt) * 64, n0 = (tt / nkt) * 64;
    __syncthreads();
    {
      const int tx = tid & 63, ty = tid >> 6;
#pragma unroll
      for (int i = 0; i < 8; ++i) {
        const int k = ty + 8 * i, n = n0 + tx;
        tile[k][tx] = (n < N) ? src[(size_t)(k0 + k) * N + n] * (kg ? kg[k0 + k] : 1.f) : 0.f;
      }
    }
    __syncthreads();
    {
      const int kx = tid & 63, ny = tid >> 6;
#pragma unroll
      for (int i = 0; i < 8; ++i) {
        const int n = ny + 8 * i;
        dst[(size_t)(n0 + n) * K + k0 + kx] = f2bf(tile[kx][n]);
      }
    }
  }
  for (int e = bid * 512 + tid; e < M_TOK; e += nblk * 512) { p.rss_q[e] = 0.f; p.rss_kv[e] = 0.f; }
  for (int e = bid * 512 + tid; e < 8192 * 16; e += nblk * 512) {
    const int pos = e >> 4, i = e & 15;
    const double freq = exp2(-(double)i * (13.287712379549449 / 16.0));
    const double ang = (double)pos * freq;
    const double kk = rint(ang * 0.15915494309189535);
    const float rf = (float)(ang - kk * 6.283185307179586);
    p.rope[e] = make_float2(cosf(rf), sinf(rf));
  }
  for (int m = bid * 8 + wid; m < M_TOK; m += nblk * 8) {
    const float* xr = xrow(p, m);
    f32x4 v[4]; float ss = 0.f;
#pragma unroll
    for (int i = 0; i < 4; ++i) {
      v[i] = *(const f32x4*)(xr + i * 256 + lane * 4);
      ss += v[i][0] * v[i][0] + v[i][1] * v[i][1] + v[i][2] * v[i][2] + v[i][3] * v[i][3];
    }
    ss = wave_sum(ss);
    const float rinv = rsqrtf(ss * (1.f / 1024.f) + EPS);
#pragma unroll
    for (int i = 0; i < 4; ++i) {
      const f32x4 g = *(const f32x4*)(p.norm_pre + i * 256 + lane * 4);
      u32x2 w;
      w[0] = pk_bf16(v[i][0] * rinv * g[0], v[i][1] * rinv * g[1]);
      w[1] = pk_bf16(v[i][2] * rinv * g[2], v[i][3] * rinv * g[3]);
      *(u32x2*)(p.h + (size_t)m * 1024 + i * 256 + lane * 4) = w;
    }
  }
}

template <bool LAST>
DI void phase_postnorm(const Params& p, const bf16_t* yout, const float* gpost, const float* gpre) {
  const int tid = fresh_tid(), nblk = gridDim.x, bid = blockIdx.x, lane = tid & 63, wid = __builtin_amdgcn_readfirstlane(tid >> 6);
  for (int m = bid * 8 + wid; m < M_TOK; m += nblk * 8) {
    const float* xr = LAST ? (const float*)(p.out + (size_t)m * 1024) : xrow(p, m);
    f32x4 y[4], x[4]; float ss = 0.f;
#pragma unroll
    for (int i = 0; i < 4; ++i) {
      const u32x2 w = *(const u32x2*)(yout + (size_t)m * 1024 + i * 256 + lane * 4);
      y[i][0] = bflo(w[0]); y[i][1] = bfhi(w[0]); y[i][2] = bflo(w[1]); y[i][3] = bfhi(w[1]);
      x[i] = *(const f32x4*)(xr + i * 256 + lane * 4);
      ss += y[i][0] * y[i][0] + y[i][1] * y[i][1] + y[i][2] * y[i][2] + y[i][3] * y[i][3];
    }
    ss = wave_sum(ss);
    const float rinv = rsqrtf(ss * (1.f / 1024.f) + EPS);
    float ss2 = 0.f;
#pragma unroll
    for (int i = 0; i < 4; ++i) {
      const f32x4 g = *(const f32x4*)(gpost + i * 256 + lane * 4);
#pragma unroll
      for (int j = 0; j < 4; ++j) { x[i][j] = x[i][j] + y[i][j] * rinv * g[j]; ss2 += x[i][j] * x[i][j]; }
      *(f32x4*)(p.out + (size_t)m * 1024 + i * 256 + lane * 4) = x[i];
    }
    if (!LAST) {
      ss2 = wave_sum(ss2);
      const float rinv2 = rsqrtf(ss2 * (1.f / 1024.f) + EPS);
#pragma unroll
      for (int i = 0; i < 4; ++i) {
        const f32x4 g = *(const f32x4*)(gpre + i * 256 + lane * 4);
        u32x2 w;
        w[0] = pk_bf16(x[i][0] * rinv2 * g[0], x[i][1] * rinv2 * g[1]);
        w[1] = pk_bf16(x[i][2] * rinv2 * g[2], x[i][3] * rinv2 * g[3]);
        *(u32x2*)(p.h + (size_t)m * 1024 + i * 256 + lane * 4) = w;
      }
    }
  }
}

DI void phase_mlanorm(const Params& p) {
  const int tid = fresh_tid(), nblk = gridDim.x, bid = blockIdx.x, lane = tid & 63, wid = __builtin_amdgcn_readfirstlane(tid >> 6);
  for (int m = bid * 8 + wid; m < M_TOK; m += nblk * 8) {
    bf16_t* pr = p.proj + (size_t)m * LD0 - 1536;
    const int T = (m < M_PROMPT) ? 8192 : 4096, t = m & (T - 1);
    {
      const u32x2 w = *(const u32x2*)(pr + 1536 + lane * 4);
      float v0 = bflo(w[0]), v1 = bfhi(w[0]), v2 = bflo(w[1]), v3 = bfhi(w[1]);
      float ss = wave_sum(v0 * v0 + v1 * v1 + v2 * v2 + v3 * v3);
      const float rinv = rsqrtf(ss * (1.f / 256.f) + EPS);
      const f32x4 g = *(const f32x4*)(p.mla_q_norm + lane * 4);
      u32x2 o; o[0] = pk_bf16(v0 * rinv * g[0], v1 * rinv * g[1]); o[1] = pk_bf16(v2 * rinv * g[2], v3 * rinv * g[3]);
      *(u32x2*)(pr + 1536 + lane * 4) = o;
    }
    {
      const unsigned w = *(const unsigned*)(pr + 1792 + lane * 2);
      float v0 = bflo(w), v1 = bfhi(w);
      float ss = wave_sum(v0 * v0 + v1 * v1);
      const float rinv = rsqrtf(ss * (1.f / 128.f) + EPS);
      const f32x2 g = *(const f32x2*)(p.mla_kv_norm + lane * 2);
      *(unsigned*)(pr + 1792 + lane * 2) = pk_bf16(v0 * rinv * g[0], v1 * rinv * g[1]);
    }
    {
      const float xv = bf2f(pr[1920 + (lane & 31)]);
      const float pv = __shfl_xor(xv, 16);
      const float2 cs = p.rope[t * 16 + (lane & 15)];
      const float o = (lane & 16) ? (xv * cs.x + pv * cs.y) : (xv * cs.x - pv * cs.y);
      if (lane < 32) p.krope[(size_t)m * 32 + lane] = f2bf(o);
    }
  }
}

#define LAS __attribute__((address_space(3)))
#define GAS __attribute__((address_space(1)))
DI void g8_stage_rc(int b, int& R, int& C) {
  const int st = b / 1024, sb = b % 1024, swz = sb ^ (((sb >> 9) & 1) << 5);
  R = (st >> 1) * 16 + swz / 64; C = (st & 1) * 32 + (swz % 64) / 2;
}
DI void g8_tile(int L, int nM, int nN, int& pm, int& pn) {
  const int nwg = nM * nN, q = nwg / 8, r = nwg % 8, xcd = L % 8, off = L / 8;
  const int wg = (xcd < r ? xcd * (q + 1) : r * (q + 1) + (xcd - r) * q) + off;
  const int nig = 8 * nN, gid = wg / nig, fm = gid * 8, gsz = (nM - fm) < 8 ? (nM - fm) : 8;
  pm = fm + (wg % nig) % gsz; pn = (wg % nig) / gsz;
}
DI void st4(bf16_t* dst, const f32x4& v) {
  u32x2 w; w[0] = pk_bf16(v[0], v[1]); w[1] = pk_bf16(v[2], v[3]);
  *(u32x2*)dst = w;
}

DI void st8_pair(bf16_t* row16, int fq, const f32x4& va, const f32x4& vb) {
  const unsigned a0 = pk_bf16(va[0], va[1]), a1 = pk_bf16(va[2], va[3]);
  const unsigned b0 = pk_bf16(vb[0], vb[1]), b1 = pk_bf16(vb[2], vb[3]);
  const auto r0 = __builtin_amdgcn_permlane16_swap(a0, b0, false, false);
  const auto r1 = __builtin_amdgcn_permlane16_swap(a1, b1, false, false);
  u32x4 v; v[0] = r0[0]; v[1] = r1[0]; v[2] = r0[1]; v[3] = r1[1];
  *(u32x4*)(row16 + (fq & 1) * 16 + (fq >> 1) * 8) = v;
}

template <int EPI>
DI void gemm_epilogue(const Params& p, f32x4 (&acc)[2][2][4][2], int m0, int n0, int wr, int wc, int fr, int fq) {
#pragma unroll
  for (int bj = 0; bj < 2; ++bj)
#pragma unroll
    for (int ni = 0; ni < 2; ++ni) {
      const int m = m0 + bj * 128 + wc * 32 + ni * 16 + fr;
      const int T = (m < M_PROMPT) ? 8192 : 4096, t = m & (T - 1);
      float ssq = 0.f;
#pragma unroll
      for (int ai = 0; ai < 2; ++ai) {
        const int nb = n0 + ai * 128 + wr * 64;
        if (EPI == 0) {
#pragma unroll
          for (int mi = 0; mi < 4; ++mi) {
            const int n = nb + mi * 16 + fq * 4;
            if (n < 1536) {
              st4(p.qkva + ((size_t)(n >> 6) * M_TOK + m) * 64 + (n & 63), acc[ai][bj][mi][ni]);
            } else if (n < N_AB) {
              f32x4 v = acc[ai][bj][mi][ni];
              if (n >= 1952) { v[0] = silu_f(v[0]); v[1] = silu_f(v[1]); v[2] = silu_f(v[2]); v[3] = silu_f(v[3]); }
              if (n < 1920 || n >= 1952) st4(p.proj + (size_t)m * LD0 + (n - 1536), v);
            }
          }
          if (nb >= 1536 && nb < 1920) {
#pragma unroll
            for (int mi = 0; mi < 4; ++mi)
#pragma unroll
              for (int j = 0; j < 4; ++j) { const float v = acc[ai][bj][mi][ni][j]; ssq += v * v; }
          } else if (nb == 1920) {
            const f32x4* rp = (const f32x4*)(p.rope + t * 16 + fq * 4);
            const f32x4 r0 = rp[0], r1 = rp[1];
            const float cs[4] = {r0[0], r0[2], r1[0], r1[2]}, sn[4] = {r0[1], r0[3], r1[1], r1[3]};
            f32x4 y1, y2;
#pragma unroll
            for (int j = 0; j < 4; ++j) {
              const float x1 = acc[ai][bj][0][ni][j], x2 = acc[ai][bj][1][ni][j];
              y1[j] = x1 * cs[j] - x2 * sn[j];
              y2[j] = x2 * cs[j] + x1 * sn[j];
            }
            st4(p.krope + (size_t)m * 32 + fq * 4, y1);
            st4(p.krope + (size_t)m * 32 + 16 + fq * 4, y2);
          }
        } else if (EPI == 1) {
          {
            const float rinv = rsqrtf(p.rss_q[m] * (1.f / 256.f) + EPS);
#pragma unroll
            for (int mi = 0; mi < 4; ++mi) acc[ai][bj][mi][ni] *= rinv;
          }
#pragma unroll
          for (int blk = 0; blk < 2; ++blk) {
            const int nblk = nb + 32 * blk;
            if (((nblk >> 5) % 3) == 2) {
              const f32x4* rp = (const f32x4*)(p.rope + t * 16 + fq * 4);
              const f32x4 r0 = rp[0], r1 = rp[1];
              const float cs[4] = {r0[0], r0[2], r1[0], r1[2]}, sn[4] = {r0[1], r0[3], r1[1], r1[3]};
#pragma unroll
              for (int j = 0; j < 4; ++j) {
                const float x1 = acc[ai][bj][2 * blk][ni][j], x2 = acc[ai][bj][2 * blk + 1][ni][j];
                acc[ai][bj][2 * blk][ni][j] = x1 * cs[j] - x2 * sn[j];
                acc[ai][bj][2 * blk + 1][ni][j] = x2 * cs[j] + x1 * sn[j];
              }
            }
          }
#pragma unroll
          for (int mi = 0; mi < 4; ++mi) st4(p.qb + (size_t)m * 768 + nb + mi * 16 + fq * 4, acc[ai][bj][mi][ni]);
        } else if (EPI == 2) {
          {
            const float rinv = rsqrtf(p.rss_kv[m] * (1.f / 128.f) + EPS);
#pragma unroll
            for (int mi = 0; mi < 4; ++mi) acc[ai][bj][mi][ni] *= rinv;
          }
          const int hh = (n0 + ai * 128) >> 7;
          if (wr == 0) {
#pragma unroll
            for (int mi = 0; mi < 4; ++mi) st4(p.knope + (size_t)m * 512 + hh * 64 + mi * 16 + fq * 4, acc[ai][bj][mi][ni]);
          } else {
            bf16_t* vb = p.vbT + (size_t)(m - t) * 512 + t;
#pragma unroll
            for (int mi = 0; mi < 4; ++mi)
#pragma unroll
              for (int j = 0; j < 4; ++j) vb[(size_t)(hh * 64 + mi * 16 + fq * 4 + j) * T] = f2bf(acc[ai][bj][mi][ni][j]);
          }
        } else if (EPI == 3 || EPI == 5) {
          bf16_t* dst = (EPI == 3) ? p.proj : p.yout1;
          st8_pair(dst + (size_t)m * 1024 + nb, fq, acc[ai][bj][0][ni], acc[ai][bj][1][ni]);
          st8_pair(dst + (size_t)m * 1024 + nb + 32, fq, acc[ai][bj][2][ni], acc[ai][bj][3][ni]);
        } else if (EPI == 4) {
          if (n0 < 1280) {
            const float* gain = (n0 < 1024) ? p.c_q_norm : p.c_k_norm;
            float ss = 0.f;
#pragma unroll
            for (int mi = 0; mi < 4; ++mi)
#pragma unroll
              for (int j = 0; j < 4; ++j) { const float v = acc[ai][bj][mi][ni][j]; ss += v * v; }
            ss += __shfl_xor(ss, 16);
            ss += __shfl_xor(ss, 32);
            const float rinv = rsqrtf(ss * (1.f / 64.f) + EPS);
#pragma unroll
            for (int blk = 0; blk < 2; ++blk) {
              const int pos = (blk == 0) ? (t >> 6) : (t & 63);
              const f32x4* rp = (const f32x4*)(p.rope + pos * 16 + fq * 4);
              const f32x4 r0 = rp[0], r1 = rp[1];
              const float cs[4] = {r0[0], r0[2], r1[0], r1[2]}, sn[4] = {r0[1], r0[3], r1[1], r1[3]};
              const f32x4 g1 = *(const f32x4*)(gain + blk * 32 + fq * 4), g2 = *(const f32x4*)(gain + blk * 32 + 16 + fq * 4);
#pragma unroll
              for (int j = 0; j < 4; ++j) {
                const float x1 = acc[ai][bj][2 * blk][ni][j] * rinv * g1[j], x2 = acc[ai][bj][2 * blk + 1][ni][j] * rinv * g2[j];
                acc[ai][bj][2 * blk][ni][j] = x1 * cs[j] - x2 * sn[j];
                acc[ai][bj][2 * blk + 1][ni][j] = x2 * cs[j] + x1 * sn[j];
              }
            }
            st8_pair(p.proj + (size_t)m * N_C + nb, fq, acc[ai][bj][0][ni], acc[ai][bj][1][ni]);
            st8_pair(p.proj + (size_t)m * N_C + nb + 32, fq, acc[ai][bj][2][ni], acc[ai][bj][3][ni]);
          } else if (n0 < 1536) {
            bf16_t* vb = p.v1T + (size_t)(m - t) * 256 + t;
#pragma unroll
            for (int mi = 0; mi < 4; ++mi)
#pragma unroll
              for (int j = 0; j < 4; ++j) vb[(size_t)(nb - 1280 + mi * 16 + fq * 4 + j) * T] = f2bf(acc[ai][bj][mi][ni][j]);
          } else {
            f32x4 sv[4];
#pragma unroll
            for (int mi = 0; mi < 4; ++mi) {
              sv[mi] = acc[ai][bj][mi][ni];
              sv[mi][0] = silu_f(sv[mi][0]); sv[mi][1] = silu_f(sv[mi][1]); sv[mi][2] = silu_f(sv[mi][2]); sv[mi][3] = silu_f(sv[mi][3]);
            }
            st8_pair(p.proj + (size_t)m * N_C + nb, fq, sv[0], sv[1]);
            st8_pair(p.proj + (size_t)m * N_C + nb + 32, fq, sv[2], sv[3]);
          }
        }
      }
      if (EPI == 0 && (n0 == 1536 || n0 == 1792)) {
        ssq += __shfl_xor(ssq, 16);
        ssq += __shfl_xor(ssq, 32);
        if (fq == 0) atomicAdd((n0 == 1536) ? p.rss_q + m : p.rss_kv + m, ssq);
      }
    }
}

template <int EPI>
DI void gemm_tile(const Params& p, const bf16_t* __restrict__ X, int ldx, const bf16_t* __restrict__ Wt, int K,
                  int m0, int n0, char* lds) {
  constexpr int HTB = 16384;
  const int tid = fresh_tid(), lane = tid & 63, wid = __builtin_amdgcn_readfirstlane(tid >> 6);
  const int wr = wid >> 2, wc = wid & 3, fr = lane & 15, fq = lane >> 4;
  f32x4 acc[2][2][4][2];
#pragma unroll
  for (int a = 0; a < 2; ++a)
#pragma unroll
    for (int b = 0; b < 2; ++b)
#pragma unroll
      for (int c = 0; c < 4; ++c)
#pragma unroll
        for (int d = 0; d < 2; ++d) acc[a][b][c][d] = (f32x4){0.f, 0.f, 0.f, 0.f};
  bf16x8 At[4][2], B0[2][2], B1[2][2];
  int sr0, sc0, sr1, sc1;
  g8_stage_rc(tid * 16, sr0, sc0);
  g8_stage_rc(tid * 16 + 8192, sr1, sc1);
  const unsigned gw0 = (unsigned)(sr0 * K + sc0) * 2u, gw1 = (unsigned)(sr1 * K + sc1) * 2u, gx0 = (unsigned)(sr0 * ldx + sc0) * 2u, gx1 = (unsigned)(sr1 * ldx + sc1) * 2u;
  const bf16_t* wbase = Wt + (size_t)n0 * K;
  const bf16_t* xbase = X + (size_t)m0 * ldx;
  const int lw = tid * 16;
  const int lo = (fr * 64 + fq * 16) ^ ((fr >> 3) << 5);
  const int la = wr * 8 * 1024 + lo, lb = wc * 4 * 1024 + lo;
#define SA(b, h) (lds + ((b) * 2 + (h)) * HTB)
#define SB(b, h) (lds + (4 + (b) * 2 + (h)) * HTB)
#define STAGE_W(P, half, kt) do { const bf16_t* g_ = wbase + (size_t)(half) * 128 * K + (kt) * 64; \
    __builtin_amdgcn_global_load_lds((const GAS unsigned*)((const char*)g_ + gw0), (LAS unsigned*)((P) + lw), 16, 0, 0); \
    __builtin_amdgcn_global_load_lds((const GAS unsigned*)((const char*)g_ + gw1), (LAS unsigned*)((P) + lw + 8192), 16, 0, 0); } while (0)
#define STAGE_X(P, half, kt) do { const bf16_t* g_ = xbase + (size_t)(half) * 128 * ldx + (kt) * 64; \
    __builtin_amdgcn_global_load_lds((const GAS unsigned*)((const char*)g_ + gx0), (LAS unsigned*)((P) + lw), 16, 0, 0); \
    __builtin_amdgcn_global_load_lds((const GAS unsigned*)((const char*)g_ + gx1), (LAS unsigned*)((P) + lw + 8192), 16, 0, 0); } while (0)
#define LDA(dst, b, h) _Pragma("unroll") for (int m_ = 0; m_ < 4; ++m_) _Pragma("unroll") for (int k_ = 0; k_ < 2; ++k_) \
    dst[m_][k_] = *(const bf16x8*)(SA(b, h) + la + (m_ * 2 + k_) * 1024)
#define LDB(dst, b, h) _Pragma("unroll") for (int n_ = 0; n_ < 2; ++n_) _Pragma("unroll") for (int k_ = 0; k_ < 2; ++k_) \
    dst[n_][k_] = *(const bf16x8*)(SB(b, h) + lb + (n_ * 2 + k_) * 1024)
#define MMA(ai, bj, Af, Bf) do { __builtin_amdgcn_s_setprio(1); \
    _Pragma("unroll") for (int m_ = 0; m_ < 4; ++m_) _Pragma("unroll") for (int n_ = 0; n_ < 2; ++n_) _Pragma("unroll") for (int k_ = 0; k_ < 2; ++k_) \
      acc[ai][bj][m_][n_] = __builtin_amdgcn_mfma_f32_16x16x32_bf16(Af[m_][k_], Bf[n_][k_], acc[ai][bj][m_][n_], 0, 0, 0); \
    __builtin_amdgcn_s_setprio(0); } while (0)
#define WAIT_V(n) asm volatile("s_waitcnt vmcnt(" #n ")" ::: "memory")
#define WAIT_L(n) asm volatile("s_waitcnt lgkmcnt(" #n ")" ::: "memory")
#define BAR __builtin_amdgcn_s_barrier()
#define SCHED __builtin_amdgcn_sched_barrier(0)
  const int nt = K >> 6;
  STAGE_X(SB(0, 0), 0, 0); STAGE_W(SA(0, 0), 0, 0);
  STAGE_X(SB(0, 1), 1, 0); STAGE_W(SA(0, 1), 1, 0);
  if (wr == 1) BAR;
  WAIT_V(4); BAR;
  STAGE_X(SB(1, 0), 0, 1); STAGE_W(SA(1, 0), 0, 1); STAGE_X(SB(1, 1), 1, 1);
  WAIT_V(6); BAR;
  for (int t = 0; t < nt - 2; t += 2) {
    LDB(B0, 0, 0); SCHED; LDA(At, 0, 0); STAGE_W(SA(1, 1), 1, t + 1);
    WAIT_L(8); BAR; WAIT_L(0); MMA(0, 0, At, B0); BAR; SCHED;
    LDB(B1, 0, 1); STAGE_X(SB(0, 0), 0, t + 2);
    BAR; WAIT_L(0); MMA(0, 1, At, B1); BAR;
    LDA(At, 0, 1); STAGE_W(SA(0, 0), 0, t + 2);
    BAR; WAIT_L(0); MMA(1, 0, At, B0); BAR; SCHED;
    STAGE_X(SB(0, 1), 1, t + 2);
    WAIT_V(6); BAR; MMA(1, 1, At, B1); BAR;
    LDB(B0, 1, 0); SCHED; LDA(At, 1, 0); STAGE_W(SA(0, 1), 1, t + 2);
    WAIT_L(8); BAR; WAIT_L(0); MMA(0, 0, At, B0); BAR; SCHED;
    LDB(B1, 1, 1); STAGE_X(SB(1, 0), 0, t + 3);
    BAR; WAIT_L(0); MMA(0, 1, At, B1); BAR;
    LDA(At, 1, 1); STAGE_W(SA(1, 0), 0, t + 3);
    BAR; WAIT_L(0); MMA(1, 0, At, B0); BAR; SCHED;
    STAGE_X(SB(1, 1), 1, t + 3);
    WAIT_V(6); BAR; MMA(1, 1, At, B1); BAR;
  }
  { LDB(B0, 0, 0); LDA(At, 0, 0); STAGE_W(SA(1, 1), 1, nt - 1);
    BAR; WAIT_L(0); MMA(0, 0, At, B0); BAR;
    LDB(B1, 0, 1); BAR; WAIT_L(0); MMA(0, 1, At, B1); BAR;
    LDA(At, 0, 1); WAIT_V(4); BAR; WAIT_L(0); MMA(1, 0, At, B0); MMA(1, 1, At, B1); BAR; }
  { LDB(B0, 1, 0); LDA(At, 1, 0); WAIT_V(2); BAR; WAIT_L(0); MMA(0, 0, At, B0); BAR;
    LDB(B1, 1, 1); WAIT_V(0); BAR; WAIT_L(0); MMA(0, 1, At, B1); BAR;
    LDA(At, 1, 1); BAR; WAIT_L(0); MMA(1, 0, At, B0); MMA(1, 1, At, B1); BAR; }
  if (wr == 0) BAR;
  gemm_epilogue<EPI>(p, acc, m0, n0, wr, wc, fr, fq);
  __syncthreads();
#undef SA
#undef SB
#undef STAGE_W
#undef STAGE_X
#undef LDA
#undef LDB
#undef MMA
#undef WAIT_V
#undef WAIT_L
#undef BAR
#undef SCHED
}

template <int MODE>
DI void attn_unit(const Params& p, int u, char* lds) {
  constexpr int DQK = (MODE == 0) ? 96 : 64;
  constexpr int NC = DQK / 16;
  constexpr int KSTR = DQK * 2 + 16;
  constexpr int KTILE = 64 * KSTR;
  constexpr int VSTR = 144, VTILE = 64 * VSTR;
  const int tid = fresh_tid(), lane = tid & 63, wid = __builtin_amdgcn_readfirstlane(tid >> 6), ql = lane & 31, h = lane >> 5;

  int T, seq_row0, hh, qblk = 0, kvh = 0;
  int dd = 1, cls = 0, u0 = 0, cfg = 0, U = 0, NB = 1;
  if (MODE == 0) {
    if (u < 512) { const int x = u & 7, j = (u >> 3) & 31, r = u >> 8, g = r * 8 + x;
      T = 8192; hh = g & 7; qblk = j; seq_row0 = (g >> 3) * 8192; }
    else { const int v = u - 512, x = v & 7, j = (v >> 3) & 31, r = v >> 8, g = (r * 8 + x) * 2 + (j >> 4);
      T = 4096; hh = g & 7; qblk = j & 15; seq_row0 = M_PROMPT + (g >> 3) * 4096; }
  } else if (MODE == 1) {
    if (u < 1024) { const int x = u & 7, j = (u >> 3) & 31, r = u >> 8;
      T = 8192; kvh = x & 3; hh = kvh * 4 + r; qblk = j; seq_row0 = (x >> 2) * 8192; }
    else { const int v = u - 1024, x = v & 7, j = (v >> 3) & 31, r = v >> 8, g = 8 * (r >> 1) + x;
      T = 4096; kvh = g & 3; hh = kvh * 4 + (r & 1) * 2 + (j >> 4); qblk = j & 15; seq_row0 = M_PROMPT + (g >> 2) * 4096; }
  } else {
    int r;
    if (u < 512) { T = 8192; seq_row0 = (u >> 8) * 8192; hh = (u >> 5) & 7; r = u & 31;
      if (r < 8) { cfg = 0; cls = 0; NB = 4; u0 = r * 1024; }
      else if (r < 16) { cfg = 1; cls = (r - 8) >> 1; NB = 4; u0 = ((r - 8) & 1) * 1024; }
      else { cfg = 2; cls = r - 16; NB = 2; u0 = 0; } }
    else { const int v = u - 512; T = 4096; seq_row0 = M_PROMPT + (v / 192) * 4096; hh = (v / 24) & 7; r = v % 24;
      if (r < 4) { cfg = 0; cls = 0; NB = 4; u0 = r * 1024; }
      else if (r < 8) { cfg = 1; cls = r - 4; NB = 4; u0 = 0; }
      else { cfg = 2; cls = r - 8; NB = 1; u0 = 0; } }
    dd = 1 << (2 * cfg); U = T >> (2 * cfg);
  }

  int mq = 0;
  bf16x8 qf[NC];
  float c2, slope2 = 0.f;
  if (MODE == 0) c2 = 0.10206207261596577f * LOG2E;
  else c2 = 0.125f * LOG2E;
  if (MODE == 2) slope2 = exp2f(-(float)(hh + 1)) * (float)dd * LOG2E;
  auto load_q = [&](int b) {
    const bf16_t* qp;
    if (MODE == 0) { mq = seq_row0 + qblk * 256 + wid * 32 + ql; qp = p.qb + (size_t)mq * 768 + hh * 96 + 8 * h; }
    else if (MODE == 1) { mq = seq_row0 + qblk * 256 + wid * 32 + ql; qp = p.proj + (size_t)mq * N_C + hh * 64 + 8 * h; }
    else { mq = seq_row0 + (u0 + b * 256 + wid * 32 + ql) * dd + cls; qp = p.proj + (size_t)mq * N_AB + hh * 64 + 8 * h; }
#pragma unroll
    for (int c = 0; c < NC; ++c) {
      u32x4 w = *(const u32x4*)(qp + 16 * c);
#pragma unroll
      for (int j = 0; j < 4; ++j) w[j] = pk_bf16(bflo(w[j]) * c2, bfhi(w[j]) * c2);
      qf[c] = __builtin_bit_cast(bf16x8, w);
    }
  };
  load_q(0);

  int kt_lo = 0, kt_hi;
  if (MODE == 2) { kt_lo = (u0 == 0) ? 0 : -1; kt_hi = (u0 + 256 * NB >= U) ? 4 * NB - 1 : 4 * NB; }
  else kt_hi = (T >> 6) - 1;
  const int n_it = kt_hi - kt_lo + 1;

  unsigned zero_v = 0u;
  asm volatile("" : "+v"(zero_v));
  const u32x4 zero4 = (u32x4){zero_v, zero_v, zero_v, zero_v};
  u32x4 ka0, ka1 = zero4, va, kb0, kb1 = zero4, vb;
  const int key = tid >> 3, kc = tid & 7;
  const int rkey = (tid >> 2) & 63, rc = tid & 3;
  unsigned koffg, roffg = 0, voffg;
  if (MODE == 0) { koffg = (unsigned)(key * 512 + 8 * kc) * 2u; roffg = (unsigned)(rkey * 32 + 8 * rc) * 2u; voffg = (unsigned)(key * T + 8 * kc) * 2u; }
  else if (MODE == 1) { koffg = (unsigned)(key * N_C + 8 * kc) * 2u; voffg = (unsigned)(key * T + 8 * kc) * 2u; }
  else { koffg = (unsigned)(key * dd * N_AB + 8 * kc) * 2u; voffg = koffg; }
  auto gloadK = [&](int kt, u32x4& kr0, u32x4& kr1) {
    if (MODE == 0) {
      const char* kb = (const char*)(p.knope + (size_t)(seq_row0 + 64 * kt) * 512 + hh * 64);
      const char* rb = (const char*)(p.krope + (size_t)(seq_row0 + 64 * kt) * 32);
      kr0 = *(const u32x4*)(kb + koffg);
      if (tid < 256) kr1 = *(const u32x4*)(rb + roffg);
    } else if (MODE == 1) {
      const char* kb = (const char*)(p.proj + (size_t)(seq_row0 + 64 * kt) * N_C + 1024 + kvh * 64);
      kr0 = *(const u32x4*)(kb + koffg);
    } else {
      const char* kb = (const char*)(p.proj + ((size_t)seq_row0 + (size_t)(u0 + 64 * kt) * dd + cls) * N_AB + 512 + hh * 64);
      kr0 = *(const u32x4*)(kb + koffg);
    }
  };
  auto gloadV = [&](int kt, u32x4& vr) {
    if (MODE == 0) {
      const char* vb = (const char*)(p.vbT + (size_t)seq_row0 * 512 + (size_t)(hh * 64) * T + 64 * kt);
      vr = *(const u32x4*)(vb + voffg);
    } else if (MODE == 1) {
      const char* vb = (const char*)(p.v1T + (size_t)seq_row0 * 256 + (size_t)(kvh * 64) * T + 64 * kt);
      vr = *(const u32x4*)(vb + voffg);
    } else {
      const char* vb = (const char*)(p.proj + ((size_t)seq_row0 + (size_t)(u0 + 64 * kt) * dd + cls) * N_AB + 1024 + hh * 64);
      vr = *(const u32x4*)(vb + voffg);
    }
  };
  auto lwriteK = [&](int stg, const u32x4& kr0, const u32x4& kr1) {
    char* ks = lds + stg * KTILE;
    *(u32x4*)(ks + key * KSTR + kc * 16) = kr0;
    if (MODE == 0) { if (tid < 256) *(u32x4*)(ks + rkey * KSTR + 128 + rc * 16) = kr1; }
  };
  auto lwriteV = [&](int slot, const u32x4& vr) {
    char* vs = lds + 3 * KTILE + slot * VTILE;
    if (MODE != 2) {
      *(u32x4*)(vs + key * VSTR + kc * 16) = vr;
    } else {
#pragma unroll
      for (int j = 0; j < 4; ++j) {
        *(bf16_t*)(vs + (8 * kc + 2 * j) * VSTR + key * 2) = (bf16_t)(vr[j] & 0xffffu);
        *(bf16_t*)(vs + (8 * kc + 2 * j + 1) * VSTR + key * 2) = (bf16_t)(vr[j] >> 16);
      }
    }
  };

  f32x16 o0, o1;
#pragma unroll
  for (int i = 0; i < 16; ++i) { o0[i] = 0.f; o1[i] = 0.f; }
  const int sq = (ql & ~12) | ((ql & 4) << 1) | ((ql & 8) >> 1);
  const int koff = sq * KSTR + h * 16, voff = 3 * KTILE + ql * VSTR + h * 16;
  float m_ref = 0.f, l_run = 0.f;
  bool fresh = true;
  bool zref = true;
  int cur_b = (MODE == 2) ? -1 : 0;
  auto qk = [&](int stg, f32x16& s0, f32x16& s1) {
    const char* kp = lds + stg * KTILE + koff;
#pragma unroll
    for (int i = 0; i < 16; ++i) { s0[i] = 0.f; s1[i] = 0.f; }
#pragma unroll
    for (int c = 0; c < NC; ++c) {
      const bf16x8 k0 = *(const bf16x8*)(kp + c * 32);
      const bf16x8 k1 = *(const bf16x8*)(kp + 32 * KSTR + c * 32);
      s0 = MFMA32(k0, qf[c], s0);
      s1 = MFMA32(k1, qf[c], s1);
    }
  };
  auto rowmax = [&](int kt, f32x16& s0, f32x16& s1) -> float {
    float mx = -1e30f;
    if (MODE == 2) {
      const int base = 64 * kt + 8 * h - (256 * cur_b + 32 * wid + ql);
#pragma unroll
      for (int i = 0; i < 16; ++i) {
        const int d0 = base + 16 * (i >> 3) + (i & 7);
        const int d1 = d0 + 32;
        const int a0 = d0 < 0 ? -d0 : d0, a1 = d1 < 0 ? -d1 : d1;
        s0[i] = (a0 <= 64) ? (s0[i] - slope2 * (float)a0) : -1e30f;
        s1[i] = (a1 <= 64) ? (s1[i] - slope2 * (float)a1) : -1e30f;
        mx = fmaxf(mx, fmaxf(s0[i], s1[i]));
      }
    } else {
#pragma unroll
      for (int i = 0; i < 16; ++i) mx = fmaxf(mx, fmaxf(s0[i], s1[i]));
    }
    return fmaxf(mx, __shfl_xor(mx, 32));
  };
  u32x4 pa[2], pb[2];
#pragma unroll
  for (int s = 0; s < 2; ++s) { pa[s] = zero4; pb[s] = zero4; }
  auto pv = [&](int slot) {
    const char* vp = lds + slot * VTILE + voff;
#pragma unroll
    for (int s = 0; s < 2; ++s) {
      const bf16x8 pfa = __builtin_bit_cast(bf16x8, pa[s]), pfb = __builtin_bit_cast(bf16x8, pb[s]);
      const bf16x8 va0 = *(const bf16x8*)(vp + s * 32);
      const bf16x8 va1 = *(const bf16x8*)(vp + 32 * VSTR + s * 32);
      const bf16x8 vb0 = *(const bf16x8*)(vp + 64 + s * 32);
      const bf16x8 vb1 = *(const bf16x8*)(vp + 32 * VSTR + 64 + s * 32);
      o0 = MFMA32(va0, pfa, o0);
      o1 = MFMA32(va1, pfa, o1);
      o0 = MFMA32(vb0, pfb, o0);
      o1 = MFMA32(vb1, pfb, o1);
    }
  };
  auto softmax = [&](f32x16& s0, f32x16& s1, float mxr) {
    const bool upd = fresh ? (__builtin_amdgcn_ballot_w64(fabsf(mxr) > 24.f && mxr > -1e29f) != 0ull)
                           : (__builtin_amdgcn_ballot_w64(mxr - m_ref > 24.f) != 0ull);
    if (upd) {
      const float delta = fresh ? ((mxr > -1e29f) ? mxr : 0.f) : fmaxf(mxr - m_ref, 0.f);
      const float alpha = fresh ? 0.f : __builtin_amdgcn_exp2f(-delta);
      m_ref += delta;
      zref = false;
      l_run *= alpha;
#pragma unroll
      for (int i = 0; i < 16; ++i) { o0[i] *= alpha; o1[i] *= alpha; }
    }
    fresh = false;
    if (!zref) {
#pragma unroll
      for (int i = 0; i < 16; ++i) { s0[i] -= m_ref; s1[i] -= m_ref; }
    }
    float ls = 0.f;
    if (MODE == 2) {
#pragma unroll
      for (int i = 0; i < 16; ++i) {
        s0[i] = (s0[i] > -1e29f) ? __builtin_amdgcn_exp2f(s0[i]) : 0.f;
        s1[i] = (s1[i] > -1e29f) ? __builtin_amdgcn_exp2f(s1[i]) : 0.f;
        ls += s0[i] + s1[i];
      }
    } else {
#pragma unroll
      for (int i = 0; i < 16; ++i) {
        s0[i] = __builtin_amdgcn_exp2f(s0[i]);
        s1[i] = __builtin_amdgcn_exp2f(s1[i]);
        ls += s0[i] + s1[i];
      }
    }
    l_run += ls;
#pragma unroll
    for (int s = 0; s < 2; ++s)
#pragma unroll
      for (int j = 0; j < 4; ++j) {
        pa[s][j] = pk_bf16(s0[8 * s + 2 * j], s0[8 * s + 2 * j + 1]);
        pb[s][j] = pk_bf16(s1[8 * s + 2 * j], s1[8 * s + 2 * j + 1]);
      }
  };
  auto wave_active = [&](int kt) -> bool {
    if (MODE != 2) return true;
    const int wc = wid >> 1;
    return (kt >= wc - 1) && (kt <= wc + 1);
  };
  const bool late = (MODE == 2) ? false : (((wid >> 1) & 1) != 0);

  __syncthreads();
  gloadK(kt_lo, ka0, ka1); gloadV(kt_lo, va);
  lwriteK(0, ka0, ka1); lwriteV(0, va);
  gloadK(kt_lo + 1, ka0, ka1);
  lwriteK(1, ka0, ka1);
  if (MODE != 2) *(u32x4*)(lds + 3 * KTILE + 2 * VTILE + key * VSTR + kc * 16) = zero4;
  gloadK(kt_lo + 2, ka0, ka1);
  gloadV(kt_lo + 1, va);
  __syncthreads();
  f32x16 s0, s1;
#pragma unroll
  for (int i = 0; i < 16; ++i) { s0[i] = 0.f; s1[i] = 0.f; }
  float mx = -1e30f;
  if (late) { qk(0, s0, s1); mx = rowmax(kt_lo, s0, s1); }
  int sl_c = 0;
  auto finalize2 = [&]() {
    const float l_tot = l_run + __shfl_xor(l_run, 32);
    const float inv = 1.f / l_tot;
    bf16_t* dst = p.pA + (size_t)cfg * M_TOK * 512 + (size_t)mq * 512 + hh * 64;
#pragma unroll
    for (int g = 0; g < 4; ++g) {
      const int d = 8 * g + 4 * h;
      u32x2 w0, w1;
      w0[0] = pk_bf16(o0[4 * g] * inv, o0[4 * g + 1] * inv); w0[1] = pk_bf16(o0[4 * g + 2] * inv, o0[4 * g + 3] * inv);
      w1[0] = pk_bf16(o1[4 * g] * inv, o1[4 * g + 1] * inv); w1[1] = pk_bf16(o1[4 * g + 2] * inv, o1[4 * g + 3] * inv);
      *(u32x2*)(dst + d) = w0;
      *(u32x2*)(dst + 32 + d) = w1;
    }
    if (h == 0) p.lse[(size_t)cfg * M_TOK * 8 + (size_t)mq * 8 + hh] = m_ref + __builtin_amdgcn_logf(l_tot);
  };
  auto step = [&](int it, u32x4& nk0, u32x4& nk1, u32x4& nv, const u32x4& ok0, const u32x4& ok1, const u32x4& ov) {
    const int kt = kt_lo + it;
    const int sl_p = (sl_c == 0) ? 2 : sl_c - 1, sl_n = (sl_c == 2) ? 0 : sl_c + 1;
    if (it + 3 < n_it) gloadK(kt + 3, nk0, nk1);
    if (it + 2 < n_it) gloadV(kt + 2, nv);
    if (MODE == 2) {
      const int rel = kt - ((wid >> 1) - 1);
      const int b = rel >> 2, pos = rel & 3;
      if (rel >= 0 && b < NB && pos < 3) {
        if (b != cur_b) {
          cur_b = b;
          load_q(b);
#pragma unroll
          for (int i = 0; i < 16; ++i) { o0[i] = 0.f; o1[i] = 0.f; }
          l_run = 0.f; m_ref = 0.f; fresh = true; zref = true;
        }
        qk(sl_c, s0, s1);
        mx = rowmax(kt, s0, s1);
        softmax(s0, s1, mx);
        pv(sl_c);
        if (pos == 2 || kt == kt_hi) finalize2();
      }
    } else if (late) {
      softmax(s0, s1, mx);
      __builtin_amdgcn_sched_barrier(0);
      pv(sl_c);
      qk(sl_n, s0, s1);
      mx = rowmax(kt + 1, s0, s1);
    } else {
      pv(sl_p);
      qk(sl_c, s0, s1);
      __builtin_amdgcn_sched_barrier(0);
      mx = rowmax(kt, s0, s1);
      softmax(s0, s1, mx);
    }
    if (it + 2 < n_it) lwriteK(sl_p, ok0, ok1);
    if (it + 1 < n_it) lwriteV(sl_n, ov);
    __syncthreads();
    sl_c = sl_n;
  };
  for (int it = 0; it < n_it; it += 2) {
    step(it, kb0, kb1, vb, ka0, ka1, va);
    if (MODE != 2 || it + 1 < n_it) step(it + 1, ka0, ka1, va, kb0, kb1, vb);
  }
  if (MODE != 2 && !late) pv((sl_c == 0) ? 2 : sl_c - 1);
  if (MODE != 2) {
  const float l_tot = l_run + __shfl_xor(l_run, 32);
  const float inv = 1.f / l_tot;
  {
    const bf16_t* gp; bf16_t* dst;
    if (MODE == 0) { gp = p.proj + (size_t)mq * LD0 + (416 + 512) + hh * 64; dst = p.h + (size_t)mq * 1024 + 512 + hh * 64; }
    else { gp = p.proj + (size_t)mq * N_C + 1536 + hh * 64; dst = p.h + (size_t)mq * 1024 + hh * 64; }
#pragma unroll
    for (int g = 0; g < 4; ++g) {
      const int d = 8 * g + 4 * h;
      const u32x2 g0 = *(const u32x2*)(gp + d), g1 = *(const u32x2*)(gp + 32 + d);
      u32x2 w0, w1;
      w0[0] = pk_bf16(o0[4 * g] * inv * bflo(g0[0]), o0[4 * g + 1] * inv * bfhi(g0[0]));
      w0[1] = pk_bf16(o0[4 * g + 2] * inv * bflo(g0[1]), o0[4 * g + 3] * inv * bfhi(g0[1]));
      w1[0] = pk_bf16(o1[4 * g] * inv * bflo(g1[0]), o1[4 * g + 1] * inv * bfhi(g1[0]));
      w1[1] = pk_bf16(o1[4 * g + 2] * inv * bflo(g1[1]), o1[4 * g + 3] * inv * bfhi(g1[1]));
      *(u32x2*)(dst + d) = w0;
      *(u32x2*)(dst + 32 + d) = w1;
    }
  }
  }
}

template <int MODE>
DI void attn_dense(const Params& p, int u, char* lds) {
  constexpr int DQK = (MODE == 0) ? 96 : 64;
  constexpr int NC = DQK / 16;
  constexpr int KSTR = DQK * 2 + 16;
  constexpr int KTILE = 64 * KSTR;
  constexpr int VSTR = 144, VTILE = 64 * VSTR;
  const int tid = fresh_tid(), lane = tid & 63, wid = __builtin_amdgcn_readfirstlane(tid >> 6), ql = lane & 31, h = lane >> 5;

  int T, seq_row0, hh, qblk, kvh = 0;
  if (MODE == 0) {
    if (u < 512) { const int x = u & 7, j = (u >> 3) & 31, r = u >> 8, g = r * 8 + x;
      T = 8192; hh = g & 7; qblk = j; seq_row0 = (g >> 3) * 8192; }
    else { const int v = u - 512, x = v & 7, j = (v >> 3) & 31, r = v >> 8, g = (r * 8 + x) * 2 + (j >> 4);
      T = 4096; hh = g & 7; qblk = j & 15; seq_row0 = M_PROMPT + (g >> 3) * 4096; }
  } else {
    if (u < 1024) { const int x = u & 7, j = (u >> 3) & 31, r = u >> 8;
      T = 8192; kvh = x & 3; hh = kvh * 4 + r; qblk = j; seq_row0 = (x >> 2) * 8192; }
    else { const int v = u - 1024, x = v & 7, j = (v >> 3) & 31, r = v >> 8, g = 8 * (r >> 1) + x;
      T = 4096; kvh = g & 3; hh = kvh * 4 + (r & 1) * 2 + (j >> 4); qblk = j & 15; seq_row0 = M_PROMPT + (g >> 2) * 4096; }
  }
  const int mq = seq_row0 + qblk * 256 + wid * 32 + ql;
  const float c2 = (MODE == 0) ? 0.10206207261596577f * LOG2E : 0.125f * LOG2E;
  bf16x8 qf[NC];
  {
    const bf16_t* qp = (MODE == 0) ? p.qb + (size_t)mq * 768 + hh * 96 + 8 * h : p.proj + (size_t)mq * N_C + hh * 64 + 8 * h;
#pragma unroll
    for (int c = 0; c < NC; ++c) {
      u32x4 w = *(const u32x4*)(qp + 16 * c);
#pragma unroll
      for (int j = 0; j < 4; ++j) w[j] = pk_bf16(bflo(w[j]) * c2, bfhi(w[j]) * c2);
      qf[c] = __builtin_bit_cast(bf16x8, w);
    }
  }
  const int n_it = T >> 6;

  unsigned zero_v = 0u;
  asm volatile("" : "+v"(zero_v));
  const u32x4 zero4 = (u32x4){zero_v, zero_v, zero_v, zero_v};
  u32x4 kr0, kr1 = zero4, vr;
  const int key = tid >> 3, kc = tid & 7;
  const int rkey = (tid >> 2) & 63, rc = tid & 3;
  const unsigned koffg = (MODE == 0) ? (unsigned)(key * 512 + 8 * kc) * 2u : (unsigned)(key * N_C + 8 * kc) * 2u;
  const unsigned roffg = (unsigned)(rkey * 32 + 8 * rc) * 2u;
  const unsigned voffg = (unsigned)(key * T + 8 * kc) * 2u;
  auto gloadK = [&](int kt) {
    if (MODE == 0) {
      const char* kb = (const char*)(p.knope + (size_t)(seq_row0 + 64 * kt) * 512 + hh * 64);
      const char* rb = (const char*)(p.krope + (size_t)(seq_row0 + 64 * kt) * 32);
      kr0 = *(const u32x4*)(kb + koffg);
      if (tid < 256) kr1 = *(const u32x4*)(rb + roffg);
    } else {
      const char* kb = (const char*)(p.proj + (size_t)(seq_row0 + 64 * kt) * N_C + 1024 + kvh * 64);
      kr0 = *(const u32x4*)(kb + koffg);
    }
  };
  auto gloadV = [&](int kt) {
    const char* vb = (MODE == 0) ? (const char*)(p.vbT + (size_t)seq_row0 * 512 + (size_t)(hh * 64) * T + 64 * kt)
                                 : (const char*)(p.v1T + (size_t)seq_row0 * 256 + (size_t)(kvh * 64) * T + 64 * kt);
    vr = *(const u32x4*)(vb + voffg);
  };
  const int lwk = key * KSTR + kc * 16, lwr = rkey * KSTR + 128 + rc * 16, lwv = 3 * KTILE + key * VSTR + kc * 16;
  auto lwriteK = [&](int slot) {
    *(u32x4*)(lds + slot * KTILE + lwk) = kr0;
    if (MODE == 0) { if (tid < 256) *(u32x4*)(lds + slot * KTILE + lwr) = kr1; }
  };
  auto lwriteV = [&](int slot) { *(u32x4*)(lds + slot * VTILE + lwv) = vr; };

  f32x16 o0, o1;
#pragma unroll
  for (int i = 0; i < 16; ++i) { o0[i] = 0.f; o1[i] = 0.f; }
  const int sq = (ql & ~12) | ((ql & 4) << 1) | ((ql & 8) >> 1);
  const int koff = sq * KSTR + h * 16, voff = 3 * KTILE + ql * VSTR + h * 16;
  float m_ref = 0.f, l_run = 0.f;
  bool zref = true;
  u32x4 pa0 = zero4, pa1 = zero4, pb0 = zero4, pb1 = zero4;

  __syncthreads();
  gloadK(0); gloadV(0);
  lwriteK(0); lwriteV(0);
  gloadK(1);
  lwriteK(1);
  *(u32x4*)(lds + 2 * VTILE + lwv) = zero4;
  __syncthreads();
  {
    const char* kp = lds + koff;
    f32x16 t0, t1;
#pragma unroll
    for (int i = 0; i < 16; ++i) { t0[i] = 0.f; t1[i] = 0.f; }
#pragma unroll
    for (int c = 0; c < NC; ++c) {
      t0 = MFMA32(*(const bf16x8*)(kp + c * 32), qf[c], t0);
      t1 = MFMA32(*(const bf16x8*)(kp + 32 * KSTR + c * 32), qf[c], t1);
    }
    float mx = -1e30f;
#pragma unroll
    for (int i = 0; i < 16; ++i) mx = fmax_nc(mx, fmax_nc(t0[i], t1[i]));
    mx = fmax_nc(mx, __shfl_xor(mx, 32));
    if (__builtin_amdgcn_ballot_w64(fabsf(mx) > 24.f) != 0ull) { m_ref = mx; zref = false; }
  }
  int sl_c = 0;
  for (int it = 0; it < n_it; ++it) {
    const int sl_p = (sl_c == 0) ? 2 : sl_c - 1, sl_n = (sl_c == 2) ? 0 : sl_c + 1;
    if (it + 2 < n_it) gloadK(it + 2);
    if (it + 1 < n_it) gloadV(it + 1);
    const char* kp = lds + sl_c * KTILE + koff;
    const char* vp = lds + sl_p * VTILE + voff;
    {
      const bf16x8 pf0 = __builtin_bit_cast(bf16x8, pa0), pf1 = __builtin_bit_cast(bf16x8, pb0);
      const bf16x8 pf2 = __builtin_bit_cast(bf16x8, pa1), pf3 = __builtin_bit_cast(bf16x8, pb1);
      o0 = MFMA32(*(const bf16x8*)(vp), pf0, o0);
      o1 = MFMA32(*(const bf16x8*)(vp + 32 * VSTR), pf0, o1);
      o0 = MFMA32(*(const bf16x8*)(vp + 64), pf1, o0);
      o1 = MFMA32(*(const bf16x8*)(vp + 32 * VSTR + 64), pf1, o1);
      o0 = MFMA32(*(const bf16x8*)(vp + 32), pf2, o0);
      o1 = MFMA32(*(const bf16x8*)(vp + 32 * VSTR + 32), pf2, o1);
      o0 = MFMA32(*(const bf16x8*)(vp + 64 + 32), pf3, o0);
      o1 = MFMA32(*(const bf16x8*)(vp + 32 * VSTR + 64 + 32), pf3, o1);
    }
    f32x16 s0, s1;
#pragma unroll
    for (int i = 0; i < 16; ++i) { s0[i] = 0.f; s1[i] = 0.f; }
#pragma unroll
    for (int c = 0; c < NC; ++c) {
      s0 = MFMA32(*(const bf16x8*)(kp + c * 32), qf[c], s0);
      s1 = MFMA32(*(const bf16x8*)(kp + 32 * KSTR + c * 32), qf[c], s1);
    }
    if (!zref) {
#pragma unroll
      for (int i = 0; i < 16; ++i) { s0[i] -= m_ref; s1[i] -= m_ref; }
    }
    float ls = 0.f;
#pragma unroll
    for (int i = 0; i < 16; ++i) {
      s0[i] = __builtin_amdgcn_exp2f(s0[i]);
      s1[i] = __builtin_amdgcn_exp2f(s1[i]);
      ls += s0[i] + s1[i];
    }
    if (__builtin_amdgcn_ballot_w64(!(ls < 1e30f)) != 0ull) {
#pragma unroll
      for (int i = 0; i < 16; ++i) { s0[i] = 0.f; s1[i] = 0.f; }
#pragma unroll
      for (int c = 0; c < NC; ++c) {
        s0 = MFMA32(*(const bf16x8*)(kp + c * 32), qf[c], s0);
        s1 = MFMA32(*(const bf16x8*)(kp + 32 * KSTR + c * 32), qf[c], s1);
      }
      float mx = -1e30f;
#pragma unroll
      for (int i = 0; i < 16; ++i) mx = fmaxf(mx, fmaxf(s0[i], s1[i]));
      mx = fmaxf(mx, __shfl_xor(mx, 32));
      const float delta = fmaxf(mx - m_ref, 0.f);
      const float alpha = __builtin_amdgcn_exp2f(-delta);
      m_ref += delta;
      zref = false;
      l_run *= alpha;
#pragma unroll
      for (int i = 0; i < 16; ++i) { o0[i] *= alpha; o1[i] *= alpha; }
      ls = 0.f;
#pragma unroll
      for (int i = 0; i < 16; ++i) {
        s0[i] = __builtin_amdgcn_exp2f(s0[i] - m_ref);
        s1[i] = __builtin_amdgcn_exp2f(s1[i] - m_ref);
        ls += s0[i] + s1[i];
      }
    }
    l_run += ls;
#pragma unroll
    for (int j = 0; j < 4; ++j) {
      pa0[j] = pk_bf16(s0[2 * j], s0[2 * j + 1]);
      pa1[j] = pk_bf16(s0[8 + 2 * j], s0[8 + 2 * j + 1]);
      pb0[j] = pk_bf16(s1[2 * j], s1[2 * j + 1]);
      pb1[j] = pk_bf16(s1[8 + 2 * j], s1[8 + 2 * j + 1]);
    }
    if (it + 2 < n_it) lwriteK(sl_p);
    if (it + 1 < n_it) lwriteV(sl_n);
    __syncthreads();
    sl_c = sl_n;
  }
  {
    const char* vp = lds + ((sl_c == 0) ? 2 : sl_c - 1) * VTILE + voff;
    const bf16x8 pf0 = __builtin_bit_cast(bf16x8, pa0), pf1 = __builtin_bit_cast(bf16x8, pb0);
    const bf16x8 pf2 = __builtin_bit_cast(bf16x8, pa1), pf3 = __builtin_bit_cast(bf16x8, pb1);
    o0 = MFMA32(*(const bf16x8*)(vp), pf0, o0);
    o1 = MFMA32(*(const bf16x8*)(vp + 32 * VSTR), pf0, o1);
    o0 = MFMA32(*(const bf16x8*)(vp + 64), pf1, o0);
    o1 = MFMA32(*(const bf16x8*)(vp + 32 * VSTR + 64), pf1, o1);
    o0 = MFMA32(*(const bf16x8*)(vp + 32), pf2, o0);
    o1 = MFMA32(*(const bf16x8*)(vp + 32 * VSTR + 32), pf2, o1);
    o0 = MFMA32(*(const bf16x8*)(vp + 64 + 32), pf3, o0);
    o1 = MFMA32(*(const bf16x8*)(vp + 32 * VSTR + 64 + 32), pf3, o1);
  }
  const float l_tot = l_run + __shfl_xor(l_run, 32);
  const float inv = 1.f / l_tot;
  const bf16_t* gp; bf16_t* dst;
  if (MODE == 0) { gp = p.proj + (size_t)mq * LD0 + (416 + 512) + hh * 64; dst = p.h + (size_t)mq * 1024 + 512 + hh * 64; }
  else { gp = p.proj + (size_t)mq * N_C + 1536 + hh * 64; dst = p.h + (size_t)mq * 1024 + hh * 64; }
#pragma unroll
  for (int g = 0; g < 4; ++g) {
    const int d = 8 * g + 4 * h;
    const u32x2 g0 = *(const u32x2*)(gp + d), g1 = *(const u32x2*)(gp + 32 + d);
    u32x2 w0, w1;
    w0[0] = pk_bf16(o0[4 * g] * inv * bflo(g0[0]), o0[4 * g + 1] * inv * bfhi(g0[0]));
    w0[1] = pk_bf16(o0[4 * g + 2] * inv * bflo(g0[1]), o0[4 * g + 3] * inv * bfhi(g0[1]));
    w1[0] = pk_bf16(o1[4 * g] * inv * bflo(g1[0]), o1[4 * g + 1] * inv * bfhi(g1[0]));
    w1[1] = pk_bf16(o1[4 * g + 2] * inv * bflo(g1[1]), o1[4 * g + 3] * inv * bfhi(g1[1]));
    *(u32x2*)(dst + d) = w0;
    *(u32x2*)(dst + 32 + d) = w1;
  }
}

template <int MODE, bool SPLIT = false, bool PIPE = false>
DI void attn_dense128(const Params& p, int u, char* lds) {
  constexpr int DQK = (MODE == 0) ? 96 : 64;
  constexpr int NC = DQK / 16;
  constexpr int KSTR = DQK * 2 + 16;
  constexpr int KTILE = 128 * KSTR;
  constexpr int VSTR = 272, VTILE = 64 * VSTR;
  const int tid = fresh_tid(), lane = tid & 63, wid = __builtin_amdgcn_readfirstlane(tid >> 6), ql = lane & 31, h = lane >> 5;

  int T, seq_row0, hh, qblk, kvh = 0;
  if (MODE == 0) {
    if (u < 512) { const int x = u & 7, j = (u >> 3) & 31, r = u >> 8, g = r * 8 + x;
      T = 8192; hh = g & 7; qblk = j; seq_row0 = (g >> 3) * 8192; }
    else { const int v = u - 512, x = v & 7, j = (v >> 3) & 31, r = v >> 8, g = (r * 8 + x) * 2 + (j >> 4);
      T = 4096; hh = g & 7; qblk = j & 15; seq_row0 = M_PROMPT + (g >> 3) * 4096; }
  } else {
    if (u < 1024) { const int x = u & 7, j = (u >> 3) & 31, r = u >> 8;
      T = 8192; kvh = x & 3; hh = kvh * 4 + r; qblk = j; seq_row0 = (x >> 2) * 8192; }
    else { const int v = u - 1024, x = v & 7, j = (v >> 3) & 31, r = v >> 8, g = 8 * (r >> 1) + x;
      T = 4096; kvh = g & 3; hh = kvh * 4 + (r & 1) * 2 + (j >> 4); qblk = j & 15; seq_row0 = M_PROMPT + (g >> 2) * 4096; }
  }
  const int mq = seq_row0 + qblk * 256 + wid * 32 + ql;
  const float c2 = (MODE == 0) ? 0.10206207261596577f * LOG2E : 0.125f * LOG2E;
  bf16x8 qf[NC];
  {
    const bf16_t* qp = (MODE == 0) ? p.qb + (size_t)mq * 768 + hh * 96 + 8 * h : p.proj + (size_t)mq * N_C + hh * 64 + 8 * h;
#pragma unroll
    for (int c = 0; c < NC; ++c) {
      u32x4 w = *(const u32x4*)(qp + 16 * c);
#pragma unroll
      for (int j = 0; j < 4; ++j) w[j] = pk_bf16(bflo(w[j]) * c2, bfhi(w[j]) * c2);
      qf[c] = __builtin_bit_cast(bf16x8, w);
    }
  }
  const int n_it = T >> 7;

  unsigned zero_v = 0u;
  asm volatile("" : "+v"(zero_v));
  const u32x4 zero4 = (u32x4){zero_v, zero_v, zero_v, zero_v};
  u32x4 kr0, kr1, kr2 = zero4, vr0, vr1;
  const int key = tid >> 3, kc = tid & 7;
  const int rkey = tid >> 2, rc = tid & 3;
  const int vd = tid >> 4, vc = tid & 15;
  const unsigned koffg = (MODE == 0) ? (unsigned)(key * 512 + 8 * kc) * 2u : (unsigned)(key * N_C + 8 * kc) * 2u;
  const unsigned koffg2 = (MODE == 0) ? 64u * 512u * 2u : 64u * (unsigned)N_C * 2u;
  const unsigned roffg = (unsigned)(rkey * 32 + 8 * rc) * 2u;
  const unsigned voffg = (unsigned)(vd * T + 8 * vc) * 2u, voffg2 = (unsigned)(32 * T) * 2u;
  auto gloadK = [&](int kt) {
    if (MODE == 0) {
      const char* kb = (const char*)(p.knope + (size_t)(seq_row0 + 128 * kt) * 512 + hh * 64);
      const char* rb = (const char*)(p.krope + (size_t)(seq_row0 + 128 * kt) * 32);
      kr0 = *(const u32x4*)(kb + koffg);
      kr1 = *(const u32x4*)(kb + koffg + koffg2);
      kr2 = *(const u32x4*)(rb + roffg);
    } else {
      const char* kb = (const char*)(p.proj + (size_t)(seq_row0 + 128 * kt) * N_C + 1024 + kvh * 64);
      kr0 = *(const u32x4*)(kb + koffg);
      kr1 = *(const u32x4*)(kb + koffg + koffg2);
    }
  };
  auto gloadV = [&](int kt) {
    const char* vb = (MODE == 0) ? (const char*)(p.vbT + (size_t)seq_row0 * 512 + (size_t)(hh * 64) * T + 128 * kt)
                                 : (const char*)(p.v1T + (size_t)seq_row0 * 256 + (size_t)(kvh * 64) * T + 128 * kt);
    vr0 = *(const u32x4*)(vb + voffg);
    vr1 = *(const u32x4*)(vb + voffg + voffg2);
  };
  const int lwk = key * KSTR + kc * 16, lwr = rkey * KSTR + 128 + rc * 16, lwv = 3 * KTILE + vd * VSTR + vc * 16;
  auto lwriteK = [&](int slot) {
    *(u32x4*)(lds + slot * KTILE + lwk) = kr0;
    *(u32x4*)(lds + slot * KTILE + lwk + 64 * KSTR) = kr1;
    if (MODE == 0) *(u32x4*)(lds + slot * KTILE + lwr) = kr2;
  };
  auto lwriteV = [&](int slot) {
    *(u32x4*)(lds + slot * VTILE + lwv) = vr0;
    *(u32x4*)(lds + slot * VTILE + lwv + 32 * VSTR) = vr1;
  };

  f32x16 o0, o1;
#pragma unroll
  for (int i = 0; i < 16; ++i) { o0[i] = 0.f; o1[i] = 0.f; }
  const int sq = (ql & ~12) | ((ql & 4) << 1) | ((ql & 8) >> 1);
  const int koff = sq * KSTR + h * 16, voff = 3 * KTILE + ql * VSTR + h * 16;
  float m_ref = 0.f, l_run = 0.f;
  bool zref = true;
  u32x4 pk[4][2];
#pragma unroll
  for (int b = 0; b < 4; ++b) { pk[b][0] = zero4; pk[b][1] = zero4; }

  __syncthreads();
  gloadK(0); gloadV(0);
  lwriteK(0); lwriteV(0);
  gloadK(1);
  lwriteK(1);
  *(u32x4*)(lds + 2 * VTILE + lwv) = zero4;
  *(u32x4*)(lds + 2 * VTILE + lwv + 32 * VSTR) = zero4;
  __syncthreads();
  f32x16 t0, t1;
  {
    const char* kp = lds + koff;
#pragma unroll
    for (int i = 0; i < 16; ++i) { t0[i] = 0.f; t1[i] = 0.f; }
#pragma unroll
    for (int c = 0; c < NC; ++c) {
      t0 = MFMA32(*(const bf16x8*)(kp + c * 32), qf[c], t0);
      t1 = MFMA32(*(const bf16x8*)(kp + 32 * KSTR + c * 32), qf[c], t1);
    }
    float mx = -1e30f;
#pragma unroll
    for (int i = 0; i < 16; ++i) mx = fmax_nc(mx, fmax_nc(t0[i], t1[i]));
    mx = fmax_nc(mx, __shfl_xor(mx, 32));
    if (__builtin_amdgcn_ballot_w64(fabsf(mx) > 24.f) != 0ull) { m_ref = mx; zref = false; }
  }
  if (PIPE) {
    u32x4 qa0 = zero4, qa1 = zero4, qb0 = zero4, qb1 = zero4;
    f32x16 sA0 = t0, sA1 = t1, sB0, sB1;
    auto half_step = [&](f32x16& c0, f32x16& c1, f32x16& n0, f32x16& n1, const char* kp_next, const char* vp_prev, const char* kp_cur) {
      if (!zref) {
#pragma unroll
        for (int i = 0; i < 16; ++i) { c0[i] -= m_ref; c1[i] -= m_ref; }
      }
      {
        const bf16x8 pf0 = __builtin_bit_cast(bf16x8, qa0), pf1 = __builtin_bit_cast(bf16x8, qb0);
        const bf16x8 pf2 = __builtin_bit_cast(bf16x8, qa1), pf3 = __builtin_bit_cast(bf16x8, qb1);
        o0 = MFMA32(*(const bf16x8*)(vp_prev), pf0, o0);
        o1 = MFMA32(*(const bf16x8*)(vp_prev + 32 * VSTR), pf0, o1);
        o0 = MFMA32(*(const bf16x8*)(vp_prev + 64), pf1, o0);
        o1 = MFMA32(*(const bf16x8*)(vp_prev + 32 * VSTR + 64), pf1, o1);
        o0 = MFMA32(*(const bf16x8*)(vp_prev + 32), pf2, o0);
        o1 = MFMA32(*(const bf16x8*)(vp_prev + 32 * VSTR + 32), pf2, o1);
        o0 = MFMA32(*(const bf16x8*)(vp_prev + 64 + 32), pf3, o0);
        o1 = MFMA32(*(const bf16x8*)(vp_prev + 32 * VSTR + 64 + 32), pf3, o1);
      }
#pragma unroll
      for (int i = 0; i < 16; ++i) { n0[i] = 0.f; n1[i] = 0.f; }
#pragma unroll
      for (int c = 0; c < NC; ++c) {
        n0 = MFMA32(*(const bf16x8*)(kp_next + c * 32), qf[c], n0);
        n1 = MFMA32(*(const bf16x8*)(kp_next + 32 * KSTR + c * 32), qf[c], n1);
      }
      float ls = 0.f;
#pragma unroll
      for (int i = 0; i < 16; ++i) {
        c0[i] = __builtin_amdgcn_exp2f(c0[i]);
        c1[i] = __builtin_amdgcn_exp2f(c1[i]);
        ls += c0[i] + c1[i];
      }
#pragma unroll
      for (int g = 0; g < 2 * NC + 8; ++g) {
        __builtin_amdgcn_sched_group_barrier(0x008, 1, 0);
        __builtin_amdgcn_sched_group_barrier(0x002, (MODE == 0) ? 3 : 4, 0);
      }
      if (__builtin_amdgcn_ballot_w64(!(ls < 1e30f)) != 0ull) {
        const float m_old = m_ref;
#pragma unroll
        for (int i = 0; i < 16; ++i) { c0[i] = 0.f; c1[i] = 0.f; }
#pragma unroll
        for (int c = 0; c < NC; ++c) {
          c0 = MFMA32(*(const bf16x8*)(kp_cur + c * 32), qf[c], c0);
          c1 = MFMA32(*(const bf16x8*)(kp_cur + 32 * KSTR + c * 32), qf[c], c1);
        }
        float mx = -1e30f;
#pragma unroll
        for (int i = 0; i < 16; ++i) mx = fmaxf(mx, fmaxf(c0[i], c1[i]));
        mx = fmaxf(mx, __shfl_xor(mx, 32));
        const float delta = fmaxf(mx - m_ref, 0.f);
        const float alpha = __builtin_amdgcn_exp2f(-delta);
        m_ref += delta;
        zref = false;
        l_run *= alpha;
#pragma unroll
        for (int i = 0; i < 16; ++i) { o0[i] *= alpha; o1[i] *= alpha; }
        ls = 0.f;
#pragma unroll
        for (int i = 0; i < 16; ++i) {
          c0[i] = __builtin_amdgcn_exp2f(c0[i] - m_ref);
          c1[i] = __builtin_amdgcn_exp2f(c1[i] - m_ref);
          ls += c0[i] + c1[i];
        }
        (void)m_old;
      }
      l_run += ls;
#pragma unroll
      for (int j = 0; j < 4; ++j) {
        qa0[j] = pk_bf16(c0[2 * j], c0[2 * j + 1]);
        qa1[j] = pk_bf16(c0[8 + 2 * j], c0[8 + 2 * j + 1]);
        qb0[j] = pk_bf16(c1[2 * j], c1[2 * j + 1]);
        qb1[j] = pk_bf16(c1[8 + 2 * j], c1[8 + 2 * j + 1]);
      }
    };
    int sl_c = 0;
    for (int it = 0; it < n_it; ++it) {
      const int sl_p = (sl_c == 0) ? 2 : sl_c - 1, sl_n = (sl_c == 2) ? 0 : sl_c + 1;
      if (it + 2 < n_it) gloadK(it + 2);
      if (it + 1 < n_it) gloadV(it + 1);
      half_step(sA0, sA1, sB0, sB1, lds + sl_c * KTILE + 64 * KSTR + koff, lds + sl_p * VTILE + voff + 128, lds + sl_c * KTILE + koff);
      half_step(sB0, sB1, sA0, sA1, lds + sl_n * KTILE + koff, lds + sl_c * VTILE + voff, lds + sl_c * KTILE + 64 * KSTR + koff);
      if (it + 2 < n_it) lwriteK(sl_p);
      if (it + 1 < n_it) lwriteV(sl_n);
      __syncthreads();
      sl_c = sl_n;
    }
    {
      const char* vp = lds + ((sl_c == 0) ? 2 : sl_c - 1) * VTILE + voff + 128;
      const bf16x8 pf0 = __builtin_bit_cast(bf16x8, qa0), pf1 = __builtin_bit_cast(bf16x8, qb0);
      const bf16x8 pf2 = __builtin_bit_cast(bf16x8, qa1), pf3 = __builtin_bit_cast(bf16x8, qb1);
      o0 = MFMA32(*(const bf16x8*)(vp), pf0, o0);
      o1 = MFMA32(*(const bf16x8*)(vp + 32 * VSTR), pf0, o1);
      o0 = MFMA32(*(const bf16x8*)(vp + 64), pf1, o0);
      o1 = MFMA32(*(const bf16x8*)(vp + 32 * VSTR + 64), pf1, o1);
      o0 = MFMA32(*(const bf16x8*)(vp + 32), pf2, o0);
      o1 = MFMA32(*(const bf16x8*)(vp + 32 * VSTR + 32), pf2, o1);
      o0 = MFMA32(*(const bf16x8*)(vp + 64 + 32), pf3, o0);
      o1 = MFMA32(*(const bf16x8*)(vp + 32 * VSTR + 64 + 32), pf3, o1);
    }
  } else if (SPLIT) {
    u32x4 qa0 = zero4, qa1 = zero4, qb0 = zero4, qb1 = zero4;
    int sl_c = 0;
    for (int it = 0; it < n_it; ++it) {
      const int sl_p = (sl_c == 0) ? 2 : sl_c - 1, sl_n = (sl_c == 2) ? 0 : sl_c + 1;
      if (it + 2 < n_it) gloadK(it + 2);
      if (it + 1 < n_it) gloadV(it + 1);
#pragma unroll
      for (int hf = 0; hf < 2; ++hf) {
        const char* kp = lds + sl_c * KTILE + hf * 64 * KSTR + koff;
        const char* vp = lds + ((hf == 0) ? sl_p : sl_c) * VTILE + voff + (1 - hf) * 128;
        {
          const bf16x8 pf0 = __builtin_bit_cast(bf16x8, qa0), pf1 = __builtin_bit_cast(bf16x8, qb0);
          const bf16x8 pf2 = __builtin_bit_cast(bf16x8, qa1), pf3 = __builtin_bit_cast(bf16x8, qb1);
          o0 = MFMA32(*(const bf16x8*)(vp), pf0, o0);
          o1 = MFMA32(*(const bf16x8*)(vp + 32 * VSTR), pf0, o1);
          o0 = MFMA32(*(const bf16x8*)(vp + 64), pf1, o0);
          o1 = MFMA32(*(const bf16x8*)(vp + 32 * VSTR + 64), pf1, o1);
          o0 = MFMA32(*(const bf16x8*)(vp + 32), pf2, o0);
          o1 = MFMA32(*(const bf16x8*)(vp + 32 * VSTR + 32), pf2, o1);
          o0 = MFMA32(*(const bf16x8*)(vp + 64 + 32), pf3, o0);
          o1 = MFMA32(*(const bf16x8*)(vp + 32 * VSTR + 64 + 32), pf3, o1);
        }
        f32x16 s0, s1;
#pragma unroll
        for (int i = 0; i < 16; ++i) { s0[i] = 0.f; s1[i] = 0.f; }
#pragma unroll
        for (int c = 0; c < NC; ++c) {
          s0 = MFMA32(*(const bf16x8*)(kp + c * 32), qf[c], s0);
          s1 = MFMA32(*(const bf16x8*)(kp + 32 * KSTR + c * 32), qf[c], s1);
        }
        if (!zref) {
#pragma unroll
          for (int i = 0; i < 16; ++i) { s0[i] -= m_ref; s1[i] -= m_ref; }
        }
        float ls = 0.f;
#pragma unroll
        for (int i = 0; i < 16; ++i) {
          s0[i] = __builtin_amdgcn_exp2f(s0[i]);
          s1[i] = __builtin_amdgcn_exp2f(s1[i]);
          ls += s0[i] + s1[i];
        }
        if (__builtin_amdgcn_ballot_w64(!(ls < 1e30f)) != 0ull) {
#pragma unroll
          for (int i = 0; i < 16; ++i) { s0[i] = 0.f; s1[i] = 0.f; }
#pragma unroll
          for (int c = 0; c < NC; ++c) {
            s0 = MFMA32(*(const bf16x8*)(kp + c * 32), qf[c], s0);
            s1 = MFMA32(*(const bf16x8*)(kp + 32 * KSTR + c * 32), qf[c], s1);
          }
          float mx = -1e30f;
#pragma unroll
          for (int i = 0; i < 16; ++i) mx = fmaxf(mx, fmaxf(s0[i], s1[i]));
          mx = fmaxf(mx, __shfl_xor(mx, 32));
          const float delta = fmaxf(mx - m_ref, 0.f);
          const float alpha = __builtin_amdgcn_exp2f(-delta);
          m_ref += delta;
          zref = false;
          l_run *= alpha;
#pragma unroll
          for (int i = 0; i < 16; ++i) { o0[i] *= alpha; o1[i] *= alpha; }
          ls = 0.f;
#pragma unroll
          for (int i = 0; i < 16; ++i) {
            s0[i] = __builtin_amdgcn_exp2f(s0[i] - m_ref);
            s1[i] = __builtin_amdgcn_exp2f(s1[i] - m_ref);
            ls += s0[i] + s1[i];
          }
        }
        l_run += ls;
#pragma unroll
        for (int j = 0; j < 4; ++j) {
          qa0[j] = pk_bf16(s0[2 * j], s0[2 * j + 1]);
          qa1[j] = pk_bf16(s0[8 + 2 * j], s0[8 + 2 * j + 1]);
          qb0[j] = pk_bf16(s1[2 * j], s1[2 * j + 1]);
          qb1[j] = pk_bf16(s1[8 + 2 * j], s1[8 + 2 * j + 1]);
        }
      }
      if (it + 2 < n_it) lwriteK(sl_p);
      if (it + 1 < n_it) lwriteV(sl_n);
      __syncthreads();
      sl_c = sl_n;
    }
    {
      const char* vp = lds + ((sl_c == 0) ? 2 : sl_c - 1) * VTILE + voff + 128;
      const bf16x8 pf0 = __builtin_bit_cast(bf16x8, qa0), pf1 = __builtin_bit_cast(bf16x8, qb0);
      const bf16x8 pf2 = __builtin_bit_cast(bf16x8, qa1), pf3 = __builtin_bit_cast(bf16x8, qb1);
      o0 = MFMA32(*(const bf16x8*)(vp), pf0, o0);
      o1 = MFMA32(*(const bf16x8*)(vp + 32 * VSTR), pf0, o1);
      o0 = MFMA32(*(const bf16x8*)(vp + 64), pf1, o0);
      o1 = MFMA32(*(const bf16x8*)(vp + 32 * VSTR + 64), pf1, o1);
      o0 = MFMA32(*(const bf16x8*)(vp + 32), pf2, o0);
      o1 = MFMA32(*(const bf16x8*)(vp + 32 * VSTR + 32), pf2, o1);
      o0 = MFMA32(*(const bf16x8*)(vp + 64 + 32), pf3, o0);
      o1 = MFMA32(*(const bf16x8*)(vp + 32 * VSTR + 64 + 32), pf3, o1);
    }
  } else {
  int sl_c = 0;
  for (int it = 0; it < n_it; ++it) {
    const int sl_p = (sl_c == 0) ? 2 : sl_c - 1, sl_n = (sl_c == 2) ? 0 : sl_c + 1;
    if (it + 2 < n_it) gloadK(it + 2);
    if (it + 1 < n_it) gloadV(it + 1);
    const char* kp = lds + sl_c * KTILE + koff;
    const char* vp = lds + sl_p * VTILE + voff;
#pragma unroll
    for (int b = 0; b < 4; ++b)
#pragma unroll
      for (int s = 0; s < 2; ++s) {
        const bf16x8 pf = __builtin_bit_cast(bf16x8, pk[b][s]);
        o0 = MFMA32(*(const bf16x8*)(vp + b * 64 + s * 32), pf, o0);
        o1 = MFMA32(*(const bf16x8*)(vp + 32 * VSTR + b * 64 + s * 32), pf, o1);
      }
    f32x16 sc[4];
#pragma unroll
    for (int b = 0; b < 4; ++b) {
      if (MODE == 0) __builtin_amdgcn_sched_barrier(0);
#pragma unroll
      for (int i = 0; i < 16; ++i) sc[b][i] = 0.f;
#pragma unroll
      for (int c = 0; c < NC; ++c) sc[b] = MFMA32(*(const bf16x8*)(kp + b * 32 * KSTR + c * 32), qf[c], sc[b]);
    }
    if (MODE == 0) __builtin_amdgcn_sched_barrier(0);
    if (!zref) {
#pragma unroll
      for (int b = 0; b < 4; ++b)
#pragma unroll
        for (int i = 0; i < 16; ++i) sc[b][i] -= m_ref;
    }
    float ls = 0.f;
#pragma unroll
    for (int b = 0; b < 4; ++b)
#pragma unroll
      for (int i = 0; i < 16; ++i) { sc[b][i] = __builtin_amdgcn_exp2f(sc[b][i]); ls += sc[b][i]; }
    if (__builtin_amdgcn_ballot_w64(!(ls < 1e30f)) != 0ull) {
      float mx = -1e30f;
#pragma unroll
      for (int b = 0; b < 4; ++b) {
#pragma unroll
        for (int i = 0; i < 16; ++i) sc[b][i] = 0.f;
#pragma unroll
        for (int c = 0; c < NC; ++c) sc[b] = MFMA32(*(const bf16x8*)(kp + b * 32 * KSTR + c * 32), qf[c], sc[b]);
#pragma unroll
        for (int i = 0; i < 16; ++i) mx = fmaxf(mx, sc[b][i]);
      }
      mx = fmaxf(mx, __shfl_xor(mx, 32));
      const float delta = fmaxf(mx - m_ref, 0.f);
      const float alpha = __builtin_amdgcn_exp2f(-delta);
      m_ref += delta;
      zref = false;
      l_run *= alpha;
#pragma unroll
      for (int i = 0; i < 16; ++i) { o0[i] *= alpha; o1[i] *= alpha; }
      ls = 0.f;
#pragma unroll
      for (int b = 0; b < 4; ++b)
#pragma unroll
        for (int i = 0; i < 16; ++i) { sc[b][i] = __builtin_amdgcn_exp2f(sc[b][i] - m_ref); ls += sc[b][i]; }
    }
    l_run += ls;
#pragma unroll
    for (int b = 0; b < 4; ++b)
#pragma unroll
      for (int s = 0; s < 2; ++s)
#pragma unroll
        for (int j = 0; j < 4; ++j) pk[b][s][j] = pk_bf16(sc[b][8 * s + 2 * j], sc[b][8 * s + 2 * j + 1]);
    if (it + 2 < n_it) lwriteK(sl_p);
    if (it + 1 < n_it) lwriteV(sl_n);
    __syncthreads();
    sl_c = sl_n;
  }
  {
    const char* vp = lds + ((sl_c == 0) ? 2 : sl_c - 1) * VTILE + voff;
#pragma unroll
    for (int b = 0; b < 4; ++b)
#pragma unroll
      for (int s = 0; s < 2; ++s) {
        const bf16x8 pf = __builtin_bit_cast(bf16x8, pk[b][s]);
        o0 = MFMA32(*(const bf16x8*)(vp + b * 64 + s * 32), pf, o0);
        o1 = MFMA32(*(const bf16x8*)(vp + 32 * VSTR + b * 64 + s * 32), pf, o1);
      }
  }
  }
  const float l_tot = l_run + __shfl_xor(l_run, 32);
  const float inv = 1.f / l_tot;
  const bf16_t* gp; bf16_t* dst;
  if (MODE == 0) { gp = p.proj + (size_t)mq * LD0 + (416 + 512) + hh * 64; dst = p.h + (size_t)mq * 1024 + 512 + hh * 64; }
  else { gp = p.proj + (size_t)mq * N_C + 1536 + hh * 64; dst = p.h + (size_t)mq * 1024 + hh * 64; }
  u32x2 w0[4], w1[4];
#pragma unroll
  for (int g = 0; g < 4; ++g) {
    const int d = 8 * g + 4 * h;
    const u32x2 g0 = *(const u32x2*)(gp + d), g1 = *(const u32x2*)(gp + 32 + d);
    w0[g][0] = pk_bf16(o0[4 * g] * inv * bflo(g0[0]), o0[4 * g + 1] * inv * bfhi(g0[0]));
    w0[g][1] = pk_bf16(o0[4 * g + 2] * inv * bflo(g0[1]), o0[4 * g + 3] * inv * bfhi(g0[1]));
    w1[g][0] = pk_bf16(o1[4 * g] * inv * bflo(g1[0]), o1[4 * g + 1] * inv * bfhi(g1[0]));
    w1[g][1] = pk_bf16(o1[4 * g + 2] * inv * bflo(g1[1]), o1[4 * g + 3] * inv * bfhi(g1[1]));
  }
  st_pair16(dst, 0, h, w0[0], w0[1]);
  st_pair16(dst, 2, h, w0[2], w0[3]);
  st_pair16(dst + 32, 0, h, w1[0], w1[1]);
  st_pair16(dst + 32, 2, h, w1[2], w1[3]);
}

DI void attn_dilated(const Params& p, int u, char* lds) {
  constexpr int KSTR = 144, KBYTES = 384 * KSTR;
  constexpr int VSTR = 192;
  const int tid = fresh_tid(), lane = tid & 63, wid = __builtin_amdgcn_readfirstlane(tid >> 6), ql = lane & 31, h = lane >> 5;
  int T, seq_row0, hh, cfg, cls, u0, NB;
  {
    int r;
    if (u < 512) { T = 8192; seq_row0 = (u >> 8) * 8192; hh = (u >> 5) & 7; r = u & 31;
      if (r < 8) { cfg = 0; cls = 0; NB = 4; u0 = r * 1024; }
      else if (r < 16) { cfg = 1; cls = (r - 8) >> 1; NB = 4; u0 = ((r - 8) & 1) * 1024; }
      else { cfg = 2; cls = r - 16; NB = 2; u0 = 0; } }
    else { const int v = u - 512; T = 4096; seq_row0 = M_PROMPT + (v / 192) * 4096; hh = (v / 24) & 7; r = v % 24;
      if (r < 4) { cfg = 0; cls = 0; NB = 4; u0 = r * 1024; }
      else if (r < 8) { cfg = 1; cls = r - 4; NB = 4; u0 = 0; }
      else { cfg = 2; cls = r - 8; NB = 1; u0 = 0; } }
  }
  const int dd = 1 << (2 * cfg), U = T >> (2 * cfg);
  const float c2 = 0.125f * LOG2E;
  const float slope2 = exp2f(-(float)(hh + 1)) * (float)dd * LOG2E;

  u32x4 kr[6], vr[6];
  const int wrow = tid >> 3, kc = tid & 7;
  auto gload = [&](int b) {
    const int ub = u0 + 256 * b;
#pragma unroll
    for (int i = 0; i < 6; ++i) {
      int uk = ub - 64 + wrow + 64 * i;
      uk = uk < 0 ? 0 : (uk >= U ? U - 1 : uk);
      const char* kbase = (const char*)(p.qkva + ((size_t)(8 + hh) * M_TOK + seq_row0) * 64);
      const char* vbase = (const char*)(p.qkva + ((size_t)(16 + hh) * M_TOK + seq_row0) * 64);
      const unsigned off = ((unsigned)(uk * dd + cls) * 64u + 8u * kc) * 2u;
      kr[i] = *(const u32x4*)(kbase + off);
      vr[i] = *(const u32x4*)(vbase + off);
    }
  };
  auto lwrite = [&]() {
#pragma unroll
    for (int i = 0; i < 6; ++i) {
      const int w = wrow + 64 * i;
      *(u32x4*)(lds + w * KSTR + kc * 16) = kr[i];
      *(u32x4*)(lds + KBYTES + w * VSTR + kc * 16) = vr[i];
    }
  };
  const int sq = (ql & ~12) | ((ql & 4) << 1) | ((ql & 8) >> 1);
  const int koff = sq * KSTR + h * 16;
  const int voff = KBYTES + (8 * h + ((lane & 15) >> 2)) * VSTR + 32 * ((lane >> 4) & 1) + 8 * (lane & 3);
  const int wc = wid >> 1;

  __syncthreads();
  gload(0);
  lwrite();
  __syncthreads();
  for (int b = 0; b < NB; ++b) {
    if (b + 1 < NB) gload(b + 1);
    const int ub = u0 + 256 * b;
    const int mq = seq_row0 + (ub + wid * 32 + ql) * dd + cls;
    bf16x8 qf[4];
    {
      const bf16_t* qp = p.qkva + ((size_t)hh * M_TOK + mq) * 64 + 8 * h;
#pragma unroll
      for (int c = 0; c < 4; ++c) {
        u32x4 w = *(const u32x4*)(qp + 16 * c);
#pragma unroll
        for (int j = 0; j < 4; ++j) w[j] = pk_bf16(bflo(w[j]) * c2, bfhi(w[j]) * c2);
        qf[c] = __builtin_bit_cast(bf16x8, w);
      }
    }
    f32x16 o0, o1;
#pragma unroll
    for (int i = 0; i < 16; ++i) { o0[i] = 0.f; o1[i] = 0.f; }
    float m_ref = 0.f, l_run = 0.f;
#pragma unroll 1
    for (int ord = 0; ord < 3; ++ord) {
      const int j = (ord == 0) ? wc + 1 : (ord == 1 ? wc : wc + 2);
      const int ut = ub - 64 + 64 * j;
      if (ut >= 0 && ut < U) {
        const char* kp = lds + (64 * j) * KSTR + koff;
        const char* vp = lds + voff + (64 * j) * VSTR;
        f32x16 s0, s1;
#pragma unroll
        for (int i = 0; i < 16; ++i) { s0[i] = 0.f; s1[i] = 0.f; }
#pragma unroll
        for (int c = 0; c < 4; ++c) {
          s0 = MFMA32(*(const bf16x8*)(kp + c * 32), qf[c], s0);
          s1 = MFMA32(*(const bf16x8*)(kp + 32 * KSTR + c * 32), qf[c], s1);
        }
        const float fb = (float)(64 * j - 64 + 8 * h - (32 * wid + ql));
        float mx = -1e30f;
#pragma unroll
        for (int i = 0; i < 16; ++i) {
          const float d0 = fb + (float)(16 * (i >> 3) + (i & 7)), d1 = d0 + 32.f;
          const float a0 = fabsf(d0), a1 = fabsf(d1);
          s0[i] = (a0 <= 64.f) ? __builtin_fmaf(-slope2, a0, s0[i]) : -1e30f;
          s1[i] = (a1 <= 64.f) ? __builtin_fmaf(-slope2, a1, s1[i]) : -1e30f;
          if (ord == 0) mx = fmaxf(mx, fmaxf(s0[i], s1[i]));
        }
        if (ord == 0) { mx = fmaxf(mx, __shfl_xor(mx, 32)); m_ref = mx; }
        float ls = 0.f;
#pragma unroll
        for (int i = 0; i < 16; ++i) {
          s0[i] = (s0[i] > -1e29f) ? __builtin_amdgcn_exp2f(s0[i] - m_ref) : 0.f;
          s1[i] = (s1[i] > -1e29f) ? __builtin_amdgcn_exp2f(s1[i] - m_ref) : 0.f;
          ls += s0[i] + s1[i];
        }
        if (ord != 0 && __builtin_amdgcn_ballot_w64(!(ls < 1e30f)) != 0ull) {
#pragma unroll
          for (int i = 0; i < 16; ++i) { s0[i] = 0.f; s1[i] = 0.f; }
#pragma unroll
          for (int c = 0; c < 4; ++c) {
            s0 = MFMA32(*(const bf16x8*)(kp + c * 32), qf[c], s0);
            s1 = MFMA32(*(const bf16x8*)(kp + 32 * KSTR + c * 32), qf[c], s1);
          }
          float m2 = -1e30f;
#pragma unroll
          for (int i = 0; i < 16; ++i) {
            const float d0 = fb + (float)(16 * (i >> 3) + (i & 7)), d1 = d0 + 32.f;
            const float a0 = fabsf(d0), a1 = fabsf(d1);
            s0[i] = (a0 <= 64.f) ? __builtin_fmaf(-slope2, a0, s0[i]) : -1e30f;
            s1[i] = (a1 <= 64.f) ? __builtin_fmaf(-slope2, a1, s1[i]) : -1e30f;
            m2 = fmaxf(m2, fmaxf(s0[i], s1[i]));
          }
          m2 = fmaxf(m2, __shfl_xor(m2, 32));
          const float delta = fmaxf(m2 - m_ref, 0.f);
          const float alpha = __builtin_amdgcn_exp2f(-delta);
          m_ref += delta;
          l_run *= alpha;
#pragma unroll
          for (int i = 0; i < 16; ++i) { o0[i] *= alpha; o1[i] *= alpha; }
          ls = 0.f;
#pragma unroll
          for (int i = 0; i < 16; ++i) {
            s0[i] = (s0[i] > -1e29f) ? __builtin_amdgcn_exp2f(s0[i] - m_ref) : 0.f;
            s1[i] = (s1[i] > -1e29f) ? __builtin_amdgcn_exp2f(s1[i] - m_ref) : 0.f;
            ls += s0[i] + s1[i];
          }
        }
        l_run += ls;
#pragma unroll
        for (int s = 0; s < 2; ++s) {
          u32x4 pa, pb;
#pragma unroll
          for (int jj = 0; jj < 4; ++jj) {
            pa[jj] = pk_bf16(s0[8 * s + 2 * jj], s0[8 * s + 2 * jj + 1]);
            pb[jj] = pk_bf16(s1[8 * s + 2 * jj], s1[8 * s + 2 * jj + 1]);
          }
          const bf16x8 pfa = __builtin_bit_cast(bf16x8, pa), pfb = __builtin_bit_cast(bf16x8, pb);
          auto vfrag = [&](int k0, int db) -> bf16x8 {
            const s16x4 lo = __builtin_amdgcn_ds_read_tr16_b64_v4i16((LAS s16x4*)(vp + k0 * VSTR + db * 64));
            const s16x4 hi = __builtin_amdgcn_ds_read_tr16_b64_v4i16((LAS s16x4*)(vp + (k0 + 4) * VSTR + db * 64));
            return __builtin_shufflevector(lo, hi, 0, 1, 2, 3, 4, 5, 6, 7);
          };
          o0 = MFMA32(vfrag(16 * s, 0), pfa, o0);
          o1 = MFMA32(vfrag(16 * s, 1), pfa, o1);
          o0 = MFMA32(vfrag(32 + 16 * s, 0), pfb, o0);
          o1 = MFMA32(vfrag(32 + 16 * s, 1), pfb, o1);
        }
      }
    }
    {
      const float l_tot = l_run + __shfl_xor(l_run, 32);
      const float inv = 1.f / l_tot;
      bf16_t* dst = p.pA + (size_t)cfg * M_TOK * 512 + (size_t)mq * 512 + hh * 64;
      u32x2 w0[4], w1[4];
#pragma unroll
      for (int g = 0; g < 4; ++g) {
        w0[g][0] = pk_bf16(o0[4 * g] * inv, o0[4 * g + 1] * inv); w0[g][1] = pk_bf16(o0[4 * g + 2] * inv, o0[4 * g + 3] * inv);
        w1[g][0] = pk_bf16(o1[4 * g] * inv, o1[4 * g + 1] * inv); w1[g][1] = pk_bf16(o1[4 * g + 2] * inv, o1[4 * g + 3] * inv);
      }
      st_pair16(dst, 0, h, w0[0], w0[1]);
      st_pair16(dst, 2, h, w0[2], w0[3]);
      st_pair16(dst + 32, 0, h, w1[0], w1[1]);
      st_pair16(dst + 32, 2, h, w1[2], w1[3]);
      if (h == 0) p.lse[(size_t)cfg * M_TOK * 8 + (size_t)mq * 8 + hh] = m_ref + __builtin_amdgcn_logf(l_tot);
    }
    __syncthreads();
    if (b + 1 < NB) { lwrite(); __syncthreads(); }
  }
}

DI void phase_merge(const Params& p) {
  const int nthr = gridDim.x * 512;
  for (int e = blockIdx.x * 512 + threadIdx.x; e < M_TOK * 64; e += nthr) {
    const int m = e >> 6, c = e & 63, hh = c >> 3;
    const float l0 = p.lse[(size_t)m * 8 + hh], l1 = p.lse[(size_t)M_TOK * 8 + (size_t)m * 8 + hh], l2 = p.lse[(size_t)2 * M_TOK * 8 + (size_t)m * 8 + hh];
    const float mx = fmaxf(l0, fmaxf(l1, l2));
    float w0 = __builtin_amdgcn_exp2f(l0 - mx), w1 = __builtin_amdgcn_exp2f(l1 - mx), w2 = __builtin_amdgcn_exp2f(l2 - mx);
    const float inv = 1.f / (w0 + w1 + w2);
    w0 *= inv; w1 *= inv; w2 *= inv;
    const u32x4 a = *(const u32x4*)(p.pA + (size_t)m * 512 + c * 8);
    const u32x4 b = *(const u32x4*)(p.pA + (size_t)M_TOK * 512 + (size_t)m * 512 + c * 8);
    const u32x4 d = *(const u32x4*)(p.pA + (size_t)2 * M_TOK * 512 + (size_t)m * 512 + c * 8);
    const u32x4 g = *(const u32x4*)(p.proj + (size_t)m * LD0 + 416 + c * 8);
    u32x4 o;
#pragma unroll
    for (int j = 0; j < 4; ++j) {
      const float lo = (bflo(a[j]) * w0 + bflo(b[j]) * w1 + bflo(d[j]) * w2) * bflo(g[j]);
      const float hi = (bfhi(a[j]) * w0 + bfhi(b[j]) * w1 + bfhi(d[j]) * w2) * bfhi(g[j]);
      o[j] = pk_bf16(lo, hi);
    }
    *(u32x4*)(p.h + (size_t)m * 1024 + c * 8) = o;
  }
}

template <int PH>
DI void run_phase(const Params& p, char* lds) {
  const int bid = blockIdx.x, nblk = gridDim.x;
  if (PH == 0) phase_prep(p, lds);
  else if (PH == 1) { for (int t = bid; t < 320 * 12; t += nblk) { int pm, pn; g8_tile(t, 320, 12, pm, pn); gemm_tile<0>(p, p.h, 1024, p.wt_in_ab, 1024, pm * 256, pn * 256, lds); } }
  else if (PH == 2) phase_mlanorm(p);
  else if (PH == 3) {
    for (int t = bid; t < 960 + 1280; t += nblk) {
      int pm, pn;
      if (t < 960) { g8_tile(t, 320, 3, pm, pn); gemm_tile<1>(p, p.proj, LD0, p.wt_uq, 256, pm * 256, pn * 256, lds); }
      else { g8_tile(t - 960, 320, 4, pm, pn); gemm_tile<2>(p, p.proj + 256, LD0, p.wt_ukv, 128, pm * 256, pn * 256, lds); }
    }
  }
  else if (PH == 4) {
    for (int u = bid; u < 2560; u += nblk) attn_dense128<0>(p, u, lds);
    for (int u = bid; u < 3584; u += nblk) attn_dilated(p, u, lds);
  }
  else if (PH == 5) phase_merge(p);
  else if (PH == 6) { for (int t = bid; t < 1280; t += nblk) { int pm, pn; g8_tile(t, 320, 4, pm, pn); gemm_tile<3>(p, p.h, 1024, p.wt_out_ab, 1024, pm * 256, pn * 256, lds); } }
  else if (PH == 7) phase_postnorm<false>(p, p.proj, p.norm_post, p.norm_pre + 1024);
  else if (PH == 8) { for (int t = bid; t < 3200; t += nblk) { int pm, pn; g8_tile(t, 320, 10, pm, pn); gemm_tile<4>(p, p.h, 1024, p.wt_in_c, 1024, pm * 256, pn * 256, lds); } }
  else if (PH == 9) { for (int u = bid; u < 5120; u += nblk) attn_dense128<1, false, true>(p, u, lds); }
  else if (PH == 10) { for (int t = bid; t < 1280; t += nblk) { int pm, pn; g8_tile(t, 320, 4, pm, pn); gemm_tile<5>(p, p.h, 1024, p.wt_out_c, 1024, pm * 256, pn * 256, lds); } }
  else if (PH == 11) phase_postnorm<true>(p, p.yout1, p.norm_post + 1024, nullptr);
}

template <int PH>
__global__ void __launch_bounds__(512) k_phase(Params p) {
  __shared__ __attribute__((aligned(16))) char lds[LDS_BYTES];
  run_phase<PH>(p, lds);
}

__global__ void __launch_bounds__(512) k_mega(Params p) {
  __shared__ __attribute__((aligned(16))) char lds[LDS_BYTES];
  cg::grid_group grid = cg::this_grid();
  run_phase<0>(p, lds); grid.sync();
  run_phase<1>(p, lds); grid.sync();
  run_phase<3>(p, lds); grid.sync();
  run_phase<4>(p, lds); grid.sync();
  run_phase<5>(p, lds); grid.sync();
  run_phase<6>(p, lds); grid.sync();
  run_phase<7>(p, lds); grid.sync();
  run_phase<8>(p, lds); grid.sync();
#ifdef PROBE_GEMM
  run_phase<8>(p, lds); grid.sync();
#endif
  run_phase<9>(p, lds); grid.sync();
#ifdef PROBE_ATT
  run_phase<9>(p, lds); grid.sync();
#endif
  run_phase<10>(p, lds); grid.sync();
  run_phase<11>(p, lds);
}

extern "C" void kernel_launch(void* const* d_in, const int* in_sizes, int n_in, void* d_out, int out_size, void* d_ws,
                              size_t ws_size, hipStream_t stream) {
  Params p{};
  p.x_prompt = (const float*)d_in[0]; p.x_sample = (const float*)d_in[1];
  p.norm_pre = (const float*)d_in[2]; p.norm_post = (const float*)d_in[3];
  p.w_in_ab = (const float*)d_in[4]; p.mla_q_norm = (const float*)d_in[5]; p.w_uq = (const float*)d_in[6];
  p.mla_kv_norm = (const float*)d_in[7]; p.w_ukv = (const float*)d_in[8]; p.w_out_ab = (const float*)d_in[9];
  p.w_in_c = (const float*)d_in[10]; p.c_q_norm = (const float*)d_in[11]; p.c_k_norm = (const float*)d_in[12];
  p.w_out_c = (const float*)d_in[13];
  p.out = (float*)d_out;
  char* ws = (char*)d_ws;
  const size_t MiB = 1ull << 20;
  p.wt_in_ab = (bf16_t*)(ws + 0 * MiB);
  p.wt_out_ab = (bf16_t*)(ws + 6 * MiB);
  p.wt_in_c = (bf16_t*)(ws + 8 * MiB);
  p.wt_out_c = (bf16_t*)(ws + 13 * MiB);
  p.rope = (float2*)(ws + 15 * MiB);
  p.wt_uq = (bf16_t*)(ws + 16 * MiB);
  p.wt_ukv = (bf16_t*)(ws + 16 * MiB + 512 * 1024);
  p.h = (bf16_t*)(ws + 20 * MiB);
  p.proj = (bf16_t*)(ws + 180 * MiB);
  p.qb = (bf16_t*)(ws + 645 * MiB);
  p.knope = (bf16_t*)(ws + 765 * MiB);
  p.vbT = (bf16_t*)(ws + 845 * MiB);
  p.krope = (bf16_t*)(ws + 925 * MiB);
  p.v1T = (bf16_t*)(ws + 645 * MiB);
  p.yout1 = (bf16_t*)(ws + 700 * MiB);
  p.pA = (bf16_t*)d_out;
  p.lse = (float*)((char*)d_out + 240 * MiB);
  p.qkva = (bf16_t*)(ws + 405 * MiB);
  p.rss_q = (float*)(ws + 931 * MiB);
  p.rss_kv = (float*)(ws + 932 * MiB);
#if N_LAUNCH_MODE == 1
  static int grid_blocks = 0;
  if (!grid_blocks) {
    int dev = 0, cus = 0, per_cu = 0;
    hipGetDevice(&dev);
    hipDeviceGetAttribute(&cus, hipDeviceAttributeMultiprocessorCount, dev);
    hipOccupancyMaxActiveBlocksPerMultiprocessor(&per_cu, k_mega, 512, 0);
    if (per_cu < 1) per_cu = 1;
    if (per_cu > 1) per_cu = 1;
    grid_blocks = cus * per_cu;
  }
  void* args[] = {&p};
  hipError_t e = hipLaunchCooperativeKernel((void*)k_mega, dim3(grid_blocks), dim3(512), args, 0, stream);
  if (e != hipSuccess) fprintf(stderr, "cooperative launch failed: %s (grid %d)\n", hipGetErrorString(e), grid_blocks);
#else
  const dim3 g(256), b(512);
  k_phase<0><<<g, b, 0, stream>>>(p);
  k_phase<1><<<g, b, 0, stream>>>(p);
  k_phase<3><<<g, b, 0, stream>>>(p);
  k_phase<4><<<g, b, 0, stream>>>(p);
  k_phase<5><<<g, b, 0, stream>>>(p);
  k_phase<6><<<g, b, 0, stream>>>(p);
  k_phase<7><<<g, b, 0, stream>>>(p);
  k_phase<8><<<g, b, 0, stream>>>(p);
  k_phase<9><<<g, b, 0, stream>>>(p);
  k_phase<10><<<g, b, 0, stream>>>(p);
  k_phase<11><<<g, b, 0, stream>>>(p);
#endif
}
```

```cpp
#include <hip/hip_runtime.h>
#include <hip/hip_cooperative_groups.h>
#include <cstdint>
#include <cstdio>
namespace cg = cooperative_groups;

#ifndef N_LAUNCH_MODE
#define N_LAUNCH_MODE 1
#endif

typedef unsigned short bf16_t;
typedef short bf16x8 __attribute__((ext_vector_type(8)));
typedef float f32x16 __attribute__((ext_vector_type(16)));
typedef float f32x4 __attribute__((ext_vector_type(4)));
typedef float f32x2 __attribute__((ext_vector_type(2)));
typedef unsigned u32x4 __attribute__((ext_vector_type(4)));
typedef unsigned u32x2 __attribute__((ext_vector_type(2)));
typedef __bf16 bf16x2_t __attribute__((ext_vector_type(2)));
typedef short s16x4 __attribute__((ext_vector_type(4)));

#define DI __device__ __forceinline__
#define MFMA32(a, b, c) __builtin_amdgcn_mfma_f32_32x32x16_bf16((a), (b), (c), 0, 0, 0)

constexpr int M_TOK = 81920, M_PROMPT = 16384;
constexpr int N_AB = 2976, N_C = 2560;
constexpr int LD0 = 1440;
constexpr float EPS = 1e-6f;
constexpr float LOG2E = 1.4426950408889634f;
constexpr int LDS_BYTES = 147456;

struct Params {
  const float *x_prompt, *x_sample, *norm_pre, *norm_post, *w_in_ab, *mla_q_norm, *w_uq, *mla_kv_norm, *w_ukv,
      *w_out_ab, *w_in_c, *c_q_norm, *c_k_norm, *w_out_c;
  float* out;
  bf16_t *wt_in_ab, *wt_out_ab, *wt_in_c, *wt_out_c, *wt_uq, *wt_ukv;
  float2* rope;
  bf16_t *h;
  bf16_t *proj;
  bf16_t *qb;
  bf16_t *knope;
  bf16_t *vbT;
  bf16_t *krope;
  bf16_t *v1T;
  bf16_t *yout1;
  bf16_t *pA;
  float *lse;
  bf16_t *qkva;
  float *rss_q, *rss_kv;
};

DI unsigned pk_bf16(float lo, float hi) {
  f32x2 v = {lo, hi};
  bf16x2_t b = __builtin_convertvector(v, bf16x2_t);
  return __builtin_bit_cast(unsigned, b);
}
DI bf16_t f2bf(float x) { return (bf16_t)(pk_bf16(x, 0.f) & 0xffffu); }
DI float bflo(unsigned u) { return __uint_as_float(u << 16); }
DI float bfhi(unsigned u) { return __uint_as_float(u & 0xffff0000u); }
DI float bf2f(bf16_t v) { return __uint_as_float(((unsigned)v) << 16); }
DI float silu_f(float v) { return v * __builtin_amdgcn_rcpf(1.f + __builtin_amdgcn_exp2f(-v * LOG2E)); }
DI float wave_sum(float v) {
  v += __shfl_xor(v, 32); v += __shfl_xor(v, 16); v += __shfl_xor(v, 8);
  v += __shfl_xor(v, 4); v += __shfl_xor(v, 2); v += __shfl_xor(v, 1);
  return v;
}
DI int fresh_tid() { int t = threadIdx.x; asm volatile("" : "+v"(t)); return t; }
DI float fmax_nc(float a, float b) { return __builtin_amdgcn_fmed3f(a, b, __builtin_inff()); }
DI void st_pair16(bf16_t* row32, int g, int h, const u32x2& a, const u32x2& b) {
  const auto r0 = __builtin_amdgcn_permlane32_swap(a[0], b[0], false, false);
  const auto r1 = __builtin_amdgcn_permlane32_swap(a[1], b[1], false, false);
  u32x4 v; v[0] = r0[0]; v[1] = r1[0]; v[2] = r0[1]; v[3] = r1[1];
  *(u32x4*)(row32 + 8 * g + 8 * h) = v;
}
DI int crow(int i, int h) { return (i & 3) + 8 * (i >> 2) + 4 * h; }
DI const float* xrow(const Params& p, int m) {
  return (m < M_PROMPT) ? p.x_prompt + (size_t)m * 1024 : p.x_sample + (size_t)(m - M_PROMPT) * 1024;
}

DI void phase_prep(const Params& p, char* lds) {
  const int tid = fresh_tid(), nblk = gridDim.x, bid = blockIdx.x, lane = tid & 63, wid = __builtin_amdgcn_readfirstlane(tid >> 6);
  float (*tile)[65] = (float (*)[65])lds;
  for (int t0 = bid; t0 < 2000; t0 += nblk) {
    const float* src; bf16_t* dst; int K, N, tt = t0; const float* kg = nullptr;
    if (tt < 768) { src = p.w_in_ab; dst = p.wt_in_ab; K = 1024; N = 2976; }
    else if ((tt -= 768) < 256) { src = p.w_out_ab; dst = p.wt_out_ab; K = 1024; N = 1024; }
    else if ((tt -= 256) < 640) { src = p.w_in_c; dst = p.wt_in_c; K = 1024; N = 2560; }
    else if ((tt -= 640) < 256) { src = p.w_out_c; dst = p.wt_out_c; K = 1024; N = 1024; }
    else if ((tt -= 256) < 48) { src = p.w_uq; dst = p.wt_uq; K = 256; N = 768; kg = p.mla_q_norm; }
    else { tt -= 48; src = p.w_ukv; dst = p.wt_ukv; K = 128; N = 1024; kg = p.mla_kv_norm; }
    const int nkt = K >> 6;
    const int k0 = (tt % nkt) * 64, n0 = (tt / nkt) * 64;
    __syncthreads();
    {
      const int tx = tid & 63, ty = tid >> 6;
#pragma unroll
      for (int i = 0; i < 8; ++i) {
        const int k = ty + 8 * i, n = n0 + tx;
        tile[k][tx] = (n < N) ? src[(size_t)(k0 + k) * N + n] * (kg ? kg[k0 + k] : 1.f) : 0.f;
      }
    }
    __syncthreads();
    {
      const int kx = tid & 63, ny = tid >> 6;
#pragma unroll
      for (int i = 0; i < 8; ++i) {
        const int n = ny + 8 * i;
        dst[(size_t)(n0 + n) * K + k0 + kx] = f2bf(tile[kx][n]);
      }
    }
  }
  for (int e = bid * 512 + tid; e < M_TOK; e += nblk * 512) { p.rss_q[e] = 0.f; p.rss_kv[e] = 0.f; }
  for (int e = bid * 512 + tid; e < 8192 * 16; e += nblk * 512) {
    const int pos = e >> 4, i = e & 15;
    const double freq = exp2(-(double)i * (13.287712379549449 / 16.0));
    const double ang = (double)pos * freq;
    const double kk = rint(ang * 0.15915494309189535);
    const float rf = (float)(ang - kk * 6.283185307179586);
    p.rope[e] = make_float2(cosf(rf), sinf(rf));
  }
  for (int m = bid * 8 + wid; m < M_TOK; m += nblk * 8) {
    const float* xr = xrow(p, m);
    f32x4 v[4]; float ss = 0.f;
#pragma unroll
    for (int i = 0; i < 4; ++i) {
      v[i] = *(const f32x4*)(xr + i * 256 + lane * 4);
      ss += v[i][0] * v[i][0] + v[i][1] * v[i][1] + v[i][2] * v[i][2] + v[i][3] * v[i][3];
    }
    ss = wave_sum(ss);
    const float rinv = rsqrtf(ss * (1.f / 1024.f) + EPS);
#pragma unroll
    for (int i = 0; i < 4; ++i) {
      const f32x4 g = *(const f32x4*)(p.norm_pre + i * 256 + lane * 4);
      u32x2 w;
      w[0] = pk_bf16(v[i][0] * rinv * g[0], v[i][1] * rinv * g[1]);
      w[1] = pk_bf16(v[i][2] * rinv * g[2], v[i][3] * rinv * g[3]);
      *(u32x2*)(p.h + (size_t)m * 1024 + i * 256 + lane * 4) = w;
    }
  }
}

template <bool LAST>
DI void phase_postnorm(const Params& p, const bf16_t* yout, const float* gpost, const float* gpre) {
  const int tid = fresh_tid(), nblk = gridDim.x, bid = blockIdx.x, lane = tid & 63, wid = __builtin_amdgcn_readfirstlane(tid >> 6);
  for (int m = bid * 8 + wid; m < M_TOK; m += nblk * 8) {
    const float* xr = LAST ? (const float*)(p.out + (size_t)m * 1024) : xrow(p, m);
    f32x4 y[4], x[4]; float ss = 0.f;
#pragma unroll
    for (int i = 0; i < 4; ++i) {
      const u32x2 w = *(const u32x2*)(yout + (size_t)m * 1024 + i * 256 + lane * 4);
      y[i][0] = bflo(w[0]); y[i][1] = bfhi(w[0]); y[i][2] = bflo(w[1]); y[i][3] = bfhi(w[1]);
      x[i] = *(const f32x4*)(xr + i * 256 + lane * 4);
      ss += y[i][0] * y[i][0] + y[i][1] * y[i][1] + y[i][2] * y[i][2] + y[i][3] * y[i][3];
    }
    ss = wave_sum(ss);
    const float rinv = rsqrtf(ss * (1.f / 1024.f) + EPS);
    float ss2 = 0.f;
#pragma unroll
    for (int i = 0; i < 4; ++i) {
      const f32x4 g = *(const f32x4*)(gpost + i * 256 + lane * 4);
#pragma unroll
      for (int j = 0; j < 4; ++j) { x[i][j] = x[i][j] + y[i][j] * rinv * g[j]; ss2 += x[i][j] * x[i][j]; }
      *(f32x4*)(p.out + (size_t)m * 1024 + i * 256 + lane * 4) = x[i];
    }
    if (!LAST) {
      ss2 = wave_sum(ss2);
      const float rinv2 = rsqrtf(ss2 * (1.f / 1024.f) + EPS);
#pragma unroll
      for (int i = 0; i < 4; ++i) {
        const f32x4 g = *(const f32x4*)(gpre + i * 256 + lane * 4);
        u32x2 w;
        w[0] = pk_bf16(x[i][0] * rinv2 * g[0], x[i][1] * rinv2 * g[1]);
        w[1] = pk_bf16(x[i][2] * rinv2 * g[2], x[i][3] * rinv2 * g[3]);
        *(u32x2*)(p.h + (size_t)m * 1024 + i * 256 + lane * 4) = w;
      }
    }
  }
}

DI void phase_mlanorm(const Params& p) {
  const int tid = fresh_tid(), nblk = gridDim.x, bid = blockIdx.x, lane = tid & 63, wid = __builtin_amdgcn_readfirstlane(tid >> 6);
  for (int m = bid * 8 + wid; m < M_TOK; m += nblk * 8) {
    bf16_t* pr = p.proj + (size_t)m * LD0 - 1536;
    const int T = (m < M_PROMPT) ? 8192 : 4096, t = m & (T - 1);
    {
      const u32x2 w = *(const u32x2*)(pr + 1536 + lane * 4);
      float v0 = bflo(w[0]), v1 = bfhi(w[0]), v2 = bflo(w[1]), v3 = bfhi(w[1]);
      float ss = wave_sum(v0 * v0 + v1 * v1 + v2 * v2 + v3 * v3);
      const float rinv = rsqrtf(ss * (1.f / 256.f) + EPS);
      const f32x4 g = *(const f32x4*)(p.mla_q_norm + lane * 4);
      u32x2 o; o[0] = pk_bf16(v0 * rinv * g[0], v1 * rinv * g[1]); o[1] = pk_bf16(v2 * rinv * g[2], v3 * rinv * g[3]);
      *(u32x2*)(pr + 1536 + lane * 4) = o;
    }
    {
      const unsigned w = *(const unsigned*)(pr + 1792 + lane * 2);
      float v0 = bflo(w), v1 = bfhi(w);
      float ss = wave_sum(v0 * v0 + v1 * v1);
      const float rinv = rsqrtf(ss * (1.f / 128.f) + EPS);
      const f32x2 g = *(const f32x2*)(p.mla_kv_norm + lane * 2);
      *(unsigned*)(pr + 1792 + lane * 2) = pk_bf16(v0 * rinv * g[0], v1 * rinv * g[1]);
    }
    {
      const float xv = bf2f(pr[1920 + (lane & 31)]);
      const float pv = __shfl_xor(xv, 16);
      const float2 cs = p.rope[t * 16 + (lane & 15)];
      const float o = (lane & 16) ? (xv * cs.x + pv * cs.y) : (xv * cs.x - pv * cs.y);
      if (lane < 32) p.krope[(size_t)m * 32 + lane] = f2bf(o);
    }
  }
}

#define LAS __attribute__((address_space(3)))
#define GAS __attribute__((address_space(1)))
DI void g8_stage_rc(int b, int& R, int& C) {
  const int st = b / 1024, sb = b % 1024, swz = sb ^ (((sb >> 9) & 1) << 5);
  R = (st >> 1) * 16 + swz / 64; C = (st & 1) * 32 + (swz % 64) / 2;
}
DI void g8_tile(int L, int nM, int nN, int& pm, int& pn) {
  const int nwg = nM * nN, q = nwg / 8, r = nwg % 8, xcd = L % 8, off = L / 8;
  const int wg = (xcd < r ? xcd * (q + 1) : r * (q + 1) + (xcd - r) * q) + off;
  const int nig = 8 * nN, gid = wg / nig, fm = gid * 8, gsz = (nM - fm) < 8 ? (nM - fm) : 8;
  pm = fm + (wg % nig) % gsz; pn = (wg % nig) / gsz;
}
DI void st4(bf16_t* dst, const f32x4& v) {
  u32x2 w; w[0] = pk_bf16(v[0], v[1]); w[1] = pk_bf16(v[2], v[3]);
  *(u32x2*)dst = w;
}

DI void st8_pair(bf16_t* row16, int fq, const f32x4& va, const f32x4& vb) {
  const unsigned a0 = pk_bf16(va[0], va[1]), a1 = pk_bf16(va[2], va[3]);
  const unsigned b0 = pk_bf16(vb[0], vb[1]), b1 = pk_bf16(vb[2], vb[3]);
  const auto r0 = __builtin_amdgcn_permlane16_swap(a0, b0, false, false);
  const auto r1 = __builtin_amdgcn_permlane16_swap(a1, b1, false, false);
  u32x4 v; v[0] = r0[0]; v[1] = r1[0]; v[2] = r0[1]; v[3] = r1[1];
  *(u32x4*)(row16 + (fq & 1) * 16 + (fq >> 1) * 8) = v;
}

template <int EPI>
DI void gemm_epilogue(const Params& p, f32x4 (&acc)[2][2][4][2], int m0, int n0, int wr, int wc, int fr, int fq) {
#pragma unroll
  for (int bj = 0; bj < 2; ++bj)
#pragma unroll
    for (int ni = 0; ni < 2; ++ni) {
      const int m = m0 + bj * 128 + wc * 32 + ni * 16 + fr;
      const int T = (m < M_PROMPT) ? 8192 : 4096, t = m & (T - 1);
      float ssq = 0.f;
#pragma unroll
      for (int ai = 0; ai < 2; ++ai) {
        const int nb = n0 + ai * 128 + wr * 64;
        if (EPI == 0) {
#pragma unroll
          for (int pr2 = 0; pr2 < 2; ++pr2) {
            const int np = nb + 32 * pr2;
            const int nl = np + (fq & 1) * 16 + (fq >> 1) * 8;
            if (np < 1536) {
              st8_pair(p.qkva + ((size_t)(np >> 6) * M_TOK + m) * 64 + (np & 63), fq, acc[ai][bj][2 * pr2][ni], acc[ai][bj][2 * pr2 + 1][ni]);
            } else if (np < 1920) {
              st8_pair(p.proj + (size_t)m * LD0 + (np - 1536), fq, acc[ai][bj][2 * pr2][ni], acc[ai][bj][2 * pr2 + 1][ni]);
            } else if (np >= 1952 && np < N_AB) {
              f32x4 va = acc[ai][bj][2 * pr2][ni], vb = acc[ai][bj][2 * pr2 + 1][ni];
              va[0] = silu_f(va[0]); va[1] = silu_f(va[1]); va[2] = silu_f(va[2]); va[3] = silu_f(va[3]);
              vb[0] = silu_f(vb[0]); vb[1] = silu_f(vb[1]); vb[2] = silu_f(vb[2]); vb[3] = silu_f(vb[3]);
              st8_pair(p.proj + (size_t)m * LD0 + (np - 1536), fq, va, vb);
            }
            (void)nl;
          }
          if (nb >= 1536 && nb < 1920) {
#pragma unroll
            for (int mi = 0; mi < 4; ++mi)
#pragma unroll
              for (int j = 0; j < 4; ++j) { const float v = acc[ai][bj][mi][ni][j]; ssq += v * v; }
          } else if (nb == 1920) {
            const f32x4* rp = (const f32x4*)(p.rope + t * 16 + fq * 4);
            const f32x4 r0 = rp[0], r1 = rp[1];
            const float cs[4] = {r0[0], r0[2], r1[0], r1[2]}, sn[4] = {r0[1], r0[3], r1[1], r1[3]};
            f32x4 y1, y2;
#pragma unroll
            for (int j = 0; j < 4; ++j) {
              const float x1 = acc[ai][bj][0][ni][j], x2 = acc[ai][bj][1][ni][j];
              y1[j] = x1 * cs[j] - x2 * sn[j];
              y2[j] = x2 * cs[j] + x1 * sn[j];
            }
            st4(p.krope + (size_t)m * 32 + fq * 4, y1);
            st4(p.krope + (size_t)m * 32 + 16 + fq * 4, y2);
          }
        } else if (EPI == 1) {
          {
            const float rinv = rsqrtf(p.rss_q[m] * (1.f / 256.f) + EPS);
#pragma unroll
            for (int mi = 0; mi < 4; ++mi) acc[ai][bj][mi][ni] *= rinv;
          }
#pragma unroll
          for (int blk = 0; blk < 2; ++blk) {
            const int nblk = nb + 32 * blk;
            if (((nblk >> 5) % 3) == 2) {
              const f32x4* rp = (const f32x4*)(p.rope + t * 16 + fq * 4);
              const f32x4 r0 = rp[0], r1 = rp[1];
              const float cs[4] = {r0[0], r0[2], r1[0], r1[2]}, sn[4] = {r0[1], r0[3], r1[1], r1[3]};
#pragma unroll
              for (int j = 0; j < 4; ++j) {
                const float x1 = acc[ai][bj][2 * blk][ni][j], x2 = acc[ai][bj][2 * blk + 1][ni][j];
                acc[ai][bj][2 * blk][ni][j] = x1 * cs[j] - x2 * sn[j];
                acc[ai][bj][2 * blk + 1][ni][j] = x2 * cs[j] + x1 * sn[j];
              }
            }
          }
          st8_pair(p.qb + (size_t)m * 768 + nb, fq, acc[ai][bj][0][ni], acc[ai][bj][1][ni]);
          st8_pair(p.qb + (size_t)m * 768 + nb + 32, fq, acc[ai][bj][2][ni], acc[ai][bj][3][ni]);
        } else if (EPI == 2) {
          {
            const float rinv = rsqrtf(p.rss_kv[m] * (1.f / 128.f) + EPS);
#pragma unroll
            for (int mi = 0; mi < 4; ++mi) acc[ai][bj][mi][ni] *= rinv;
          }
          const int hh = (n0 + ai * 128) >> 7;
          if (wr == 0) {
            st8_pair(p.knope + (size_t)m * 512 + hh * 64, fq, acc[ai][bj][0][ni], acc[ai][bj][1][ni]);
            st8_pair(p.knope + (size_t)m * 512 + hh * 64 + 32, fq, acc[ai][bj][2][ni], acc[ai][bj][3][ni]);
          } else {
            bf16_t* vb = p.vbT + (size_t)(m - t) * 512 + t;
#pragma unroll
            for (int mi = 0; mi < 4; ++mi)
#pragma unroll
              for (int j = 0; j < 4; ++j) vb[(size_t)(hh * 64 + mi * 16 + fq * 4 + j) * T] = f2bf(acc[ai][bj][mi][ni][j]);
          }
        } else if (EPI == 3 || EPI == 5) {
          bf16_t* dst = (EPI == 3) ? p.proj : p.yout1;
          st8_pair(dst + (size_t)m * 1024 + nb, fq, acc[ai][bj][0][ni], acc[ai][bj][1][ni]);
          st8_pair(dst + (size_t)m * 1024 + nb + 32, fq, acc[ai][bj][2][ni], acc[ai][bj][3][ni]);
        } else if (EPI == 4) {
          if (n0 < 1280) {
            const float* gain = (n0 < 1024) ? p.c_q_norm : p.c_k_norm;
            float ss = 0.f;
#pragma unroll
            for (int mi = 0; mi < 4; ++mi)
#pragma unroll
              for (int j = 0; j < 4; ++j) { const float v = acc[ai][bj][mi][ni][j]; ss += v * v; }
            ss += __shfl_xor(ss, 16);
            ss += __shfl_xor(ss, 32);
            const float rinv = rsqrtf(ss * (1.f / 64.f) + EPS);
#pragma unroll
            for (int blk = 0; blk < 2; ++blk) {
              const int pos = (blk == 0) ? (t >> 6) : (t & 63);
              const f32x4* rp = (const f32x4*)(p.rope + pos * 16 + fq * 4);
              const f32x4 r0 = rp[0], r1 = rp[1];
              const float cs[4] = {r0[0], r0[2], r1[0], r1[2]}, sn[4] = {r0[1], r0[3], r1[1], r1[3]};
              const f32x4 g1 = *(const f32x4*)(gain + blk * 32 + fq * 4), g2 = *(const f32x4*)(gain + blk * 32 + 16 + fq * 4);
#pragma unroll
              for (int j = 0; j < 4; ++j) {
                const float x1 = acc[ai][bj][2 * blk][ni][j] * rinv * g1[j], x2 = acc[ai][bj][2 * blk + 1][ni][j] * rinv * g2[j];
                acc[ai][bj][2 * blk][ni][j] = x1 * cs[j] - x2 * sn[j];
                acc[ai][bj][2 * blk + 1][ni][j] = x2 * cs[j] + x1 * sn[j];
              }
            }
            st8_pair(p.proj + (size_t)m * N_C + nb, fq, acc[ai][bj][0][ni], acc[ai][bj][1][ni]);
            st8_pair(p.proj + (size_t)m * N_C + nb + 32, fq, acc[ai][bj][2][ni], acc[ai][bj][3][ni]);
          } else if (n0 < 1536) {
            bf16_t* vb = p.v1T + (size_t)(m - t) * 256 + t;
#pragma unroll
            for (int mi = 0; mi < 4; ++mi)
#pragma unroll
              for (int j = 0; j < 4; ++j) vb[(size_t)(nb - 1280 + mi * 16 + fq * 4 + j) * T] = f2bf(acc[ai][bj][mi][ni][j]);
          } else {
            f32x4 sv[4];
#pragma unroll
            for (int mi = 0; mi < 4; ++mi) {
              sv[mi] = acc[ai][bj][mi][ni];
              sv[mi][0] = silu_f(sv[mi][0]); sv[mi][1] = silu_f(sv[mi][1]); sv[mi][2] = silu_f(sv[mi][2]); sv[mi][3] = silu_f(sv[mi][3]);
            }
            st8_pair(p.proj + (size_t)m * N_C + nb, fq, sv[0], sv[1]);
            st8_pair(p.proj + (size_t)m * N_C + nb + 32, fq, sv[2], sv[3]);
          }
        }
      }
      if (EPI == 0 && (n0 == 1536 || n0 == 1792)) {
        ssq += __shfl_xor(ssq, 16);
        ssq += __shfl_xor(ssq, 32);
        if (fq == 0) atomicAdd((n0 == 1536) ? p.rss_q + m : p.rss_kv + m, ssq);
      }
    }
}

template <int EPI>
DI void gemm_tile(const Params& p, const bf16_t* __restrict__ X, int ldx, const bf16_t* __restrict__ Wt, int K,
                  int m0, int n0, char* lds) {
  constexpr int HTB = 16384;
  const int tid = fresh_tid(), lane = tid & 63, wid = __builtin_amdgcn_readfirstlane(tid >> 6);
  const int wr = wid >> 2, wc = wid & 3, fr = lane & 15, fq = lane >> 4;
  f32x4 acc[2][2][4][2];
#pragma unroll
  for (int a = 0; a < 2; ++a)
#pragma unroll
    for (int b = 0; b < 2; ++b)
#pragma unroll
      for (int c = 0; c < 4; ++c)
#pragma unroll
        for (int d = 0; d < 2; ++d) acc[a][b][c][d] = (f32x4){0.f, 0.f, 0.f, 0.f};
  bf16x8 At[4][2], B0[2][2], B1[2][2];
  int sr0, sc0, sr1, sc1;
  g8_stage_rc(tid * 16, sr0, sc0);
  g8_stage_rc(tid * 16 + 8192, sr1, sc1);
  const unsigned gw0 = (unsigned)(sr0 * K + sc0) * 2u, gw1 = (unsigned)(sr1 * K + sc1) * 2u, gx0 = (unsigned)(sr0 * ldx + sc0) * 2u, gx1 = (unsigned)(sr1 * ldx + sc1) * 2u;
  const bf16_t* wbase = Wt + (size_t)n0 * K;
  const bf16_t* xbase = X + (size_t)m0 * ldx;
  const int lw = tid * 16;
  const int lo = (fr * 64 + fq * 16) ^ ((fr >> 3) << 5);
  const int la = wr * 8 * 1024 + lo, lb = wc * 4 * 1024 + lo;
#define SA(b, h) (lds + ((b) * 2 + (h)) * HTB)
#define SB(b, h) (lds + (4 + (b) * 2 + (h)) * HTB)
#define STAGE_W(P, half, kt) do { const bf16_t* g_ = wbase + (size_t)(half) * 128 * K + (kt) * 64; \
    __builtin_amdgcn_global_load_lds((const GAS unsigned*)((const char*)g_ + gw0), (LAS unsigned*)((P) + lw), 16, 0, 0); \
    __builtin_amdgcn_global_load_lds((const GAS unsigned*)((const char*)g_ + gw1), (LAS unsigned*)((P) + lw + 8192), 16, 0, 0); } while (0)
#define STAGE_X(P, half, kt) do { const bf16_t* g_ = xbase + (size_t)(half) * 128 * ldx + (kt) * 64; \
    __builtin_amdgcn_global_load_lds((const GAS unsigned*)((const char*)g_ + gx0), (LAS unsigned*)((P) + lw), 16, 0, 0); \
    __builtin_amdgcn_global_load_lds((const GAS unsigned*)((const char*)g_ + gx1), (LAS unsigned*)((P) + lw + 8192), 16, 0, 0); } while (0)
#define LDA(dst, b, h) _Pragma("unroll") for (int m_ = 0; m_ < 4; ++m_) _Pragma("unroll") for (int k_ = 0; k_ < 2; ++k_) \
    dst[m_][k_] = *(const bf16x8*)(SA(b, h) + la + (m_ * 2 + k_) * 1024)
#define LDB(dst, b, h) _Pragma("unroll") for (int n_ = 0; n_ < 2; ++n_) _Pragma("unroll") for (int k_ = 0; k_ < 2; ++k_) \
    dst[n_][k_] = *(const bf16x8*)(SB(b, h) + lb + (n_ * 2 + k_) * 1024)
#define MMA(ai, bj, Af, Bf) do { __builtin_amdgcn_s_setprio(1); \
    _Pragma("unroll") for (int m_ = 0; m_ < 4; ++m_) _Pragma("unroll") for (int n_ = 0; n_ < 2; ++n_) _Pragma("unroll") for (int k_ = 0; k_ < 2; ++k_) \
      acc[ai][bj][m_][n_] = __builtin_amdgcn_mfma_f32_16x16x32_bf16(Af[m_][k_], Bf[n_][k_], acc[ai][bj][m_][n_], 0, 0, 0); \
    __builtin_amdgcn_s_setprio(0); } while (0)
#define WAIT_V(n) asm volatile("s_waitcnt vmcnt(" #n ")" ::: "memory")
#define WAIT_L(n) asm volatile("s_waitcnt lgkmcnt(" #n ")" ::: "memory")
#define BAR __builtin_amdgcn_s_barrier()
#define SCHED __builtin_amdgcn_sched_barrier(0)
  const int nt = K >> 6;
  STAGE_X(SB(0, 0), 0, 0); STAGE_W(SA(0, 0), 0, 0);
  STAGE_X(SB(0, 1), 1, 0); STAGE_W(SA(0, 1), 1, 0);
  if (wr == 1) BAR;
  WAIT_V(4); BAR;
  STAGE_X(SB(1, 0), 0, 1); STAGE_W(SA(1, 0), 0, 1); STAGE_X(SB(1, 1), 1, 1);
  WAIT_V(6); BAR;
  for (int t = 0; t < nt - 2; t += 2) {
    LDB(B0, 0, 0); SCHED; LDA(At, 0, 0); STAGE_W(SA(1, 1), 1, t + 1);
    WAIT_L(8); BAR; WAIT_L(0); MMA(0, 0, At, B0); BAR; SCHED;
    LDB(B1, 0, 1); STAGE_X(SB(0, 0), 0, t + 2);
    BAR; WAIT_L(0); MMA(0, 1, At, B1); BAR;
    LDA(At, 0, 1); STAGE_W(SA(0, 0), 0, t + 2);
    BAR; WAIT_L(0); MMA(1, 0, At, B0); BAR; SCHED;
    STAGE_X(SB(0, 1), 1, t + 2);
    WAIT_V(6); BAR; MMA(1, 1, At, B1); BAR;
    LDB(B0, 1, 0); SCHED; LDA(At, 1, 0); STAGE_W(SA(0, 1), 1, t + 2);
    WAIT_L(8); BAR; WAIT_L(0); MMA(0, 0, At, B0); BAR; SCHED;
    LDB(B1, 1, 1); STAGE_X(SB(1, 0), 0, t + 3);
    BAR; WAIT_L(0); MMA(0, 1, At, B1); BAR;
    LDA(At, 1, 1); STAGE_W(SA(1, 0), 0, t + 3);
    BAR; WAIT_L(0); MMA(1, 0, At, B0); BAR; SCHED;
    STAGE_X(SB(1, 1), 1, t + 3);
    WAIT_V(6); BAR; MMA(1, 1, At, B1); BAR;
  }
  { LDB(B0, 0, 0); LDA(At, 0, 0); STAGE_W(SA(1, 1), 1, nt - 1);
    BAR; WAIT_L(0); MMA(0, 0, At, B0); BAR;
    LDB(B1, 0, 1); BAR; WAIT_L(0); MMA(0, 1, At, B1); BAR;
    LDA(At, 0, 1); WAIT_V(4); BAR; WAIT_L(0); MMA(1, 0, At, B0); MMA(1, 1, At, B1); BAR; }
  { LDB(B0, 1, 0); LDA(At, 1, 0); WAIT_V(2); BAR; WAIT_L(0); MMA(0, 0, At, B0); BAR;
    LDB(B1, 1, 1); WAIT_V(0); BAR; WAIT_L(0); MMA(0, 1, At, B1); BAR;
    LDA(At, 1, 1); BAR; WAIT_L(0); MMA(1, 0, At, B0); MMA(1, 1, At, B1); BAR; }
  if (wr == 0) BAR;
  gemm_epilogue<EPI>(p, acc, m0, n0, wr, wc, fr, fq);
  __syncthreads();
#undef SA
#undef SB
#undef STAGE_W
#undef STAGE_X
#undef LDA
#undef LDB
#undef MMA
#undef WAIT_V
#undef WAIT_L
#undef BAR
#undef SCHED
}

template <int MODE>
DI void attn_unit(const Params& p, int u, char* lds) {
  constexpr int DQK = (MODE == 0) ? 96 : 64;
  constexpr int NC = DQK / 16;
  constexpr int KSTR = DQK * 2 + 16;
  constexpr int KTILE = 64 * KSTR;
  constexpr int VSTR = 144, VTILE = 64 * VSTR;
  const int tid = fresh_tid(), lane = tid & 63, wid = __builtin_amdgcn_readfirstlane(tid >> 6), ql = lane & 31, h = lane >> 5;

  int T, seq_row0, hh, qblk = 0, kvh = 0;
  int dd = 1, cls = 0, u0 = 0, cfg = 0, U = 0, NB = 1;
  if (MODE == 0) {
    if (u < 512) { const int x = u & 7, j = (u >> 3) & 31, r = u >> 8, g = r * 8 + x;
      T = 8192; hh = g & 7; qblk = j; seq_row0 = (g >> 3) * 8192; }
    else { const int v = u - 512, x = v & 7, j = (v >> 3) & 31, r = v >> 8, g = (r * 8 + x) * 2 + (j >> 4);
      T = 4096; hh = g & 7; qblk = j & 15; seq_row0 = M_PROMPT + (g >> 3) * 4096; }
  } else if (MODE == 1) {
    if (u < 1024) { const int x = u & 7, j = (u >> 3) & 31, r = u >> 8;
      T = 8192; kvh = x & 3; hh = kvh * 4 + r; qblk = j; seq_row0 = (x >> 2) * 8192; }
    else { const int v = u - 1024, x = v & 7, j = (v >> 3) & 31, r = v >> 8, g = 8 * (r >> 1) + x;
      T = 4096; kvh = g & 3; hh = kvh * 4 + (r & 1) * 2 + (j >> 4); qblk = j & 15; seq_row0 = M_PROMPT + (g >> 2) * 4096; }
  } else {
    int r;
    if (u < 512) { T = 8192; seq_row0 = (u >> 8) * 8192; hh = (u >> 5) & 7; r = u & 31;
      if (r < 8) { cfg = 0; cls = 0; NB = 4; u0 = r * 1024; }
      else if (r < 16) { cfg = 1; cls = (r - 8) >> 1; NB = 4; u0 = ((r - 8) & 1) * 1024; }
      else { cfg = 2; cls = r - 16; NB = 2; u0 = 0; } }
    else { const int v = u - 512; T = 4096; seq_row0 = M_PROMPT + (v / 192) * 4096; hh = (v / 24) & 7; r = v % 24;
      if (r < 4) { cfg = 0; cls = 0; NB = 4; u0 = r * 1024; }
      else if (r < 8) { cfg = 1; cls = r - 4; NB = 4; u0 = 0; }
      else { cfg = 2; cls = r - 8; NB = 1; u0 = 0; } }
    dd = 1 << (2 * cfg); U = T >> (2 * cfg);
  }

  int mq = 0;
  bf16x8 qf[NC];
  float c2, slope2 = 0.f;
  if (MODE == 0) c2 = 0.10206207261596577f * LOG2E;
  else c2 = 0.125f * LOG2E;
  if (MODE == 2) slope2 = exp2f(-(float)(hh + 1)) * (float)dd * LOG2E;
  auto load_q = [&](int b) {
    const bf16_t* qp;
    if (MODE == 0) { mq = seq_row0 + qblk * 256 + wid * 32 + ql; qp = p.qb + (size_t)mq * 768 + hh * 96 + 8 * h; }
    else if (MODE == 1) { mq = seq_row0 + qblk * 256 + wid * 32 + ql; qp = p.proj + (size_t)mq * N_C + hh * 64 + 8 * h; }
    else { mq = seq_row0 + (u0 + b * 256 + wid * 32 + ql) * dd + cls; qp = p.proj + (size_t)mq * N_AB + hh * 64 + 8 * h; }
#pragma unroll
    for (int c = 0; c < NC; ++c) {
      u32x4 w = *(const u32x4*)(qp + 16 * c);
#pragma unroll
      for (int j = 0; j < 4; ++j) w[j] = pk_bf16(bflo(w[j]) * c2, bfhi(w[j]) * c2);
      qf[c] = __builtin_bit_cast(bf16x8, w);
    }
  };
  load_q(0);

  int kt_lo = 0, kt_hi;
  if (MODE == 2) { kt_lo = (u0 == 0) ? 0 : -1; kt_hi = (u0 + 256 * NB >= U) ? 4 * NB - 1 : 4 * NB; }
  else kt_hi = (T >> 6) - 1;
  const int n_it = kt_hi - kt_lo + 1;

  unsigned zero_v = 0u;
  asm volatile("" : "+v"(zero_v));
  const u32x4 zero4 = (u32x4){zero_v, zero_v, zero_v, zero_v};
  u32x4 ka0, ka1 = zero4, va, kb0, kb1 = zero4, vb;
  const int key = tid >> 3, kc = tid & 7;
  const int rkey = (tid >> 2) & 63, rc = tid & 3;
  unsigned koffg, roffg = 0, voffg;
  if (MODE == 0) { koffg = (unsigned)(key * 512 + 8 * kc) * 2u; roffg = (unsigned)(rkey * 32 + 8 * rc) * 2u; voffg = (unsigned)(key * T + 8 * kc) * 2u; }
  else if (MODE == 1) { koffg = (unsigned)(key * N_C + 8 * kc) * 2u; voffg = (unsigned)(key * T + 8 * kc) * 2u; }
  else { koffg = (unsigned)(key * dd * N_AB + 8 * kc) * 2u; voffg = koffg; }
  auto gloadK = [&](int kt, u32x4& kr0, u32x4& kr1) {
    if (MODE == 0) {
      const char* kb = (const char*)(p.knope + (size_t)(seq_row0 + 64 * kt) * 512 + hh * 64);
      const char* rb = (const char*)(p.krope + (size_t)(seq_row0 + 64 * kt) * 32);
      kr0 = *(const u32x4*)(kb + koffg);
      if (tid < 256) kr1 = *(const u32x4*)(rb + roffg);
    } else if (MODE == 1) {
      const char* kb = (const char*)(p.proj + (size_t)(seq_row0 + 64 * kt) * N_C + 1024 + kvh * 64);
      kr0 = *(const u32x4*)(kb + koffg);
    } else {
      const char* kb = (const char*)(p.proj + ((size_t)seq_row0 + (size_t)(u0 + 64 * kt) * dd + cls) * N_AB + 512 + hh * 64);
      kr0 = *(const u32x4*)(kb + koffg);
    }
  };
  auto gloadV = [&](int kt, u32x4& vr) {
    if (MODE == 0) {
      const char* vb = (const char*)(p.vbT + (size_t)seq_row0 * 512 + (size_t)(hh * 64) * T + 64 * kt);
      vr = *(const u32x4*)(vb + voffg);
    } else if (MODE == 1) {
      const char* vb = (const char*)(p.v1T + (size_t)seq_row0 * 256 + (size_t)(kvh * 64) * T + 64 * kt);
      vr = *(const u32x4*)(vb + voffg);
    } else {
      const char* vb = (const char*)(p.proj + ((size_t)seq_row0 + (size_t)(u0 + 64 * kt) * dd + cls) * N_AB + 1024 + hh * 64);
      vr = *(const u32x4*)(vb + voffg);
    }
  };
  auto lwriteK = [&](int stg, const u32x4& kr0, const u32x4& kr1) {
    char* ks = lds + stg * KTILE;
    *(u32x4*)(ks + key * KSTR + kc * 16) = kr0;
    if (MODE == 0) { if (tid < 256) *(u32x4*)(ks + rkey * KSTR + 128 + rc * 16) = kr1; }
  };
  auto lwriteV = [&](int slot, const u32x4& vr) {
    char* vs = lds + 3 * KTILE + slot * VTILE;
    if (MODE != 2) {
      *(u32x4*)(vs + key * VSTR + kc * 16) = vr;
    } else {
#pragma unroll
      for (int j = 0; j < 4; ++j) {
        *(bf16_t*)(vs + (8 * kc + 2 * j) * VSTR + key * 2) = (bf16_t)(vr[j] & 0xffffu);
        *(bf16_t*)(vs + (8 * kc + 2 * j + 1) * VSTR + key * 2) = (bf16_t)(vr[j] >> 16);
      }
    }
  };

  f32x16 o0, o1;
#pragma unroll
  for (int i = 0; i < 16; ++i) { o0[i] = 0.f; o1[i] = 0.f; }
  const int sq = (ql & ~12) | ((ql & 4) << 1) | ((ql & 8) >> 1);
  const int koff = sq * KSTR + h * 16, voff = 3 * KTILE + ql * VSTR + h * 16;
  float m_ref = 0.f, l_run = 0.f;
  bool fresh = true;
  bool zref = true;
  int cur_b = (MODE == 2) ? -1 : 0;
  auto qk = [&](int stg, f32x16& s0, f32x16& s1) {
    const char* kp = lds + stg * KTILE + koff;
#pragma unroll
    for (int i = 0; i < 16; ++i) { s0[i] = 0.f; s1[i] = 0.f; }
#pragma unroll
    for (int c = 0; c < NC; ++c) {
      const bf16x8 k0 = *(const bf16x8*)(kp + c * 32);
      const bf16x8 k1 = *(const bf16x8*)(kp + 32 * KSTR + c * 32);
      s0 = MFMA32(k0, qf[c], s0);
      s1 = MFMA32(k1, qf[c], s1);
    }
  };
  auto rowmax = [&](int kt, f32x16& s0, f32x16& s1) -> float {
    float mx = -1e30f;
    if (MODE == 2) {
      const int base = 64 * kt + 8 * h - (256 * cur_b + 32 * wid + ql);
#pragma unroll
      for (int i = 0; i < 16; ++i) {
        const int d0 = base + 16 * (i >> 3) + (i & 7);
        const int d1 = d0 + 32;
        const int a0 = d0 < 0 ? -d0 : d0, a1 = d1 < 0 ? -d1 : d1;
        s0[i] = (a0 <= 64) ? (s0[i] - slope2 * (float)a0) : -1e30f;
        s1[i] = (a1 <= 64) ? (s1[i] - slope2 * (float)a1) : -1e30f;
        mx = fmaxf(mx, fmaxf(s0[i], s1[i]));
      }
    } else {
#pragma unroll
      for (int i = 0; i < 16; ++i) mx = fmaxf(mx, fmaxf(s0[i], s1[i]));
    }
    return fmaxf(mx, __shfl_xor(mx, 32));
  };
  u32x4 pa[2], pb[2];
#pragma unroll
  for (int s = 0; s < 2; ++s) { pa[s] = zero4; pb[s] = zero4; }
  auto pv = [&](int slot) {
    const char* vp = lds + slot * VTILE + voff;
#pragma unroll
    for (int s = 0; s < 2; ++s) {
      const bf16x8 pfa = __builtin_bit_cast(bf16x8, pa[s]), pfb = __builtin_bit_cast(bf16x8, pb[s]);
      const bf16x8 va0 = *(const bf16x8*)(vp + s * 32);
      const bf16x8 va1 = *(const bf16x8*)(vp + 32 * VSTR + s * 32);
      const bf16x8 vb0 = *(const bf16x8*)(vp + 64 + s * 32);
      const bf16x8 vb1 = *(const bf16x8*)(vp + 32 * VSTR + 64 + s * 32);
      o0 = MFMA32(va0, pfa, o0);
      o1 = MFMA32(va1, pfa, o1);
      o0 = MFMA32(vb0, pfb, o0);
      o1 = MFMA32(vb1, pfb, o1);
    }
  };
  auto softmax = [&](f32x16& s0, f32x16& s1, float mxr) {
    const bool upd = fresh ? (__builtin_amdgcn_ballot_w64(fabsf(mxr) > 24.f && mxr > -1e29f) != 0ull)
                           : (__builtin_amdgcn_ballot_w64(mxr - m_ref > 24.f) != 0ull);
    if (upd) {
      const float delta = fresh ? ((mxr > -1e29f) ? mxr : 0.f) : fmaxf(mxr - m_ref, 0.f);
      const float alpha = fresh ? 0.f : __builtin_amdgcn_exp2f(-delta);
      m_ref += delta;
      zref = false;
      l_run *= alpha;
#pragma unroll
      for (int i = 0; i < 16; ++i) { o0[i] *= alpha; o1[i] *= alpha; }
    }
    fresh = false;
    if (!zref) {
#pragma unroll
      for (int i = 0; i < 16; ++i) { s0[i] -= m_ref; s1[i] -= m_ref; }
    }
    float ls = 0.f;
    if (MODE == 2) {
#pragma unroll
      for (int i = 0; i < 16; ++i) {
        s0[i] = (s0[i] > -1e29f) ? __builtin_amdgcn_exp2f(s0[i]) : 0.f;
        s1[i] = (s1[i] > -1e29f) ? __builtin_amdgcn_exp2f(s1[i]) : 0.f;
        ls += s0[i] + s1[i];
      }
    } else {
#pragma unroll
      for (int i = 0; i < 16; ++i) {
        s0[i] = __builtin_amdgcn_exp2f(s0[i]);
        s1[i] = __builtin_amdgcn_exp2f(s1[i]);
        ls += s0[i] + s1[i];
      }
    }
    l_run += ls;
#pragma unroll
    for (int s = 0; s < 2; ++s)
#pragma unroll
      for (int j = 0; j < 4; ++j) {
        pa[s][j] = pk_bf16(s0[8 * s + 2 * j], s0[8 * s + 2 * j + 1]);
        pb[s][j] = pk_bf16(s1[8 * s + 2 * j], s1[8 * s + 2 * j + 1]);
      }
  };
  auto wave_active = [&](int kt) -> bool {
    if (MODE != 2) return true;
    const int wc = wid >> 1;
    return (kt >= wc - 1) && (kt <= wc + 1);
  };
  const bool late = (MODE == 2) ? false : (((wid >> 1) & 1) != 0);

  __syncthreads();
  gloadK(kt_lo, ka0, ka1); gloadV(kt_lo, va);
  lwriteK(0, ka0, ka1); lwriteV(0, va);
  gloadK(kt_lo + 1, ka0, ka1);
  lwriteK(1, ka0, ka1);
  if (MODE != 2) *(u32x4*)(lds + 3 * KTILE + 2 * VTILE + key * VSTR + kc * 16) = zero4;
  gloadK(kt_lo + 2, ka0, ka1);
  gloadV(kt_lo + 1, va);
  __syncthreads();
  f32x16 s0, s1;
#pragma unroll
  for (int i = 0; i < 16; ++i) { s0[i] = 0.f; s1[i] = 0.f; }
  float mx = -1e30f;
  if (late) { qk(0, s0, s1); mx = rowmax(kt_lo, s0, s1); }
  int sl_c = 0;
  auto finalize2 = [&]() {
    const float l_tot = l_run + __shfl_xor(l_run, 32);
    const float inv = 1.f / l_tot;
    bf16_t* dst = p.pA + (size_t)cfg * M_TOK * 512 + (size_t)mq * 512 + hh * 64;
#pragma unroll
    for (int g = 0; g < 4; ++g) {
      const int d = 8 * g + 4 * h;
      u32x2 w0, w1;
      w0[0] = pk_bf16(o0[4 * g] * inv, o0[4 * g + 1] * inv); w0[1] = pk_bf16(o0[4 * g + 2] * inv, o0[4 * g + 3] * inv);
      w1[0] = pk_bf16(o1[4 * g] * inv, o1[4 * g + 1] * inv); w1[1] = pk_bf16(o1[4 * g + 2] * inv, o1[4 * g + 3] * inv);
      *(u32x2*)(dst + d) = w0;
      *(u32x2*)(dst + 32 + d) = w1;
    }
    if (h == 0) p.lse[(size_t)cfg * M_TOK * 8 + (size_t)mq * 8 + hh] = m_ref + __builtin_amdgcn_logf(l_tot);
  };
  auto step = [&](int it, u32x4& nk0, u32x4& nk1, u32x4& nv, const u32x4& ok0, const u32x4& ok1, const u32x4& ov) {
    const int kt = kt_lo + it;
    const int sl_p = (sl_c == 0) ? 2 : sl_c - 1, sl_n = (sl_c == 2) ? 0 : sl_c + 1;
    if (it + 3 < n_it) gloadK(kt + 3, nk0, nk1);
    if (it + 2 < n_it) gloadV(kt + 2, nv);
    if (MODE == 2) {
      const int rel = kt - ((wid >> 1) - 1);
      const int b = rel >> 2, pos = rel & 3;
      if (rel >= 0 && b < NB && pos < 3) {
        if (b != cur_b) {
          cur_b = b;
          load_q(b);
#pragma unroll
          for (int i = 0; i < 16; ++i) { o0[i] = 0.f; o1[i] = 0.f; }
          l_run = 0.f; m_ref = 0.f; fresh = true; zref = true;
        }
        qk(sl_c, s0, s1);
        mx = rowmax(kt, s0, s1);
        softmax(s0, s1, mx);
        pv(sl_c);
        if (pos == 2 || kt == kt_hi) finalize2();
      }
    } else if (late) {
      softmax(s0, s1, mx);
      __builtin_amdgcn_sched_barrier(0);
      pv(sl_c);
      qk(sl_n, s0, s1);
      mx = rowmax(kt + 1, s0, s1);
    } else {
      pv(sl_p);
      qk(sl_c, s0, s1);
      __builtin_amdgcn_sched_barrier(0);
      mx = rowmax(kt, s0, s1);
      softmax(s0, s1, mx);
    }
    if (it + 2 < n_it) lwriteK(sl_p, ok0, ok1);
    if (it + 1 < n_it) lwriteV(sl_n, ov);
    __syncthreads();
    sl_c = sl_n;
  };
  for (int it = 0; it < n_it; it += 2) {
    step(it, kb0, kb1, vb, ka0, ka1, va);
    if (MODE != 2 || it + 1 < n_it) step(it + 1, ka0, ka1, va, kb0, kb1, vb);
  }
  if (MODE != 2 && !late) pv((sl_c == 0) ? 2 : sl_c - 1);
  if (MODE != 2) {
  const float l_tot = l_run + __shfl_xor(l_run, 32);
  const float inv = 1.f / l_tot;
  {
    const bf16_t* gp; bf16_t* dst;
    if (MODE == 0) { gp = p.proj + (size_t)mq * LD0 + (416 + 512) + hh * 64; dst = p.h + (size_t)mq * 1024 + 512 + hh * 64; }
    else { gp = p.proj + (size_t)mq * N_C + 1536 + hh * 64; dst = p.h + (size_t)mq * 1024 + hh * 64; }
#pragma unroll
    for (int g = 0; g < 4; ++g) {
      const int d = 8 * g + 4 * h;
      const u32x2 g0 = *(const u32x2*)(gp + d), g1 = *(const u32x2*)(gp + 32 + d);
      u32x2 w0, w1;
      w0[0] = pk_bf16(o0[4 * g] * inv * bflo(g0[0]), o0[4 * g + 1] * inv * bfhi(g0[0]));
      w0[1] = pk_bf16(o0[4 * g + 2] * inv * bflo(g0[1]), o0[4 * g + 3] * inv * bfhi(g0[1]));
      w1[0] = pk_bf16(o1[4 * g] * inv * bflo(g1[0]), o1[4 * g + 1] * inv * bfhi(g1[0]));
      w1[1] = pk_bf16(o1[4 * g + 2] * inv * bflo(g1[1]), o1[4 * g + 3] * inv * bfhi(g1[1]));
      *(u32x2*)(dst + d) = w0;
      *(u32x2*)(dst + 32 + d) = w1;
    }
  }
  }
}

template <int MODE>
DI void attn_dense(const Params& p, int u, char* lds) {
  constexpr int DQK = (MODE == 0) ? 96 : 64;
  constexpr int NC = DQK / 16;
  constexpr int KSTR = DQK * 2 + 16;
  constexpr int KTILE = 64 * KSTR;
  constexpr int VSTR = 144, VTILE = 64 * VSTR;
  const int tid = fresh_tid(), lane = tid & 63, wid = __builtin_amdgcn_readfirstlane(tid >> 6), ql = lane & 31, h = lane >> 5;

  int T, seq_row0, hh, qblk, kvh = 0;
  if (MODE == 0) {
    if (u < 512) { const int x = u & 7, j = (u >> 3) & 31, r = u >> 8, g = r * 8 + x;
      T = 8192; hh = g & 7; qblk = j; seq_row0 = (g >> 3) * 8192; }
    else { const int v = u - 512, x = v & 7, j = (v >> 3) & 31, r = v >> 8, g = (r * 8 + x) * 2 + (j >> 4);
      T = 4096; hh = g & 7; qblk = j & 15; seq_row0 = M_PROMPT + (g >> 3) * 4096; }
  } else {
    if (u < 1024) { const int x = u & 7, j = (u >> 3) & 31, r = u >> 8;
      T = 8192; kvh = x & 3; hh = kvh * 4 + r; qblk = j; seq_row0 = (x >> 2) * 8192; }
    else { const int v = u - 1024, x = v & 7, j = (v >> 3) & 31, r = v >> 8, g = 8 * (r >> 1) + x;
      T = 4096; kvh = g & 3; hh = kvh * 4 + (r & 1) * 2 + (j >> 4); qblk = j & 15; seq_row0 = M_PROMPT + (g >> 2) * 4096; }
  }
  const int mq = seq_row0 + qblk * 256 + wid * 32 + ql;
  const float c2 = (MODE == 0) ? 0.10206207261596577f * LOG2E : 0.125f * LOG2E;
  bf16x8 qf[NC];
  {
    const bf16_t* qp = (MODE == 0) ? p.qb + (size_t)mq * 768 + hh * 96 + 8 * h : p.proj + (size_t)mq * N_C + hh * 64 + 8 * h;
#pragma unroll
    for (int c = 0; c < NC; ++c) {
      u32x4 w = *(const u32x4*)(qp + 16 * c);
#pragma unroll
      for (int j = 0; j < 4; ++j) w[j] = pk_bf16(bflo(w[j]) * c2, bfhi(w[j]) * c2);
      qf[c] = __builtin_bit_cast(bf16x8, w);
    }
  }
  const int n_it = T >> 6;

  unsigned zero_v = 0u;
  asm volatile("" : "+v"(zero_v));
  const u32x4 zero4 = (u32x4){zero_v, zero_v, zero_v, zero_v};
  u32x4 kr0, kr1 = zero4, vr;
  const int key = tid >> 3, kc = tid & 7;
  const int rkey = (tid >> 2) & 63, rc = tid & 3;
  const unsigned koffg = (MODE == 0) ? (unsigned)(key * 512 + 8 * kc) * 2u : (unsigned)(key * N_C + 8 * kc) * 2u;
  const unsigned roffg = (unsigned)(rkey * 32 + 8 * rc) * 2u;
  const unsigned voffg = (unsigned)(key * T + 8 * kc) * 2u;
  auto gloadK = [&](int kt) {
    if (MODE == 0) {
      const char* kb = (const char*)(p.knope + (size_t)(seq_row0 + 64 * kt) * 512 + hh * 64);
      const char* rb = (const char*)(p.krope + (size_t)(seq_row0 + 64 * kt) * 32);
      kr0 = *(const u32x4*)(kb + koffg);
      if (tid < 256) kr1 = *(const u32x4*)(rb + roffg);
    } else {
      const char* kb = (const char*)(p.proj + (size_t)(seq_row0 + 64 * kt) * N_C + 1024 + kvh * 64);
      kr0 = *(const u32x4*)(kb + koffg);
    }
  };
  auto gloadV = [&](int kt) {
    const char* vb = (MODE == 0) ? (const char*)(p.vbT + (size_t)seq_row0 * 512 + (size_t)(hh * 64) * T + 64 * kt)
                                 : (const char*)(p.v1T + (size_t)seq_row0 * 256 + (size_t)(kvh * 64) * T + 64 * kt);
    vr = *(const u32x4*)(vb + voffg);
  };
  const int lwk = key * KSTR + kc * 16, lwr = rkey * KSTR + 128 + rc * 16, lwv = 3 * KTILE + key * VSTR + kc * 16;
  auto lwriteK = [&](int slot) {
    *(u32x4*)(lds + slot * KTILE + lwk) = kr0;
    if (MODE == 0) { if (tid < 256) *(u32x4*)(lds + slot * KTILE + lwr) = kr1; }
  };
  auto lwriteV = [&](int slot) { *(u32x4*)(lds + slot * VTILE + lwv) = vr; };

  f32x16 o0, o1;
#pragma unroll
  for (int i = 0; i < 16; ++i) { o0[i] = 0.f; o1[i] = 0.f; }
  const int sq = (ql & ~12) | ((ql & 4) << 1) | ((ql & 8) >> 1);
  const int koff = sq * KSTR + h * 16, voff = 3 * KTILE + ql * VSTR + h * 16;
  float m_ref = 0.f, l_run = 0.f;
  bool zref = true;
  u32x4 pa0 = zero4, pa1 = zero4, pb0 = zero4, pb1 = zero4;

  __syncthreads();
  gloadK(0); gloadV(0);
  lwriteK(0); lwriteV(0);
  gloadK(1);
  lwriteK(1);
  *(u32x4*)(lds + 2 * VTILE + lwv) = zero4;
  __syncthreads();
  {
    const char* kp = lds + koff;
    f32x16 t0, t1;
#pragma unroll
    for (int i = 0; i < 16; ++i) { t0[i] = 0.f; t1[i] = 0.f; }
#pragma unroll
    for (int c = 0; c < NC; ++c) {
      t0 = MFMA32(*(const bf16x8*)(kp + c * 32), qf[c], t0);
      t1 = MFMA32(*(const bf16x8*)(kp + 32 * KSTR + c * 32), qf[c], t1);
    }
    float mx = -1e30f;
#pragma unroll
    for (int i = 0; i < 16; ++i) mx = fmax_nc(mx, fmax_nc(t0[i], t1[i]));
    mx = fmax_nc(mx, __shfl_xor(mx, 32));
    if (__builtin_amdgcn_ballot_w64(fabsf(mx) > 24.f) != 0ull) { m_ref = mx; zref = false; }
  }
  int sl_c = 0;
  for (int it = 0; it < n_it; ++it) {
    const int sl_p = (sl_c == 0) ? 2 : sl_c - 1, sl_n = (sl_c == 2) ? 0 : sl_c + 1;
    if (it + 2 < n_it) gloadK(it + 2);
    if (it + 1 < n_it) gloadV(it + 1);
    const char* kp = lds + sl_c * KTILE + koff;
    const char* vp = lds + sl_p * VTILE + voff;
    {
      const bf16x8 pf0 = __builtin_bit_cast(bf16x8, pa0), pf1 = __builtin_bit_cast(bf16x8, pb0);
      const bf16x8 pf2 = __builtin_bit_cast(bf16x8, pa1), pf3 = __builtin_bit_cast(bf16x8, pb1);
      o0 = MFMA32(*(const bf16x8*)(vp), pf0, o0);
      o1 = MFMA32(*(const bf16x8*)(vp + 32 * VSTR), pf0, o1);
      o0 = MFMA32(*(const bf16x8*)(vp + 64), pf1, o0);
      o1 = MFMA32(*(const bf16x8*)(vp + 32 * VSTR + 64), pf1, o1);
      o0 = MFMA32(*(const bf16x8*)(vp + 32), pf2, o0);
      o1 = MFMA32(*(const bf16x8*)(vp + 32 * VSTR + 32), pf2, o1);
      o0 = MFMA32(*(const bf16x8*)(vp + 64 + 32), pf3, o0);
      o1 = MFMA32(*(const bf16x8*)(vp + 32 * VSTR + 64 + 32), pf3, o1);
    }
    f32x16 s0, s1;
#pragma unroll
    for (int i = 0; i < 16; ++i) { s0[i] = 0.f; s1[i] = 0.f; }
#pragma unroll
    for (int c = 0; c < NC; ++c) {
      s0 = MFMA32(*(const bf16x8*)(kp + c * 32), qf[c], s0);
      s1 = MFMA32(*(const bf16x8*)(kp + 32 * KSTR + c * 32), qf[c], s1);
    }
    if (!zref) {
#pragma unroll
      for (int i = 0; i < 16; ++i) { s0[i] -= m_ref; s1[i] -= m_ref; }
    }
    float ls = 0.f;
#pragma unroll
    for (int i = 0; i < 16; ++i) {
      s0[i] = __builtin_amdgcn_exp2f(s0[i]);
      s1[i] = __builtin_amdgcn_exp2f(s1[i]);
      ls += s0[i] + s1[i];
    }
    if (__builtin_amdgcn_ballot_w64(!(ls < 1e30f)) != 0ull) {
#pragma unroll
      for (int i = 0; i < 16; ++i) { s0[i] = 0.f; s1[i] = 0.f; }
#pragma unroll
      for (int c = 0; c < NC; ++c) {
        s0 = MFMA32(*(const bf16x8*)(kp + c * 32), qf[c], s0);
        s1 = MFMA32(*(const bf16x8*)(kp + 32 * KSTR + c * 32), qf[c], s1);
      }
      float mx = -1e30f;
#pragma unroll
      for (int i = 0; i < 16; ++i) mx = fmaxf(mx, fmaxf(s0[i], s1[i]));
      mx = fmaxf(mx, __shfl_xor(mx, 32));
      const float delta = fmaxf(mx - m_ref, 0.f);
      const float alpha = __builtin_amdgcn_exp2f(-delta);
      m_ref += delta;
      zref = false;
      l_run *= alpha;
#pragma unroll
      for (int i = 0; i < 16; ++i) { o0[i] *= alpha; o1[i] *= alpha; }
      ls = 0.f;
#pragma unroll
      for (int i = 0; i < 16; ++i) {
        s0[i] = __builtin_amdgcn_exp2f(s0[i] - m_ref);
        s1[i] = __builtin_amdgcn_exp2f(s1[i] - m_ref);
        ls += s0[i] + s1[i];
      }
    }
    l_run += ls;
#pragma unroll
    for (int j = 0; j < 4; ++j) {
      pa0[j] = pk_bf16(s0[2 * j], s0[2 * j + 1]);
      pa1[j] = pk_bf16(s0[8 + 2 * j], s0[8 + 2 * j + 1]);
      pb0[j] = pk_bf16(s1[2 * j], s1[2 * j + 1]);
      pb1[j] = pk_bf16(s1[8 + 2 * j], s1[8 + 2 * j + 1]);
    }
    if (it + 2 < n_it) lwriteK(sl_p);
    if (it + 1 < n_it) lwriteV(sl_n);
    __syncthreads();
    sl_c = sl_n;
  }
  {
    const char* vp = lds + ((sl_c == 0) ? 2 : sl_c - 1) * VTILE + voff;
    const bf16x8 pf0 = __builtin_bit_cast(bf16x8, pa0), pf1 = __builtin_bit_cast(bf16x8, pb0);
    const bf16x8 pf2 = __builtin_bit_cast(bf16x8, pa1), pf3 = __builtin_bit_cast(bf16x8, pb1);
    o0 = MFMA32(*(const bf16x8*)(vp), pf0, o0);
    o1 = MFMA32(*(const bf16x8*)(vp + 32 * VSTR), pf0, o1);
    o0 = MFMA32(*(const bf16x8*)(vp + 64), pf1, o0);
    o1 = MFMA32(*(const bf16x8*)(vp + 32 * VSTR + 64), pf1, o1);
    o0 = MFMA32(*(const bf16x8*)(vp + 32), pf2, o0);
    o1 = MFMA32(*(const bf16x8*)(vp + 32 * VSTR + 32), pf2, o1);
    o0 = MFMA32(*(const bf16x8*)(vp + 64 + 32), pf3, o0);
    o1 = MFMA32(*(const bf16x8*)(vp + 32 * VSTR + 64 + 32), pf3, o1);
  }
  const float l_tot = l_run + __shfl_xor(l_run, 32);
  const float inv = 1.f / l_tot;
  const bf16_t* gp; bf16_t* dst;
  if (MODE == 0) { gp = p.proj + (size_t)mq * LD0 + (416 + 512) + hh * 64; dst = p.h + (size_t)mq * 1024 + 512 + hh * 64; }
  else { gp = p.proj + (size_t)mq * N_C + 1536 + hh * 64; dst = p.h + (size_t)mq * 1024 + hh * 64; }
#pragma unroll
  for (int g = 0; g < 4; ++g) {
    const int d = 8 * g + 4 * h;
    const u32x2 g0 = *(const u32x2*)(gp + d), g1 = *(const u32x2*)(gp + 32 + d);
    u32x2 w0, w1;
    w0[0] = pk_bf16(o0[4 * g] * inv * bflo(g0[0]), o0[4 * g + 1] * inv * bfhi(g0[0]));
    w0[1] = pk_bf16(o0[4 * g + 2] * inv * bflo(g0[1]), o0[4 * g + 3] * inv * bfhi(g0[1]));
    w1[0] = pk_bf16(o1[4 * g] * inv * bflo(g1[0]), o1[4 * g + 1] * inv * bfhi(g1[0]));
    w1[1] = pk_bf16(o1[4 * g + 2] * inv * bflo(g1[1]), o1[4 * g + 3] * inv * bfhi(g1[1]));
    *(u32x2*)(dst + d) = w0;
    *(u32x2*)(dst + 32 + d) = w1;
  }
}

template <int MODE, bool SPLIT = false, bool PIPE = false>
DI void attn_dense128(const Params& p, int u, char* lds) {
  constexpr int DQK = (MODE == 0) ? 96 : 64;
  constexpr int NC = DQK / 16;
  constexpr int KSTR = DQK * 2 + 16;
  constexpr int KTILE = 128 * KSTR;
  constexpr int VSTR = 272, VTILE = 64 * VSTR;
  const int tid = fresh_tid(), lane = tid & 63, wid = __builtin_amdgcn_readfirstlane(tid >> 6), ql = lane & 31, h = lane >> 5;

  int T, seq_row0, hh, qblk, kvh = 0;
  if (MODE == 0) {
    if (u < 512) { const int x = u & 7, j = (u >> 3) & 31, r = u >> 8, g = r * 8 + x;
      T = 8192; hh = g & 7; qblk = j; seq_row0 = (g >> 3) * 8192; }
    else { const int v = u - 512, x = v & 7, j = (v >> 3) & 31, r = v >> 8, g = (r * 8 + x) * 2 + (j >> 4);
      T = 4096; hh = g & 7; qblk = j & 15; seq_row0 = M_PROMPT + (g >> 3) * 4096; }
  } else {
    if (u < 1024) { const int x = u & 7, j = (u >> 3) & 31, r = u >> 8;
      T = 8192; kvh = x & 3; hh = kvh * 4 + r; qblk = j; seq_row0 = (x >> 2) * 8192; }
    else { const int v = u - 1024, x = v & 7, j = (v >> 3) & 31, r = v >> 8, g = 8 * (r >> 1) + x;
      T = 4096; kvh = g & 3; hh = kvh * 4 + (r & 1) * 2 + (j >> 4); qblk = j & 15; seq_row0 = M_PROMPT + (g >> 2) * 4096; }
  }
  const int mq = seq_row0 + qblk * 256 + wid * 32 + ql;
  const float c2 = (MODE == 0) ? 0.10206207261596577f * LOG2E : 0.125f * LOG2E;
  bf16x8 qf[NC];
  {
    const bf16_t* qp = (MODE == 0) ? p.qb + (size_t)mq * 768 + hh * 96 + 8 * h : p.proj + (size_t)mq * N_C + hh * 64 + 8 * h;
#pragma unroll
    for (int c = 0; c < NC; ++c) {
      u32x4 w = *(const u32x4*)(qp + 16 * c);
#pragma unroll
      for (int j = 0; j < 4; ++j) w[j] = pk_bf16(bflo(w[j]) * c2, bfhi(w[j]) * c2);
      qf[c] = __builtin_bit_cast(bf16x8, w);
    }
  }
  const int n_it = T >> 7;

  unsigned zero_v = 0u;
  asm volatile("" : "+v"(zero_v));
  const u32x4 zero4 = (u32x4){zero_v, zero_v, zero_v, zero_v};
  u32x4 kr0, kr1, kr2 = zero4, vr0, vr1;
  const int key = tid >> 3, kc = tid & 7;
  const int rkey = tid >> 2, rc = tid & 3;
  const int vd = tid >> 4, vc = tid & 15;
  const unsigned koffg = (MODE == 0) ? (unsigned)(key * 512 + 8 * kc) * 2u : (unsigned)(key * N_C + 8 * kc) * 2u;
  const unsigned koffg2 = (MODE == 0) ? 64u * 512u * 2u : 64u * (unsigned)N_C * 2u;
  const unsigned roffg = (unsigned)(rkey * 32 + 8 * rc) * 2u;
  const unsigned voffg = (unsigned)(vd * T + 8 * vc) * 2u, voffg2 = (unsigned)(32 * T) * 2u;
  auto gloadK = [&](int kt) {
    if (MODE == 0) {
      const char* kb = (const char*)(p.knope + (size_t)(seq_row0 + 128 * kt) * 512 + hh * 64);
      const char* rb = (const char*)(p.krope + (size_t)(seq_row0 + 128 * kt) * 32);
      kr0 = *(const u32x4*)(kb + koffg);
      kr1 = *(const u32x4*)(kb + koffg + koffg2);
      kr2 = *(const u32x4*)(rb + roffg);
    } else {
      const char* kb = (const char*)(p.proj + (size_t)(seq_row0 + 128 * kt) * N_C + 1024 + kvh * 64);
      kr0 = *(const u32x4*)(kb + koffg);
      kr1 = *(const u32x4*)(kb + koffg + koffg2);
    }
  };
  auto gloadV = [&](int kt) {
    const char* vb = (MODE == 0) ? (const char*)(p.vbT + (size_t)seq_row0 * 512 + (size_t)(hh * 64) * T + 128 * kt)
                                 : (const char*)(p.v1T + (size_t)seq_row0 * 256 + (size_t)(kvh * 64) * T + 128 * kt);
    vr0 = *(const u32x4*)(vb + voffg);
    vr1 = *(const u32x4*)(vb + voffg + voffg2);
  };
  const int lwk = key * KSTR + kc * 16, lwr = rkey * KSTR + 128 + rc * 16, lwv = 3 * KTILE + vd * VSTR + vc * 16;
  auto lwriteK = [&](int slot) {
    *(u32x4*)(lds + slot * KTILE + lwk) = kr0;
    *(u32x4*)(lds + slot * KTILE + lwk + 64 * KSTR) = kr1;
    if (MODE == 0) *(u32x4*)(lds + slot * KTILE + lwr) = kr2;
  };
  auto lwriteV = [&](int slot) {
    *(u32x4*)(lds + slot * VTILE + lwv) = vr0;
    *(u32x4*)(lds + slot * VTILE + lwv + 32 * VSTR) = vr1;
  };

  f32x16 o0, o1;
#pragma unroll
  for (int i = 0; i < 16; ++i) { o0[i] = 0.f; o1[i] = 0.f; }
  const int sq = (ql & ~12) | ((ql & 4) << 1) | ((ql & 8) >> 1);
  const int koff = sq * KSTR + h * 16, voff = 3 * KTILE + ql * VSTR + h * 16;
  float m_ref = 0.f, l_run = 0.f;
  bool zref = true;
  u32x4 pk[4][2];
#pragma unroll
  for (int b = 0; b < 4; ++b) { pk[b][0] = zero4; pk[b][1] = zero4; }

  __syncthreads();
  gloadK(0); gloadV(0);
  lwriteK(0); lwriteV(0);
  gloadK(1);
  lwriteK(1);
  *(u32x4*)(lds + 2 * VTILE + lwv) = zero4;
  *(u32x4*)(lds + 2 * VTILE + lwv + 32 * VSTR) = zero4;
  __syncthreads();
  f32x16 t0, t1;
  {
    const char* kp = lds + koff;
#pragma unroll
    for (int i = 0; i < 16; ++i) { t0[i] = 0.f; t1[i] = 0.f; }
#pragma unroll
    for (int c = 0; c < NC; ++c) {
      t0 = MFMA32(*(const bf16x8*)(kp + c * 32), qf[c], t0);
      t1 = MFMA32(*(const bf16x8*)(kp + 32 * KSTR + c * 32), qf[c], t1);
    }
    float mx = -1e30f;
#pragma unroll
    for (int i = 0; i < 16; ++i) mx = fmax_nc(mx, fmax_nc(t0[i], t1[i]));
    mx = fmax_nc(mx, __shfl_xor(mx, 32));
    if (__builtin_amdgcn_ballot_w64(fabsf(mx) > 24.f) != 0ull) { m_ref = mx; zref = false; }
  }
  if (PIPE) {
    u32x4 qa0 = zero4, qa1 = zero4, qb0 = zero4, qb1 = zero4;
    f32x16 sA0 = t0, sA1 = t1, sB0, sB1;
    auto half_step = [&](f32x16& c0, f32x16& c1, f32x16& n0, f32x16& n1, const char* kp_next, const char* vp_prev, const char* kp_cur) {
      if (!zref) {
#pragma unroll
        for (int i = 0; i < 16; ++i) { c0[i] -= m_ref; c1[i] -= m_ref; }
      }
      {
        const bf16x8 pf0 = __builtin_bit_cast(bf16x8, qa0), pf1 = __builtin_bit_cast(bf16x8, qb0);
        const bf16x8 pf2 = __builtin_bit_cast(bf16x8, qa1), pf3 = __builtin_bit_cast(bf16x8, qb1);
        o0 = MFMA32(*(const bf16x8*)(vp_prev), pf0, o0);
        o1 = MFMA32(*(const bf16x8*)(vp_prev + 32 * VSTR), pf0, o1);
        o0 = MFMA32(*(const bf16x8*)(vp_prev + 64), pf1, o0);
        o1 = MFMA32(*(const bf16x8*)(vp_prev + 32 * VSTR + 64), pf1, o1);
        o0 = MFMA32(*(const bf16x8*)(vp_prev + 32), pf2, o0);
        o1 = MFMA32(*(const bf16x8*)(vp_prev + 32 * VSTR + 32), pf2, o1);
        o0 = MFMA32(*(const bf16x8*)(vp_prev + 64 + 32), pf3, o0);
        o1 = MFMA32(*(const bf16x8*)(vp_prev + 32 * VSTR + 64 + 32), pf3, o1);
      }
#pragma unroll
      for (int i = 0; i < 16; ++i) { n0[i] = 0.f; n1[i] = 0.f; }
#pragma unroll
      for (int c = 0; c < NC; ++c) {
        n0 = MFMA32(*(const bf16x8*)(kp_next + c * 32), qf[c], n0);
        n1 = MFMA32(*(const bf16x8*)(kp_next + 32 * KSTR + c * 32), qf[c], n1);
      }
      float ls = 0.f;
#pragma unroll
      for (int i = 0; i < 16; ++i) {
        c0[i] = __builtin_amdgcn_exp2f(c0[i]);
        c1[i] = __builtin_amdgcn_exp2f(c1[i]);
        ls += c0[i] + c1[i];
      }
#pragma unroll
      for (int g = 0; g < 2 * NC + 8; ++g) {
        __builtin_amdgcn_sched_group_barrier(0x008, 1, 0);
        __builtin_amdgcn_sched_group_barrier(0x002, (MODE == 0) ? 3 : 4, 0);
      }
      if (__builtin_amdgcn_ballot_w64(!(ls < 1e30f)) != 0ull) {
        const float m_old = m_ref;
#pragma unroll
        for (int i = 0; i < 16; ++i) { c0[i] = 0.f; c1[i] = 0.f; }
#pragma unroll
        for (int c = 0; c < NC; ++c) {
          c0 = MFMA32(*(const bf16x8*)(kp_cur + c * 32), qf[c], c0);
          c1 = MFMA32(*(const bf16x8*)(kp_cur + 32 * KSTR + c * 32), qf[c], c1);
        }
        float mx = -1e30f;
#pragma unroll
        for (int i = 0; i < 16; ++i) mx = fmaxf(mx, fmaxf(c0[i], c1[i]));
        mx = fmaxf(mx, __shfl_xor(mx, 32));
        const float delta = fmaxf(mx - m_ref, 0.f);
        const float alpha = __builtin_amdgcn_exp2f(-delta);
        m_ref += delta;
        zref = false;
        l_run *= alpha;
#pragma unroll
        for (int i = 0; i < 16; ++i) { o0[i] *= alpha; o1[i] *= alpha; }
        ls = 0.f;
#pragma unroll
        for (int i = 0; i < 16; ++i) {
          c0[i] = __builtin_amdgcn_exp2f(c0[i] - m_ref);
          c1[i] = __builtin_amdgcn_exp2f(c1[i] - m_ref);
          ls += c0[i] + c1[i];
        }
        (void)m_old;
      }
      l_run += ls;
#pragma unroll
      for (int j = 0; j < 4; ++j) {
        qa0[j] = pk_bf16(c0[2 * j], c0[2 * j + 1]);
        qa1[j] = pk_bf16(c0[8 + 2 * j], c0[8 + 2 * j + 1]);
        qb0[j] = pk_bf16(c1[2 * j], c1[2 * j + 1]);
        qb1[j] = pk_bf16(c1[8 + 2 * j], c1[8 + 2 * j + 1]);
      }
    };
    int sl_c = 0;
    for (int it = 0; it < n_it; ++it) {
      const int sl_p = (sl_c == 0) ? 2 : sl_c - 1, sl_n = (sl_c == 2) ? 0 : sl_c + 1;
      if (it + 2 < n_it) gloadK(it + 2);
      if (it + 1 < n_it) gloadV(it + 1);
      half_step(sA0, sA1, sB0, sB1, lds + sl_c * KTILE + 64 * KSTR + koff, lds + sl_p * VTILE + voff + 128, lds + sl_c * KTILE + koff);
      half_step(sB0, sB1, sA0, sA1, lds + sl_n * KTILE + koff, lds + sl_c * VTILE + voff, lds + sl_c * KTILE + 64 * KSTR + koff);
      if (it + 2 < n_it) lwriteK(sl_p);
      if (it + 1 < n_it) lwriteV(sl_n);
      __syncthreads();
      sl_c = sl_n;
    }
    {
      const char* vp = lds + ((sl_c == 0) ? 2 : sl_c - 1) * VTILE + voff + 128;
      const bf16x8 pf0 = __builtin_bit_cast(bf16x8, qa0), pf1 = __builtin_bit_cast(bf16x8, qb0);
      const bf16x8 pf2 = __builtin_bit_cast(bf16x8, qa1), pf3 = __builtin_bit_cast(bf16x8, qb1);
      o0 = MFMA32(*(const bf16x8*)(vp), pf0, o0);
      o1 = MFMA32(*(const bf16x8*)(vp + 32 * VSTR), pf0, o1);
      o0 = MFMA32(*(const bf16x8*)(vp + 64), pf1, o0);
      o1 = MFMA32(*(const bf16x8*)(vp + 32 * VSTR + 64), pf1, o1);
      o0 = MFMA32(*(const bf16x8*)(vp + 32), pf2, o0);
      o1 = MFMA32(*(const bf16x8*)(vp + 32 * VSTR + 32), pf2, o1);
      o0 = MFMA32(*(const bf16x8*)(vp + 64 + 32), pf3, o0);
      o1 = MFMA32(*(const bf16x8*)(vp + 32 * VSTR + 64 + 32), pf3, o1);
    }
  } else if (SPLIT) {
    u32x4 qa0 = zero4, qa1 = zero4, qb0 = zero4, qb1 = zero4;
    int sl_c = 0;
    for (int it = 0; it < n_it; ++it) {
      const int sl_p = (sl_c == 0) ? 2 : sl_c - 1, sl_n = (sl_c == 2) ? 0 : sl_c + 1;
      if (it + 2 < n_it) gloadK(it + 2);
      if (it + 1 < n_it) gloadV(it + 1);
#pragma unroll
      for (int hf = 0; hf < 2; ++hf) {
        const char* kp = lds + sl_c * KTILE + hf * 64 * KSTR + koff;
        const char* vp = lds + ((hf == 0) ? sl_p : sl_c) * VTILE + voff + (1 - hf) * 128;
        {
          const bf16x8 pf0 = __builtin_bit_cast(bf16x8, qa0), pf1 = __builtin_bit_cast(bf16x8, qb0);
          const bf16x8 pf2 = __builtin_bit_cast(bf16x8, qa1), pf3 = __builtin_bit_cast(bf16x8, qb1);
          o0 = MFMA32(*(const bf16x8*)(vp), pf0, o0);
          o1 = MFMA32(*(const bf16x8*)(vp + 32 * VSTR), pf0, o1);
          o0 = MFMA32(*(const bf16x8*)(vp + 64), pf1, o0);
          o1 = MFMA32(*(const bf16x8*)(vp + 32 * VSTR + 64), pf1, o1);
          o0 = MFMA32(*(const bf16x8*)(vp + 32), pf2, o0);
          o1 = MFMA32(*(const bf16x8*)(vp + 32 * VSTR + 32), pf2, o1);
          o0 = MFMA32(*(const bf16x8*)(vp + 64 + 32), pf3, o0);
          o1 = MFMA32(*(const bf16x8*)(vp + 32 * VSTR + 64 + 32), pf3, o1);
        }
        f32x16 s0, s1;
#pragma unroll
        for (int i = 0; i < 16; ++i) { s0[i] = 0.f; s1[i] = 0.f; }
#pragma unroll
        for (int c = 0; c < NC; ++c) {
          s0 = MFMA32(*(const bf16x8*)(kp + c * 32), qf[c], s0);
          s1 = MFMA32(*(const bf16x8*)(kp + 32 * KSTR + c * 32), qf[c], s1);
        }
        if (!zref) {
#pragma unroll
          for (int i = 0; i < 16; ++i) { s0[i] -= m_ref; s1[i] -= m_ref; }
        }
        float ls = 0.f;
#pragma unroll
        for (int i = 0; i < 16; ++i) {
          s0[i] = __builtin_amdgcn_exp2f(s0[i]);
          s1[i] = __builtin_amdgcn_exp2f(s1[i]);
          ls += s0[i] + s1[i];
        }
        if (__builtin_amdgcn_ballot_w64(!(ls < 1e30f)) != 0ull) {
#pragma unroll
          for (int i = 0; i < 16; ++i) { s0[i] = 0.f; s1[i] = 0.f; }
#pragma unroll
          for (int c = 0; c < NC; ++c) {
            s0 = MFMA32(*(const bf16x8*)(kp + c * 32), qf[c], s0);
            s1 = MFMA32(*(const bf16x8*)(kp + 32 * KSTR + c * 32), qf[c], s1);
          }
          float mx = -1e30f;
#pragma unroll
          for (int i = 0; i < 16; ++i) mx = fmaxf(mx, fmaxf(s0[i], s1[i]));
          mx = fmaxf(mx, __shfl_xor(mx, 32));
          const float delta = fmaxf(mx - m_ref, 0.f);
          const float alpha = __builtin_amdgcn_exp2f(-delta);
          m_ref += delta;
          zref = false;
          l_run *= alpha;
#pragma unroll
          for (int i = 0; i < 16; ++i) { o0[i] *= alpha; o1[i] *= alpha; }
          ls = 0.f;
#pragma unroll
          for (int i = 0; i < 16; ++i) {
            s0[i] = __builtin_amdgcn_exp2f(s0[i] - m_ref);
            s1[i] = __builtin_amdgcn_exp2f(s1[i] - m_ref);
            ls += s0[i] + s1[i];
          }
        }
        l_run += ls;
#pragma unroll
        for (int j = 0; j < 4; ++j) {
          qa0[j] = pk_bf16(s0[2 * j], s0[2 * j + 1]);
          qa1[j] = pk_bf16(s0[8 + 2 * j], s0[8 + 2 * j + 1]);
          qb0[j] = pk_bf16(s1[2 * j], s1[2 * j + 1]);
          qb1[j] = pk_bf16(s1[8 + 2 * j], s1[8 + 2 * j + 1]);
        }
      }
      if (it + 2 < n_it) lwriteK(sl_p);
      if (it + 1 < n_it) lwriteV(sl_n);
      __syncthreads();
      sl_c = sl_n;
    }
    {
      const char* vp = lds + ((sl_c == 0) ? 2 : sl_c - 1) * VTILE + voff + 128;
      const bf16x8 pf0 = __builtin_bit_cast(bf16x8, qa0), pf1 = __builtin_bit_cast(bf16x8, qb0);
      const bf16x8 pf2 = __builtin_bit_cast(bf16x8, qa1), pf3 = __builtin_bit_cast(bf16x8, qb1);
      o0 = MFMA32(*(const bf16x8*)(vp), pf0, o0);
      o1 = MFMA32(*(const bf16x8*)(vp + 32 * VSTR), pf0, o1);
      o0 = MFMA32(*(const bf16x8*)(vp + 64), pf1, o0);
      o1 = MFMA32(*(const bf16x8*)(vp + 32 * VSTR + 64), pf1, o1);
      o0 = MFMA32(*(const bf16x8*)(vp + 32), pf2, o0);
      o1 = MFMA32(*(const bf16x8*)(vp + 32 * VSTR + 32), pf2, o1);
      o0 = MFMA32(*(const bf16x8*)(vp + 64 + 32), pf3, o0);
      o1 = MFMA32(*(const bf16x8*)(vp + 32 * VSTR + 64 + 32), pf3, o1);
    }
  } else {
  int sl_c = 0;
  for (int it = 0; it < n_it; ++it) {
    const int sl_p = (sl_c == 0) ? 2 : sl_c - 1, sl_n = (sl_c == 2) ? 0 : sl_c + 1;
    if (it + 2 < n_it) gloadK(it + 2);
    if (it + 1 < n_it) gloadV(it + 1);
    const char* kp = lds + sl_c * KTILE + koff;
    const char* vp = lds + sl_p * VTILE + voff;
#pragma unroll
    for (int b = 0; b < 4; ++b)
#pragma unroll
      for (int s = 0; s < 2; ++s) {
        const bf16x8 pf = __builtin_bit_cast(bf16x8, pk[b][s]);
        o0 = MFMA32(*(const bf16x8*)(vp + b * 64 + s * 32), pf, o0);
        o1 = MFMA32(*(const bf16x8*)(vp + 32 * VSTR + b * 64 + s * 32), pf, o1);
      }
    f32x16 sc[4];
#pragma unroll
    for (int b = 0; b < 4; ++b) {
      if (MODE == 0) __builtin_amdgcn_sched_barrier(0);
#pragma unroll
      for (int i = 0; i < 16; ++i) sc[b][i] = 0.f;
#pragma unroll
      for (int c = 0; c < NC; ++c) sc[b] = MFMA32(*(const bf16x8*)(kp + b * 32 * KSTR + c * 32), qf[c], sc[b]);
    }
    if (MODE == 0) __builtin_amdgcn_sched_barrier(0);
    if (!zref) {
#pragma unroll
      for (int b = 0; b < 4; ++b)
#pragma unroll
        for (int i = 0; i < 16; ++i) sc[b][i] -= m_ref;
    }
    float ls = 0.f;
#pragma unroll
    for (int b = 0; b < 4; ++b)
#pragma unroll
      for (int i = 0; i < 16; ++i) { sc[b][i] = __builtin_amdgcn_exp2f(sc[b][i]); ls += sc[b][i]; }
    if (__builtin_amdgcn_ballot_w64(!(ls < 1e30f)) != 0ull) {
      float mx = -1e30f;
#pragma unroll
      for (int b = 0; b < 4; ++b) {
#pragma unroll
        for (int i = 0; i < 16; ++i) sc[b][i] = 0.f;
#pragma unroll
        for (int c = 0; c < NC; ++c) sc[b] = MFMA32(*(const bf16x8*)(kp + b * 32 * KSTR + c * 32), qf[c], sc[b]);
#pragma unroll
        for (int i = 0; i < 16; ++i) mx = fmaxf(mx, sc[b][i]);
      }
      mx = fmaxf(mx, __shfl_xor(mx, 32));
      const float delta = fmaxf(mx - m_ref, 0.f);
      const float alpha = __builtin_amdgcn_exp2f(-delta);
      m_ref += delta;
      zref = false;
      l_run *= alpha;
#pragma unroll
      for (int i = 0; i < 16; ++i) { o0[i] *= alpha; o1[i] *= alpha; }
      ls = 0.f;
#pragma unroll
      for (int b = 0; b < 4; ++b)
#pragma unroll
        for (int i = 0; i < 16; ++i) { sc[b][i] = __builtin_amdgcn_exp2f(sc[b][i] - m_ref); ls += sc[b][i]; }
    }
    l_run += ls;
#pragma unroll
    for (int b = 0; b < 4; ++b)
#pragma unroll
      for (int s = 0; s < 2; ++s)
#pragma unroll
        for (int j = 0; j < 4; ++j) pk[b][s][j] = pk_bf16(sc[b][8 * s + 2 * j], sc[b][8 * s + 2 * j + 1]);
    if (it + 2 < n_it) lwriteK(sl_p);
    if (it + 1 < n_it) lwriteV(sl_n);
    __syncthreads();
    sl_c = sl_n;
  }
  {
    const char* vp = lds + ((sl_c == 0) ? 2 : sl_c - 1) * VTILE + voff;
#pragma unroll
    for (int b = 0; b < 4; ++b)
#pragma unroll
      for (int s = 0; s < 2; ++s) {
        const bf16x8 pf = __builtin_bit_cast(bf16x8, pk[b][s]);
        o0 = MFMA32(*(const bf16x8*)(vp + b * 64 + s * 32), pf, o0);
        o1 = MFMA32(*(const bf16x8*)(vp + 32 * VSTR + b * 64 + s * 32), pf, o1);
      }
  }
  }
  const float l_tot = l_run + __shfl_xor(l_run, 32);
  const float inv = 1.f / l_tot;
  const bf16_t* gp; bf16_t* dst;
  if (MODE == 0) { gp = p.proj + (size_t)mq * LD0 + (416 + 512) + hh * 64; dst = p.h + (size_t)mq * 1024 + 512 + hh * 64; }
  else { gp = p.proj + (size_t)mq * N_C + 1536 + hh * 64; dst = p.h + (size_t)mq * 1024 + hh * 64; }
  u32x2 w0[4], w1[4];
#pragma unroll
  for (int g = 0; g < 4; ++g) {
    const int d = 8 * g + 4 * h;
    const u32x2 g0 = *(const u32x2*)(gp + d), g1 = *(const u32x2*)(gp + 32 + d);
    w0[g][0] = pk_bf16(o0[4 * g] * inv * bflo(g0[0]), o0[4 * g + 1] * inv * bfhi(g0[0]));
    w0[g][1] = pk_bf16(o0[4 * g + 2] * inv * bflo(g0[1]), o0[4 * g + 3] * inv * bfhi(g0[1]));
    w1[g][0] = pk_bf16(o1[4 * g] * inv * bflo(g1[0]), o1[4 * g + 1] * inv * bfhi(g1[0]));
    w1[g][1] = pk_bf16(o1[4 * g + 2] * inv * bflo(g1[1]), o1[4 * g + 3] * inv * bfhi(g1[1]));
  }
  st_pair16(dst, 0, h, w0[0], w0[1]);
  st_pair16(dst, 2, h, w0[2], w0[3]);
  st_pair16(dst + 32, 0, h, w1[0], w1[1]);
  st_pair16(dst + 32, 2, h, w1[2], w1[3]);
}

DI void attn_dilated(const Params& p, int u, char* lds) {
  constexpr int KSTR = 144, KBYTES = 384 * KSTR;
  constexpr int VSTR = 192;
  const int tid = fresh_tid(), lane = tid & 63, wid = __builtin_amdgcn_readfirstlane(tid >> 6), ql = lane & 31, h = lane >> 5;
  int T, seq_row0, hh, cfg, cls, u0, NB;
  {
    int r;
    if (u < 512) { T = 8192; seq_row0 = (u >> 8) * 8192; hh = (u >> 5) & 7; r = u & 31;
      if (r < 8) { cfg = 0; cls = 0; NB = 4; u0 = r * 1024; }
      else if (r < 16) { cfg = 1; cls = (r - 8) >> 1; NB = 4; u0 = ((r - 8) & 1) * 1024; }
      else { cfg = 2; cls = r - 16; NB = 2; u0 = 0; } }
    else { const int v = u - 512; T = 4096; seq_row0 = M_PROMPT + (v / 192) * 4096; hh = (v / 24) & 7; r = v % 24;
      if (r < 4) { cfg = 0; cls = 0; NB = 4; u0 = r * 1024; }
      else if (r < 8) { cfg = 1; cls = r - 4; NB = 4; u0 = 0; }
      else { cfg = 2; cls = r - 8; NB = 1; u0 = 0; } }
  }
  const int dd = 1 << (2 * cfg), U = T >> (2 * cfg);
  const float c2 = 0.125f * LOG2E;
  const float slope2 = exp2f(-(float)(hh + 1)) * (float)dd * LOG2E;

  u32x4 kr[6], vr[6];
  const int wrow = tid >> 3, kc = tid & 7;
  auto gload = [&](int b) {
    const int ub = u0 + 256 * b;
#pragma unroll
    for (int i = 0; i < 6; ++i) {
      int uk = ub - 64 + wrow + 64 * i;
      uk = uk < 0 ? 0 : (uk >= U ? U - 1 : uk);
      const char* kbase = (const char*)(p.qkva + ((size_t)(8 + hh) * M_TOK + seq_row0) * 64);
      const char* vbase = (const char*)(p.qkva + ((size_t)(16 + hh) * M_TOK + seq_row0) * 64);
      const unsigned off = ((unsigned)(uk * dd + cls) * 64u + 8u * kc) * 2u;
      kr[i] = *(const u32x4*)(kbase + off);
      vr[i] = *(const u32x4*)(vbase + off);
    }
  };
  auto lwrite = [&]() {
#pragma unroll
    for (int i = 0; i < 6; ++i) {
      const int w = wrow + 64 * i;
      *(u32x4*)(lds + w * KSTR + kc * 16) = kr[i];
      *(u32x4*)(lds + KBYTES + w * VSTR + kc * 16) = vr[i];
    }
  };
  const int sq = (ql & ~12) | ((ql & 4) << 1) | ((ql & 8) >> 1);
  const int koff = sq * KSTR + h * 16;
  const int voff = KBYTES + (8 * h + ((lane & 15) >> 2)) * VSTR + 32 * ((lane >> 4) & 1) + 8 * (lane & 3);
  const int wc = wid >> 1;

  __syncthreads();
  gload(0);
  lwrite();
  __syncthreads();
  for (int b = 0; b < NB; ++b) {
    if (b + 1 < NB) gload(b + 1);
    const int ub = u0 + 256 * b;
    const int mq = seq_row0 + (ub + wid * 32 + ql) * dd + cls;
    bf16x8 qf[4];
    {
      const bf16_t* qp = p.qkva + ((size_t)hh * M_TOK + mq) * 64 + 8 * h;
#pragma unroll
      for (int c = 0; c < 4; ++c) {
        u32x4 w = *(const u32x4*)(qp + 16 * c);
#pragma unroll
        for (int j = 0; j < 4; ++j) w[j] = pk_bf16(bflo(w[j]) * c2, bfhi(w[j]) * c2);
        qf[c] = __builtin_bit_cast(bf16x8, w);
      }
    }
    f32x16 o0, o1;
#pragma unroll
    for (int i = 0; i < 16; ++i) { o0[i] = 0.f; o1[i] = 0.f; }
    float m_ref = 0.f, l_run = 0.f;
#pragma unroll 1
    for (int ord = 0; ord < 3; ++ord) {
      const int j = (ord == 0) ? wc + 1 : (ord == 1 ? wc : wc + 2);
      const int ut = ub - 64 + 64 * j;
      if (ut >= 0 && ut < U) {
        const char* kp = lds + (64 * j) * KSTR + koff;
        const char* vp = lds + voff + (64 * j) * VSTR;
        f32x16 s0, s1;
#pragma unroll
        for (int i = 0; i < 16; ++i) { s0[i] = 0.f; s1[i] = 0.f; }
#pragma unroll
        for (int c = 0; c < 4; ++c) {
          s0 = MFMA32(*(const bf16x8*)(kp + c * 32), qf[c], s0);
          s1 = MFMA32(*(const bf16x8*)(kp + 32 * KSTR + c * 32), qf[c], s1);
        }
        const float fb = (float)(64 * j - 64 + 8 * h - (32 * wid + ql));
        float mx = -1e30f;
#pragma unroll
        for (int i = 0; i < 16; ++i) {
          const float d0 = fb + (float)(16 * (i >> 3) + (i & 7)), d1 = d0 + 32.f;
          const float a0 = fabsf(d0), a1 = fabsf(d1);
          s0[i] = (a0 <= 64.f) ? __builtin_fmaf(-slope2, a0, s0[i]) : -1e30f;
          s1[i] = (a1 <= 64.f) ? __builtin_fmaf(-slope2, a1, s1[i]) : -1e30f;
          if (ord == 0) mx = fmaxf(mx, fmaxf(s0[i], s1[i]));
        }
        if (ord == 0) { mx = fmaxf(mx, __shfl_xor(mx, 32)); m_ref = mx; }
        float ls = 0.f;
#pragma unroll
        for (int i = 0; i < 16; ++i) {
          s0[i] = (s0[i] > -1e29f) ? __builtin_amdgcn_exp2f(s0[i] - m_ref) : 0.f;
          s1[i] = (s1[i] > -1e29f) ? __builtin_amdgcn_exp2f(s1[i] - m_ref) : 0.f;
          ls += s0[i] + s1[i];
        }
        if (ord != 0 && __builtin_amdgcn_ballot_w64(!(ls < 1e30f)) != 0ull) {
#pragma unroll
          for (int i = 0; i < 16; ++i) { s0[i] = 0.f; s1[i] = 0.f; }
#pragma unroll
          for (int c = 0; c < 4; ++c) {
            s0 = MFMA32(*(const bf16x8*)(kp + c * 32), qf[c], s0);
            s1 = MFMA32(*(const bf16x8*)(kp + 32 * KSTR + c * 32), qf[c], s1);
          }
          float m2 = -1e30f;
#pragma unroll
          for (int i = 0; i < 16; ++i) {
            const float d0 = fb + (float)(16 * (i >> 3) + (i & 7)), d1 = d0 + 32.f;
            const float a0 = fabsf(d0), a1 = fabsf(d1);
            s0[i] = (a0 <= 64.f) ? __builtin_fmaf(-slope2, a0, s0[i]) : -1e30f;
            s1[i] = (a1 <= 64.f) ? __builtin_fmaf(-slope2, a1, s1[i]) : -1e30f;
            m2 = fmaxf(m2, fmaxf(s0[i], s1[i]));
          }
          m2 = fmaxf(m2, __shfl_xor(m2, 32));
          const float delta = fmaxf(m2 - m_ref, 0.f);
          const float alpha = __builtin_amdgcn_exp2f(-delta);
          m_ref += delta;
          l_run *= alpha;
#pragma unroll
          for (int i = 0; i < 16; ++i) { o0[i] *= alpha; o1[i] *= alpha; }
          ls = 0.f;
#pragma unroll
          for (int i = 0; i < 16; ++i) {
            s0[i] = (s0[i] > -1e29f) ? __builtin_amdgcn_exp2f(s0[i] - m_ref) : 0.f;
            s1[i] = (s1[i] > -1e29f) ? __builtin_amdgcn_exp2f(s1[i] - m_ref) : 0.f;
            ls += s0[i] + s1[i];
          }
        }
        l_run += ls;
#pragma unroll
        for (int s = 0; s < 2; ++s) {
          u32x4 pa, pb;
#pragma unroll
          for (int jj = 0; jj < 4; ++jj) {
            pa[jj] = pk_bf16(s0[8 * s + 2 * jj], s0[8 * s + 2 * jj + 1]);
            pb[jj] = pk_bf16(s1[8 * s + 2 * jj], s1[8 * s + 2 * jj + 1]);
          }
          const bf16x8 pfa = __builtin_bit_cast(bf16x8, pa), pfb = __builtin_bit_cast(bf16x8, pb);
          auto vfrag = [&](int k0, int db) -> bf16x8 {
            const s16x4 lo = __builtin_amdgcn_ds_read_tr16_b64_v4i16((LAS s16x4*)(vp + k0 * VSTR + db * 64));
            const s16x4 hi = __builtin_amdgcn_ds_read_tr16_b64_v4i16((LAS s16x4*)(vp + (k0 + 4) * VSTR + db * 64));
            return __builtin_shufflevector(lo, hi, 0, 1, 2, 3, 4, 5, 6, 7);
          };
          o0 = MFMA32(vfrag(16 * s, 0), pfa, o0);
          o1 = MFMA32(vfrag(16 * s, 1), pfa, o1);
          o0 = MFMA32(vfrag(32 + 16 * s, 0), pfb, o0);
          o1 = MFMA32(vfrag(32 + 16 * s, 1), pfb, o1);
        }
      }
    }
    {
      const float l_tot = l_run + __shfl_xor(l_run, 32);
      const float inv = 1.f / l_tot;
      bf16_t* dst = p.pA + (size_t)cfg * M_TOK * 512 + (size_t)mq * 512 + hh * 64;
      u32x2 w0[4], w1[4];
#pragma unroll
      for (int g = 0; g < 4; ++g) {
        w0[g][0] = pk_bf16(o0[4 * g] * inv, o0[4 * g + 1] * inv); w0[g][1] = pk_bf16(o0[4 * g + 2] * inv, o0[4 * g + 3] * inv);
        w1[g][0] = pk_bf16(o1[4 * g] * inv, o1[4 * g + 1] * inv); w1[g][1] = pk_bf16(o1[4 * g + 2] * inv, o1[4 * g + 3] * inv);
      }
      st_pair16(dst, 0, h, w0[0], w0[1]);
      st_pair16(dst, 2, h, w0[2], w0[3]);
      st_pair16(dst + 32, 0, h, w1[0], w1[1]);
      st_pair16(dst + 32, 2, h, w1[2], w1[3]);
      if (h == 0) p.lse[(size_t)cfg * M_TOK * 8 + (size_t)mq * 8 + hh] = m_ref + __builtin_amdgcn_logf(l_tot);
    }
    __syncthreads();
    if (b + 1 < NB) { lwrite(); __syncthreads(); }
  }
}

DI void phase_merge(const Params& p) {
  const int nthr = gridDim.x * 512;
  for (int e = blockIdx.x * 512 + threadIdx.x; e < M_TOK * 64; e += nthr) {
    const int m = e >> 6, c = e & 63, hh = c >> 3;
    const float l0 = p.lse[(size_t)m * 8 + hh], l1 = p.lse[(size_t)M_TOK * 8 + (size_t)m * 8 + hh], l2 = p.lse[(size_t)2 * M_TOK * 8 + (size_t)m * 8 + hh];
    const float mx = fmaxf(l0, fmaxf(l1, l2));
    float w0 = __builtin_amdgcn_exp2f(l0 - mx), w1 = __builtin_amdgcn_exp2f(l1 - mx), w2 = __builtin_amdgcn_exp2f(l2 - mx);
    const float inv = 1.f / (w0 + w1 + w2);
    w0 *= inv; w1 *= inv; w2 *= inv;
    const u32x4 a = *(const u32x4*)(p.pA + (size_t)m * 512 + c * 8);
    const u32x4 b = *(const u32x4*)(p.pA + (size_t)M_TOK * 512 + (size_t)m * 512 + c * 8);
    const u32x4 d = *(const u32x4*)(p.pA + (size_t)2 * M_TOK * 512 + (size_t)m * 512 + c * 8);
    const u32x4 g = *(const u32x4*)(p.proj + (size_t)m * LD0 + 416 + c * 8);
    u32x4 o;
#pragma unroll
    for (int j = 0; j < 4; ++j) {
      const float lo = (bflo(a[j]) * w0 + bflo(b[j]) * w1 + bflo(d[j]) * w2) * bflo(g[j]);
      const float hi = (bfhi(a[j]) * w0 + bfhi(b[j]) * w1 + bfhi(d[j]) * w2) * bfhi(g[j]);
      o[j] = pk_bf16(lo, hi);
    }
    *(u32x4*)(p.h + (size_t)m * 1024 + c * 8) = o;
  }
}

template <int PH>
DI void run_phase(const Params& p, char* lds) {
  const int bid = blockIdx.x, nblk = gridDim.x;
  if (PH == 0) phase_prep(p, lds);
  else if (PH == 1) { for (int t = bid; t < 320 * 12; t += nblk) { int pm, pn; g8_tile(t, 320, 12, pm, pn); gemm_tile<0>(p, p.h, 1024, p.wt_in_ab, 1024, pm * 256, pn * 256, lds); } }
  else if (PH == 2) phase_mlanorm(p);
  else if (PH == 3) {
    for (int t = bid; t < 960 + 1280; t += nblk) {
      int pm, pn;
      if (t < 960) { g8_tile(t, 320, 3, pm, pn); gemm_tile<1>(p, p.proj, LD0, p.wt_uq, 256, pm * 256, pn * 256, lds); }
      else { g8_tile(t - 960, 320, 4, pm, pn); gemm_tile<2>(p, p.proj + 256, LD0, p.wt_ukv, 128, pm * 256, pn * 256, lds); }
    }
  }
  else if (PH == 4) {
    for (int u = bid; u < 2560; u += nblk) attn_dense128<0>(p, u, lds);
    for (int u = bid; u < 3584; u += nblk) attn_dilated(p, u, lds);
  }
  else if (PH == 5) phase_merge(p);
  else if (PH == 6) { for (int t = bid; t < 1280; t += nblk) { int pm, pn; g8_tile(t, 320, 4, pm, pn); gemm_tile<3>(p, p.h, 1024, p.wt_out_ab, 1024, pm * 256, pn * 256, lds); } }
  else if (PH == 7) phase_postnorm<false>(p, p.proj, p.norm_post, p.norm_pre + 1024);
  else if (PH == 8) { for (int t = bid; t < 3200; t += nblk) { int pm, pn; g8_tile(t, 320, 10, pm, pn); gemm_tile<4>(p, p.h, 1024, p.wt_in_c, 1024, pm * 256, pn * 256, lds); } }
  else if (PH == 9) { for (int u = bid; u < 5120; u += nblk) attn_dense128<1, false, true>(p, u, lds); }
  else if (PH == 10) { for (int t = bid; t < 1280; t += nblk) { int pm, pn; g8_tile(t, 320, 4, pm, pn); gemm_tile<5>(p, p.h, 1024, p.wt_out_c, 1024, pm * 256, pn * 256, lds); } }
  else if (PH == 11) phase_postnorm<true>(p, p.yout1, p.norm_post + 1024, nullptr);
}

template <int PH>
__global__ void __launch_bounds__(512) k_phase(Params p) {
  __shared__ __attribute__((aligned(16))) char lds[LDS_BYTES];
  run_phase<PH>(p, lds);
}

__global__ void __launch_bounds__(512) k_mega(Params p) {
  __shared__ __attribute__((aligned(16))) char lds[LDS_BYTES];
  cg::grid_group grid = cg::this_grid();
  run_phase<0>(p, lds); grid.sync();
  run_phase<1>(p, lds); grid.sync();
  run_phase<3>(p, lds); grid.sync();
  run_phase<4>(p, lds); grid.sync();
  run_phase<5>(p, lds); grid.sync();
  run_phase<6>(p, lds); grid.sync();
  run_phase<7>(p, lds); grid.sync();
  run_phase<8>(p, lds); grid.sync();
#ifdef PROBE_GEMM
  run_phase<8>(p, lds); grid.sync();
#endif
  run_phase<9>(p, lds); grid.sync();
#ifdef PROBE_ATT
  run_phase<9>(p, lds); grid.sync();
#endif
  run_phase<10>(p, lds); grid.sync();
  run_phase<11>(p, lds);
}

extern "C" void kernel_launch(void* const* d_in, const int* in_sizes, int n_in, void* d_out, int out_size, void* d_ws,
                              size_t ws_size, hipStream_t stream) {
  Params p{};
  p.x_prompt = (const float*)d_in[0]; p.x_sample = (const float*)d_in[1];
  p.norm_pre = (const float*)d_in[2]; p.norm_post = (const float*)d_in[3];
  p.w_in_ab = (const float*)d_in[4]; p.mla_q_norm = (const float*)d_in[5]; p.w_uq = (const float*)d_in[6];
  p.mla_kv_norm = (const float*)d_in[7]; p.w_ukv = (const float*)d_in[8]; p.w_out_ab = (const float*)d_in[9];
  p.w_in_c = (const float*)d_in[10]; p.c_q_norm = (const float*)d_in[11]; p.c_k_norm = (const float*)d_in[12];
  p.w_out_c = (const float*)d_in[13];
  p.out = (float*)d_out;
  char* ws = (char*)d_ws;
  const size_t MiB = 1ull << 20;
  p.wt_in_ab = (bf16_t*)(ws + 0 * MiB);
  p.wt_out_ab = (bf16_t*)(ws + 6 * MiB);
  p.wt_in_c = (bf16_t*)(ws + 8 * MiB);
  p.wt_out_c = (bf16_t*)(ws + 13 * MiB);
  p.rope = (float2*)(ws + 15 * MiB);
  p.wt_uq = (bf16_t*)(ws + 16 * MiB);
  p.wt_ukv = (bf16_t*)(ws + 16 * MiB + 512 * 1024);
  p.h = (bf16_t*)(ws + 20 * MiB);
  p.proj = (bf16_t*)(ws + 180 * MiB);
  p.qb = (bf16_t*)(ws + 645 * MiB);
  p.knope = (bf16_t*)(ws + 765 * MiB);
  p.vbT = (bf16_t*)(ws + 845 * MiB);
  p.krope = (bf16_t*)(ws + 925 * MiB);
  p.v1T = (bf16_t*)(ws + 645 * MiB);
  p.yout1 = (bf16_t*)(ws + 700 * MiB);
  p.pA = (bf16_t*)d_out;
  p.lse = (float*)((char*)d_out + 240 * MiB);
  p.qkva = (bf16_t*)(ws + 405 * MiB);
  p.rss_q = (float*)(ws + 931 * MiB);
  p.rss_kv = (float*)(ws + 932 * MiB);
#if N_LAUNCH_MODE == 1
  static int grid_blocks = 0;
  if (!grid_blocks) {
    int dev = 0, cus = 0, per_cu = 0;
    hipGetDevice(&dev);
    hipDeviceGetAttribute(&cus, hipDeviceAttributeMultiprocessorCount, dev);
    hipOccupancyMaxActiveBlocksPerMultiprocessor(&per_cu, k_mega, 512, 0);
    if (per_cu < 1) per_cu = 1;
    if (per_cu > 1) per_cu = 1;
    grid_blocks = cus * per_cu;
  }
  void* args[] = {&p};
  hipError_t e = hipLaunchCooperativeKernel((void*)k_mega, dim3(grid_blocks), dim3(512), args, 0, stream);
  if (e != hipSuccess) fprintf(stderr, "cooperative launch failed: %s (grid %d)\n", hipGetErrorString(e), grid_blocks);
#else
  const dim3 g(256), b(512);
  k_phase<0><<<g, b, 0, stream>>>(p);
  k_phase<1><<<g, b, 0, stream>>>(p);
  k_phase<3><<<g, b, 0, stream>>>(p);
  k_phase<4><<<g, b, 0, stream>>>(p);
  k_phase<5><<<g, b, 0, stream>>>(p);
  k_phase<6><<<g, b, 0, stream>>>(p);
  k_phase<7><<<g, b, 0, stream>>>(p);
  k_phase<8><<<g, b, 0, stream>>>(p);
  k_phase<9><<<g, b, 0, stream>>>(p);
  k_phase<10><<<g, b, 0, stream>>>(p);
  k_phase<11><<<g, b, 0, stream>>>(p);
#endif
}
```
